# Optimizing an MI355X kernel written in HIP

```python
import jax, jax.numpy as jnp
from jax import lax
import numpy as np

D_MODEL = 4096
BATCH = 1
SEQ = 8192
DEPTH = 2
DEC_BATCH = 16
DEC_SEQ = 16
PAST_LEN = 1024

CHUNK = 64
Q_BLOCK = 128
HEAD_DIM = 128
A_HEADS = D_MODEL // 2 // HEAD_DIM
A_DK = 128
A_DV = HEAD_DIM
A_QK = A_HEADS * A_DK
A_WIDTH = A_HEADS * A_DV
B_HEADS = D_MODEL // 2 // HEAD_DIM
B_WIDTH = B_HEADS * HEAD_DIM
C_HEADS = D_MODEL // HEAD_DIM
C_WIDTH = C_HEADS * HEAD_DIM
N_EVEN = (DEPTH + 1) // 2
N_ODD = DEPTH // 2
EVEN_SPLITS = (A_QK, A_QK, A_WIDTH, A_WIDTH, B_WIDTH, B_WIDTH, B_WIDTH, B_WIDTH)
ODD_SPLITS = (C_WIDTH, C_WIDTH, C_WIDTH, C_WIDTH, C_HEADS)
EVEN_IN = sum(EVEN_SPLITS)
ODD_IN = sum(ODD_SPLITS)
EPS = 1e-6

kernel_name = 'hgrn2_stickbreak_fox_streaming_step'


def _split(a, sizes):
    idx = [int(i) for i in np.cumsum(sizes)[:-1]]
    return jnp.split(a, idx, axis=-1)


def rms_norm(x, w):
    xf = x.astype(jnp.float32)
    y = xf * lax.rsqrt(jnp.mean(xf * xf, axis=-1, keepdims=True) + EPS)
    return (y * w.astype(jnp.float32)).astype(x.dtype)


def hgrn2_chunkwise(q, k, v, g, s0):
    B, T, H, DK = q.shape
    DV = v.shape[-1]
    c = min(CHUNK, T)
    n = T // c

    def to_chunks(a):
        return a.astype(jnp.float32).reshape(B, n, c, H, a.shape[-1]).transpose(1, 0, 3, 2, 4)

    qc, kc, vc, gc = to_chunks(q), to_chunks(k), to_chunks(v), to_chunks(g)
    causal = jnp.tril(jnp.ones((c, c), dtype=bool))

    def step(S, inp):
        qi, ki, vi, gi = inp
        G = jnp.cumsum(gi, axis=2)
        o_inter = jnp.einsum('bhtk,bhkv->bhtv', qi * jnp.exp(G), S)
        diff = jnp.where(causal[None, None, :, :, None], G[:, :, :, None, :] - G[:, :, None, :, :], -jnp.inf)
        att = jnp.einsum('bhtsk,bhsk->bhts', qi[:, :, :, None, :] * jnp.exp(diff), ki)
        o_intra = jnp.einsum('bhts,bhsv->bhtv', att, vi)
        G_last = G[:, :, -1:, :]
        S_new = S * jnp.exp(G_last[:, :, 0, :, None]) + jnp.einsum('bhsk,bhsv->bhkv', ki * jnp.exp(G_last - G), vi)
        return S_new, o_inter + o_intra

    S, o = lax.scan(step, s0.astype(jnp.float32), (qc, kc, vc, gc))
    o = o.transpose(1, 0, 3, 2, 4).reshape(B, T, H, DV)
    return o, S


def stick_breaking_attention(q, k, v):
    B, Tq, H, d = q.shape
    Tk = k.shape[1]
    off = Tk - Tq
    blk = min(Q_BLOCK, Tq)
    nb = Tq // blk
    qb = q.reshape(B, nb, blk, H, d).transpose(1, 0, 2, 3, 4)
    kf = k.astype(jnp.float32)
    vf = v.astype(jnp.float32)
    kpos = jnp.arange(Tk)
    scale = d ** -0.5

    def one_block(args):
        qi, bi = args
        z = jnp.einsum('bthd,bshd->bhts', qi.astype(jnp.float32), kf) * scale
        qpos = off + bi * blk + jnp.arange(blk)
        mask = kpos[None, :] < qpos[:, None]
        log_1m = jnp.where(mask, jax.nn.log_sigmoid(-z), 0.0)
        tail = lax.cumsum(log_1m, axis=3, reverse=True) - log_1m
        w = jnp.where(mask, jnp.exp(jax.nn.log_sigmoid(z) + tail), 0.0)
        return jnp.einsum('bhts,bshd->bthd', w, vf)

    o = lax.map(one_block, (qb, jnp.arange(nb)))
    return o.transpose(1, 0, 2, 3, 4).reshape(B, Tq, H, d)


def forgetting_attention(q, k, v, logf):
    B, Tq, H, d = q.shape
    Tk = k.shape[1]
    off = Tk - Tq
    blk = min(Q_BLOCK, Tq)
    nb = Tq // blk
    F = jnp.cumsum(logf.astype(jnp.float32), axis=1)
    Fk = F.transpose(0, 2, 1)
    Fqb = F[:, off:].reshape(B, nb, blk, H).transpose(1, 0, 3, 2)
    qb = q.reshape(B, nb, blk, H, d).transpose(1, 0, 2, 3, 4)
    kf = k.astype(jnp.float32)
    vf = v.astype(jnp.float32)
    kpos = jnp.arange(Tk)
    scale = d ** -0.5

    def one_block(args):
        qi, Fi, bi = args
        s = jnp.einsum('bthd,bshd->bhts', qi.astype(jnp.float32), kf) * scale + Fi[..., None] - Fk[:, :, None, :]
        qpos = off + bi * blk + jnp.arange(blk)
        s = jnp.where(kpos[None, :] <= qpos[:, None], s, -jnp.inf)
        p = jax.nn.softmax(s, axis=-1)
        return jnp.einsum('bhts,bshd->bthd', p, vf)

    o = lax.map(one_block, (qb, Fqb, jnp.arange(nb)))
    return o.transpose(1, 0, 2, 3, 4).reshape(B, Tq, H, d)


def even_layer_mixer(h, w_in, w_out, lb, a_norm_w, s0, past_k, past_v):
    B, T, _ = h.shape
    f32 = jnp.float32
    qa, fa, ia, ga, qb, kb, vb, gb = _split(h @ w_in, EVEN_SPLITS)
    lbh = lb.astype(f32).reshape(A_HEADS, A_DK)
    z = fa.astype(f32).reshape(B, T, A_HEADS, A_DK)
    f = lbh + (1.0 - lbh) * jax.nn.sigmoid(z)
    ka = (1.0 - lbh) * jax.nn.sigmoid(-z)
    qa = jax.nn.silu(qa.astype(f32)).reshape(B, T, A_HEADS, A_DK)
    oa, s_new = hgrn2_chunkwise(qa, ka, ia.astype(f32).reshape(B, T, A_HEADS, A_DV), jnp.log(f), s0)
    oa = rms_norm(oa, a_norm_w).reshape(B, T, A_WIDTH) * jax.nn.silu(ga.astype(f32))
    qb = qb.reshape(B, T, B_HEADS, HEAD_DIM)
    kb = kb.reshape(B, T, B_HEADS, HEAD_DIM)
    vb = vb.reshape(B, T, B_HEADS, HEAD_DIM)
    if past_k is None:
        k_all, v_all = kb, vb
    else:
        k_all = jnp.concatenate([past_k.astype(kb.dtype), kb], axis=1)
        v_all = jnp.concatenate([past_v.astype(vb.dtype), vb], axis=1)
    ob = stick_breaking_attention(qb, k_all, v_all).reshape(B, T, B_WIDTH) * jax.nn.silu(gb.astype(f32))
    y = jnp.concatenate([oa, ob], axis=-1).astype(h.dtype) @ w_out
    return y, s_new, kb, vb


def odd_layer_mixer(h, w_in, b_forget, w_out, past_k, past_v, past_logf):
    B, T, _ = h.shape
    f32 = jnp.float32
    q, k, v, gate, fl = _split(h @ w_in, ODD_SPLITS)
    q = q.reshape(B, T, C_HEADS, HEAD_DIM)
    k = k.reshape(B, T, C_HEADS, HEAD_DIM)
    v = v.reshape(B, T, C_HEADS, HEAD_DIM)
    logf = jax.nn.log_sigmoid(fl.astype(f32) + b_forget.astype(f32))
    if past_k is None:
        k_all, v_all, lf_all = k, v, logf
    else:
        k_all = jnp.concatenate([past_k.astype(k.dtype), k], axis=1)
        v_all = jnp.concatenate([past_v.astype(v.dtype), v], axis=1)
        lf_all = jnp.concatenate([past_logf.astype(f32), logf], axis=1)
    o = forgetting_attention(q, k_all, v_all, lf_all).reshape(B, T, C_WIDTH) * jax.nn.silu(gate.astype(f32))
    y = o.astype(h.dtype) @ w_out
    return y, k, v, logf


def setup_inputs(seed: int = 0) -> dict:
    key = jax.random.key(seed)
    ks = jax.random.split(key, 20)
    f32 = jnp.float32

    def nrm(k, shape, scale):
        return jax.random.normal(k, shape, f32) * scale

    return {
        'x_prompt': nrm(ks[0], (BATCH, SEQ, D_MODEL), 1.0),
        'x_sample': nrm(ks[1], (DEC_BATCH, DEC_SEQ, D_MODEL), 1.0),
        'state_a_hgrn': nrm(ks[2], (N_EVEN, DEC_BATCH, A_HEADS, A_DK, A_DV), 0.3),
        'cache_b_k': nrm(ks[3], (N_EVEN, DEC_BATCH, PAST_LEN, B_HEADS, HEAD_DIM), 1.0),
        'cache_b_v': nrm(ks[4], (N_EVEN, DEC_BATCH, PAST_LEN, B_HEADS, HEAD_DIM), 1.0),
        'cache_c_k': nrm(ks[5], (N_ODD, DEC_BATCH, PAST_LEN, C_HEADS, HEAD_DIM), 1.0),
        'cache_c_v': nrm(ks[6], (N_ODD, DEC_BATCH, PAST_LEN, C_HEADS, HEAD_DIM), 1.0),
        'cache_c_logf': jax.nn.log_sigmoid(nrm(ks[7], (N_ODD, DEC_BATCH, PAST_LEN, C_HEADS), 1.0) + 3.0),
        'norm_w': 1.0 + nrm(ks[8], (DEPTH, D_MODEL), 0.02),
        'final_norm_w': 1.0 + nrm(ks[9], (D_MODEL,), 0.02),
        'w_in_even': nrm(ks[10], (N_EVEN, D_MODEL, EVEN_IN), D_MODEL ** -0.5),
        'w_out_even': nrm(ks[11], (N_EVEN, A_WIDTH + B_WIDTH, D_MODEL), (A_WIDTH + B_WIDTH) ** -0.5),
        'lb_logits': nrm(ks[12], (N_EVEN + 1, A_QK), 0.5),
        'a_norm_w': 1.0 + nrm(ks[13], (N_EVEN, A_DV), 0.02),
        'w_in_odd': nrm(ks[14], (N_ODD, D_MODEL, ODD_IN), D_MODEL ** -0.5),
        'b_forget': jax.random.uniform(ks[15], (N_ODD, C_HEADS), f32, 1.0, 5.0),
        'w_out_odd': nrm(ks[16], (N_ODD, C_WIDTH, D_MODEL), C_WIDTH ** -0.5),
    }


def reference(x_prompt, x_sample, state_a_hgrn, cache_b_k, cache_b_v, cache_c_k, cache_c_v, cache_c_logf,
              norm_w, final_norm_w, w_in_even, w_out_even, lb_logits, a_norm_w, w_in_odd, b_forget, w_out_odd):
    lb_all = jnp.cumsum(jax.nn.softmax(lb_logits.astype(jnp.float32), axis=0), axis=0)[:N_EVEN]
    hp, hs = x_prompt, x_sample
    sa_p, sa_s, bk_p, bv_p, bk_s, bv_s = [], [], [], [], [], []
    ck_p, cv_p, cf_p, ck_s, cv_s, cf_s = [], [], [], [], [], []
    for layer in range(DEPTH):
        j = layer // 2
        n_p = rms_norm(hp, norm_w[layer])
        n_s = rms_norm(hs, norm_w[layer])
        if layer % 2 == 0:
            s0 = jnp.zeros((hp.shape[0], A_HEADS, A_DK, A_DV), jnp.float32)
            yp, sp, kp, vp = even_layer_mixer(n_p, w_in_even[j], w_out_even[j], lb_all[j], a_norm_w[j], s0, None, None)
            ys, ss, ksm, vsm = even_layer_mixer(n_s, w_in_even[j], w_out_even[j], lb_all[j], a_norm_w[j],
                                                state_a_hgrn[j], cache_b_k[j], cache_b_v[j])
            sa_p.append(sp); sa_s.append(ss)
            bk_p.append(kp); bv_p.append(vp); bk_s.append(ksm); bv_s.append(vsm)
        else:
            yp, kp, vp, fp = odd_layer_mixer(n_p, w_in_odd[j], b_forget[j], w_out_odd[j], None, None, None)
            ys, ksm, vsm, fsm = odd_layer_mixer(n_s, w_in_odd[j], b_forget[j], w_out_odd[j],
                                                cache_c_k[j], cache_c_v[j], cache_c_logf[j])
            ck_p.append(kp); cv_p.append(vp); cf_p.append(fp)
            ck_s.append(ksm); cv_s.append(vsm); cf_s.append(fsm)
        hp = hp + yp.astype(hp.dtype)
        hs = hs + ys.astype(hs.dtype)
    y_prompt = rms_norm(hp, final_norm_w)
    y_sample = rms_norm(hs, final_norm_w)
    new_state_a_prompt = jnp.stack(sa_p)
    new_state_a_sample = jnp.stack(sa_s)
    new_b_k_prompt = jnp.stack(bk_p)
    new_b_v_prompt = jnp.stack(bv_p)
    new_b_k_sample = jnp.stack(bk_s)
    new_b_v_sample = jnp.stack(bv_s)
    new_c_k_prompt = jnp.stack(ck_p)
    new_c_v_prompt = jnp.stack(cv_p)
    new_c_logf_prompt = jnp.stack(cf_p)
    new_c_k_sample = jnp.stack(ck_s)
    new_c_v_sample = jnp.stack(cv_s)
    new_c_logf_sample = jnp.stack(cf_s)
    return (y_prompt, y_sample, new_state_a_prompt, new_state_a_sample,
            new_b_k_prompt, new_b_v_prompt, new_b_k_sample, new_b_v_sample,
            new_c_k_prompt, new_c_v_prompt, new_c_logf_prompt,
            new_c_k_sample, new_c_v_sample, new_c_logf_sample)
```

```cpp
#include <hip/hip_runtime.h>
#include <cstdio>
#include <cstdint>

namespace pg8 {
#define PG8_LAS __attribute__((address_space(3)))
typedef unsigned short bf16_t;
typedef short bf16x8 __attribute__((ext_vector_type(8)));
typedef float f32x4 __attribute__((ext_vector_type(4)));
typedef unsigned u32x4 __attribute__((ext_vector_type(4)));
constexpr int BM = 256, BK = 64, HALF = 128, HTB = HALF * BK * 2  , STAGE_BYTES = 8 * HTB, NXCD = 8, WGM = 8;

__host__ __device__ __forceinline__ int lds_byte(int r, int c) { const int st = (r >> 4) * 2 + (c >> 5), rr = r & 15, cc = c & 31, ob = rr * 64 + cc * 2; return st * 1024 + (ob ^ (((ob >> 9) & 1) << 5)); }
__host__ __device__ __forceinline__ void stage_rc(int b, int& R, int& C) { const int st = b / 1024, sb = b % 1024, swz = sb ^ (((sb >> 9) & 1) << 5); R = (st >> 1) * 16 + swz / 64; C = (st & 1) * 32 + (swz % 64) / 2; }
__host__ __device__ __forceinline__ int perm32(int rho) { const int n = rho >> 4, i = rho & 15; return 8 * (i >> 2) + 4 * n + (i & 3); }

struct Unit { int pm, pn, hf; };
struct Gemm { const bf16_t* A; const bf16_t* Bt; int M, N, K; };

struct StaticOrder {
    int nM, nN, nwg, G, c;
    __host__ __device__ void init(int M, int N, int G_, int c_) { nM = M / BM; nN = N / BM; nwg = nM * nN; G = G_; c = c_; }
    __host__ __device__ bool next(int i, Unit& u) const {
        const long L = (long)i * G + c; if (L >= nwg) return false;
        int wgid = (int)L; { const int q = nwg / NXCD, r = nwg % NXCD, xcd = wgid % NXCD, off = wgid / NXCD; wgid = (xcd < r ? xcd * (q + 1) : r * (q + 1) + (xcd - r) * q) + off; }
        const int nig = WGM * nN, gid = wgid / nig, fm = gid * WGM, gsz = (nM - fm) < WGM ? (nM - fm) : WGM;
        u.pm = fm + ((wgid % nig) % gsz); u.pn = (wgid % nig) / gsz; u.hf = -1; return true;
    }
    __device__ __forceinline__ void a_ready(const Unit&) const {}
    __device__ __forceinline__ void done(const Unit&) const {}
};
__device__ __forceinline__ unsigned cvt_pk_bf16(float lo, float hi) { unsigned r; asm volatile("v_cvt_pk_bf16_f32 %0, %1, %2" : "=v"(r) : "v"(lo), "v"(hi)); return r; }
template <class Epi, class Sched, bool ALIGN_EPI = false, bool SP2 = false, bool HALFN = false>
__device__ __forceinline__ void gemm_phase(PG8_LAS unsigned char* lds, const Gemm g, const Sched& S, const Epi& E, const int tid_in) {
    const int tid = tid_in, wid = __builtin_amdgcn_readfirstlane(tid >> 6), lane = tid & 63, wr = wid >> 2, wc = wid & 3, fr = lane & 15, fq = lane >> 4;
    const int K = g.K, nt = K / BK;
    unsigned voffA[2], voffB[2];
#pragma unroll
    for (int i = 0; i < 2; ++i) { int R, C; stage_rc(tid * 16 + i * 8192, R, C); const int Rb = Epi::PERM ? ((R & ~31) + perm32(R & 31)) : R;
        voffA[i] = (unsigned)(R * K + C) * 2u; voffB[i] = (unsigned)(Rb * K + C) * 2u; }
    const size_t kstep = (size_t)(BK * 2);
    const size_t hstep = (size_t)HALF * K * 2;
    const size_t tstep = 2 * hstep;
    const size_t hstepB = HALFN ? 0 : hstep;
    const unsigned ldsw = (unsigned)wid * 1024u;
    const int aoff = lds_byte(wr * 64 + fr, fq * 8), boff = lds_byte(wc * 32 + fr, fq * 8);
#define PG8_SA(b, h) (((b) * 2 + (h)) * HTB)
#define PG8_SB(b, h) ((4 + (b) * 2 + (h)) * HTB)
#define PG8_STAGE(bufoff, gbase, voff) do { _Pragma("unroll") for (int _i = 0; _i < 2; ++_i) \
        __builtin_amdgcn_global_load_lds((const unsigned*)((const char*)(gbase) + (voff)[_i]), (PG8_LAS unsigned*)(lds + (bufoff) + ldsw + _i * 8192), 16, 0, 0); } while (0)
#define PG8_LDA(dst, b, h) do { _Pragma("unroll") for (int m = 0; m < 4; ++m) _Pragma("unroll") for (int k = 0; k < 2; ++k) dst[m][k] = *(const PG8_LAS bf16x8*)(lds + PG8_SA(b, h) + aoff + m * 2048 + k * 1024); } while (0)
#define PG8_LDB(dst, b, h) do { _Pragma("unroll") for (int n = 0; n < 2; ++n) _Pragma("unroll") for (int k = 0; k < 2; ++k) dst[n][k] = *(const PG8_LAS bf16x8*)(lds + PG8_SB(b, h) + boff + n * 2048 + k * 1024); } while (0)
#define PG8_MMA(ai, bj, At, Bt) do { __builtin_amdgcn_s_setprio(1); _Pragma("unroll") for (int m = 0; m < 4; ++m) _Pragma("unroll") for (int n = 0; n < 2; ++n) _Pragma("unroll") for (int k = 0; k < 2; ++k) \
        acc[ai][bj][m][n] = __builtin_amdgcn_mfma_f32_16x16x32_bf16(Bt[n][k], At[m][k], acc[ai][bj][m][n], 0, 0, 0); __builtin_amdgcn_s_setprio(0); } while (0)
#define PG8_WAIT_V(n) asm volatile("s_waitcnt vmcnt(" #n ")" ::: "memory")
#define PG8_WAIT_L(n) asm volatile("s_waitcnt lgkmcnt(" #n ")" ::: "memory")
#define PG8_BAR __builtin_amdgcn_s_barrier()
#define PG8_SCHED __builtin_amdgcn_sched_barrier(0)
    Unit cur, nxt; int ui = 0;
    if (!S.next(0, cur)) return;
    f32x4 acc[2][2][4][2];
#pragma unroll
    for (int a = 0; a < 2; ++a)
#pragma unroll
        for (int b = 0; b < 2; ++b)
#pragma unroll
            for (int m = 0; m < 4; ++m)
#pragma unroll
                for (int n = 0; n < 2; ++n) acc[a][b][m][n] = (f32x4){0.f, 0.f, 0.f, 0.f};
    bf16x8 At[4][2], B0[2][2], B1[2][2];
    const char* cA = (const char*)g.A + (size_t)cur.pm * tstep; const char* cB = (const char*)g.Bt + (size_t)cur.pn * tstep + ((HALFN && cur.hf > 0) ? hstep : 0);
    S.a_ready(cur);
    if constexpr (SP2) {
        PG8_STAGE(PG8_SB(0, 0), cB, voffB); PG8_STAGE(PG8_SB(0, 1), cB + hstepB, voffB); PG8_STAGE(PG8_SA(0, 0), cA, voffA); PG8_STAGE(PG8_SA(0, 1), cA + hstep, voffA);
        if (wr == 1) PG8_BAR;
        PG8_WAIT_V(2); PG8_BAR;
        PG8_STAGE(PG8_SB(1, 0), cB + kstep, voffB); PG8_STAGE(PG8_SA(1, 0), cA + kstep, voffA); PG8_STAGE(PG8_SB(1, 1), cB + hstepB + kstep, voffB);
        PG8_WAIT_V(6); PG8_BAR;
    } else {
        PG8_STAGE(PG8_SB(0, 0), cB, voffB); PG8_STAGE(PG8_SA(0, 0), cA, voffA); PG8_STAGE(PG8_SB(0, 1), cB + hstepB, voffB); PG8_STAGE(PG8_SA(0, 1), cA + hstep, voffA);
        if (wr == 1) PG8_BAR;
        PG8_WAIT_V(4); PG8_BAR;
        PG8_STAGE(PG8_SB(1, 0), cB + kstep, voffB); PG8_STAGE(PG8_SA(1, 0), cA + kstep, voffA); PG8_STAGE(PG8_SB(1, 1), cB + hstepB + kstep, voffB);
        PG8_WAIT_V(6); PG8_BAR;
    }
    for (;;) {
        const bool has_next = S.next(ui + 1, nxt);
        const char* nA = has_next ? (const char*)g.A + (size_t)nxt.pm * tstep : cA; const char* nB = has_next ? (const char*)g.Bt + (size_t)nxt.pn * tstep + ((HALFN && nxt.hf > 0) ? hstep : 0) : cB;
        for (int t = 0; t < nt; t += 2) {
            const bool last = (t == nt - 2);
            const char* a1 = cA + (size_t)(t + 1) * kstep;
            const char* a2 = last ? nA : cA + (size_t)(t + 2) * kstep; const char* b2 = last ? nB : cB + (size_t)(t + 2) * kstep;
            const char* a3 = a2 + kstep; const char* b3 = b2 + kstep;
            if (last && has_next) S.a_ready(nxt);
            if constexpr (SP2) {
            PG8_LDB(B0, 0, 0); if constexpr (!HALFN) PG8_LDB(B1, 0, 1); PG8_SCHED; PG8_LDA(At, 0, 0); PG8_STAGE(PG8_SA(1, 1), a1 + hstep, voffA);
            PG8_WAIT_V(8); PG8_WAIT_L(0); PG8_BAR; PG8_MMA(0, 0, At, B0); if constexpr (!HALFN) PG8_MMA(0, 1, At, B1); PG8_BAR; PG8_SCHED;
            PG8_LDA(At, 0, 1); PG8_STAGE(PG8_SB(0, 0), b2, voffB); PG8_STAGE(PG8_SB(0, 1), b2 + hstepB, voffB); PG8_STAGE(PG8_SA(0, 0), a2, voffA);
            PG8_WAIT_V(8); PG8_WAIT_L(0); PG8_BAR; PG8_MMA(1, 0, At, B0); if constexpr (!HALFN) PG8_MMA(1, 1, At, B1); PG8_BAR; PG8_SCHED;
            PG8_LDB(B0, 1, 0); if constexpr (!HALFN) PG8_LDB(B1, 1, 1); PG8_SCHED; PG8_LDA(At, 1, 0); PG8_STAGE(PG8_SA(0, 1), a2 + hstep, voffA);
            PG8_WAIT_V(8); PG8_WAIT_L(0); PG8_BAR; PG8_MMA(0, 0, At, B0); if constexpr (!HALFN) PG8_MMA(0, 1, At, B1); PG8_BAR; PG8_SCHED;
            PG8_LDA(At, 1, 1); PG8_STAGE(PG8_SB(1, 0), b3, voffB); PG8_STAGE(PG8_SB(1, 1), b3 + hstepB, voffB); PG8_STAGE(PG8_SA(1, 0), a3, voffA);
            PG8_WAIT_V(8); PG8_WAIT_L(0); PG8_BAR; PG8_MMA(1, 0, At, B0); if constexpr (!HALFN) PG8_MMA(1, 1, At, B1); PG8_BAR; PG8_SCHED;
            } else {
            PG8_LDB(B0, 0, 0); PG8_SCHED; PG8_LDA(At, 0, 0); PG8_STAGE(PG8_SA(1, 1), a1 + hstep, voffA);
            PG8_WAIT_L(8); PG8_BAR; PG8_WAIT_L(0); PG8_MMA(0, 0, At, B0); PG8_BAR; PG8_SCHED;
            if constexpr (!HALFN) PG8_LDB(B1, 0, 1); PG8_STAGE(PG8_SB(0, 0), b2, voffB);
            PG8_BAR; PG8_WAIT_L(0); if constexpr (!HALFN) PG8_MMA(0, 1, At, B1); PG8_BAR;
            PG8_LDA(At, 0, 1); PG8_STAGE(PG8_SA(0, 0), a2, voffA);
            PG8_BAR; PG8_WAIT_L(0); PG8_MMA(1, 0, At, B0); PG8_BAR; PG8_SCHED;
            PG8_STAGE(PG8_SB(0, 1), b2 + hstepB, voffB);
            PG8_WAIT_V(6); PG8_BAR; if constexpr (!HALFN) PG8_MMA(1, 1, At, B1); PG8_BAR;
            PG8_LDB(B0, 1, 0); PG8_SCHED; PG8_LDA(At, 1, 0); PG8_STAGE(PG8_SA(0, 1), a2 + hstep, voffA);
            PG8_WAIT_L(8); PG8_BAR; PG8_WAIT_L(0); PG8_MMA(0, 0, At, B0); PG8_BAR; PG8_SCHED;
            if constexpr (!HALFN) PG8_LDB(B1, 1, 1); PG8_STAGE(PG8_SB(1, 0), b3, voffB);
            PG8_BAR; PG8_WAIT_L(0); if constexpr (!HALFN) PG8_MMA(0, 1, At, B1); PG8_BAR;
            PG8_LDA(At, 1, 1); PG8_STAGE(PG8_SA(1, 0), a3, voffA);
            PG8_BAR; PG8_WAIT_L(0); PG8_MMA(1, 0, At, B0); PG8_BAR; PG8_SCHED;
            PG8_STAGE(PG8_SB(1, 1), b3 + hstepB, voffB);
            PG8_WAIT_V(6); PG8_BAR; if constexpr (!HALFN) PG8_MMA(1, 1, At, B1); PG8_BAR;
            }
        }
        if constexpr (ALIGN_EPI) { if (wr == 0) PG8_BAR; }
        if constexpr (!Epi::AFTER_DRAIN) { E(acc, cur, wr, wc, fr, fq); S.done(cur); }
        if (!has_next) break;
#pragma unroll
        for (int a = 0; a < 2; ++a)
#pragma unroll
            for (int b = 0; b < 2; ++b)
#pragma unroll
                for (int m = 0; m < 4; ++m)
#pragma unroll
                    for (int n = 0; n < 2; ++n) acc[a][b][m][n] = (f32x4){0.f, 0.f, 0.f, 0.f};
        cur = nxt; cA = nA; cB = nB; ++ui;
        if constexpr (ALIGN_EPI) { if (wr == 1) PG8_BAR; }
    }
    PG8_WAIT_V(0);
    if constexpr (!ALIGN_EPI) { if (wr == 0) PG8_BAR; }
    PG8_BAR;
    if constexpr (Epi::AFTER_DRAIN) { E.fused(acc, cur, wr, wc, fr, fq, lds, wid, lane); S.done(cur); }
#undef PG8_SA
#undef PG8_SB
#undef PG8_STAGE
#undef PG8_LDA
#undef PG8_LDB
#undef PG8_MMA
#undef PG8_WAIT_V
#undef PG8_WAIT_L
#undef PG8_BAR
#undef PG8_SCHED
}
}

constexpr int DM = 4096, TP = 8192, NSB = 16, TSQ = 16, PAST = 1024;
constexpr int MROWS = TP + NSB * TSQ;
constexpr int N1 = 16384, N3R = 16416, N3 = 16640;
constexpr int HW = 2048;
constexpr int NH_A = 16, NH_B = 16, NH_C = 32, HD = 128;
constexpr int FCS_LD = 1056;
constexpr float EPS = 1e-6f;
constexpr float LOG2E = 1.4426950408889634f;
constexpr float QK2 = 0.08838834764831845f * 1.4426950408889634f;
constexpr float NFRS = 11.313708498984761f;
constexpr float FIX = 16777216.f;

constexpr size_t O_YP = 0, O_YS = O_YP + (size_t)TP * DM, O_SAP = O_YS + (size_t)256 * DM, O_SAS = O_SAP + (size_t)16 * 128 * 128,
    O_BKP = O_SAS + (size_t)16 * 16 * 128 * 128, O_BVP = O_BKP + (size_t)TP * HW, O_BKS = O_BVP + (size_t)TP * HW, O_BVS = O_BKS + (size_t)256 * HW,
    O_CKP = O_BVS + (size_t)256 * HW, O_CVP = O_CKP + (size_t)TP * DM, O_CFP = O_CVP + (size_t)TP * DM, O_CKS = O_CFP + (size_t)TP * 32,
    O_CVS = O_CKS + (size_t)256 * DM, O_CFS = O_CVS + (size_t)256 * DM, O_END = O_CFS + (size_t)256 * 32;
static_assert(O_END == 143138816, "output size");

constexpr size_t MiB = 1u << 20;
constexpr size_t WS_CTL = 0, CTL_ZERO_BYTES = 1 * MiB;
constexpr size_t WS_LB = 1 * MiB;
constexpr size_t WS_W1T = 2 * MiB;
constexpr size_t WS_W2T = WS_W1T + 128 * MiB;
constexpr size_t WS_W3T = WS_W2T + 32 * MiB;
constexpr size_t WS_W4T = WS_W3T + 130 * MiB;
constexpr size_t WS_XN = WS_W4T + 32 * MiB;
constexpr size_t WS_P = WS_XN + 66 * MiB;
constexpr size_t PSTR1 = (size_t)MROWS * HW;
constexpr size_t PSTR3 = (size_t)MROWS * DM;
constexpr size_t WS_G = WS_P + 8 * 33 * MiB;
constexpr size_t WS_A = WS_G + 66 * MiB;
constexpr size_t WS_H1 = WS_A + 66 * MiB;
constexpr size_t WS_SLOC = WS_H1 + 132 * MiB;
constexpr size_t WS_SST = WS_SLOC + 128 * MiB;
constexpr size_t WS_DEC = WS_SST + 64 * MiB;
constexpr size_t WS_FL = WS_DEC + 1 * MiB;
constexpr size_t WS_FCP = WS_FL + 2 * MiB;
constexpr size_t WS_FCS = WS_FCP + 1 * MiB;
constexpr size_t WS_P3 = WS_FCS + 3 * MiB;
constexpr size_t WS_END = WS_P3 + 4 * 66 * MiB;
static_assert(WS_P + 4 * 66 * MiB <= WS_A, "layer-1 overlay fits");
constexpr int CW_BAR = 4096;
constexpr int CW_RS1 = 16384;
constexpr int CW_RS2 = CW_RS1 + 2 * 8448 + 128;
constexpr int CW_STAT = CW_RS2 + 2 * 8448 + 128;
constexpr int CW_KN2 = 8192;
constexpr int CW_WQ = CW_KN2 + 64;
constexpr int CW_WQ3 = CW_WQ + 32;
constexpr int CW_WQ4 = CW_WQ + 64, CW_FQ = CW_WQ4 + 64;
constexpr int CW_HSTAT = CW_STAT + 256;
static_assert(CW_BAR + 3456 <= CW_KN2 && CW_FQ + 128 <= CW_RS1 && (CW_HSTAT + 128) * 4 <= (int)CTL_ZERO_BYTES, "ctl region");

constexpr int RING_BYTES = 131072;
constexpr int MISC_OFF = RING_BYTES + 320;
constexpr int LDS_BYTES = 147456;
constexpr int NWAVES = 8;

#define LAS __attribute__((address_space(3)))
typedef unsigned short bf16_t;
typedef unsigned v4u __attribute__((ext_vector_type(4)));
typedef unsigned v2u __attribute__((ext_vector_type(2)));
typedef float f32x4 __attribute__((ext_vector_type(4)));
typedef float f32x2 __attribute__((ext_vector_type(2)));
typedef float f32x16 __attribute__((ext_vector_type(16)));
typedef short bf16x8 __attribute__((ext_vector_type(8)));
typedef short s16x4 __attribute__((ext_vector_type(4)));
#define LDS_WAIT() asm volatile("s_waitcnt lgkmcnt(0)" ::: "memory")
#define VM_WAIT() asm volatile("s_waitcnt vmcnt(0)" ::: "memory")

typedef __bf16 bf16x2_n __attribute__((ext_vector_type(2)));
__device__ __forceinline__ unsigned cvtpk(float lo, float hi) { const f32x2 f = {lo, hi}; const bf16x2_n r = __builtin_convertvector(f, bf16x2_n); return __builtin_bit_cast(unsigned, r); }
__device__ __forceinline__ float bf2f(unsigned short b) { return __uint_as_float(((unsigned)b) << 16); }
__device__ __forceinline__ float bflo(unsigned w) { return __uint_as_float(w << 16); }
__device__ __forceinline__ float bfhi(unsigned w) { return __uint_as_float(w & 0xffff0000u); }
__device__ __forceinline__ float ex2(float x) { return __builtin_amdgcn_exp2f(x); }
__device__ __forceinline__ float lg2(float x) { return __builtin_amdgcn_logf(x); }
__device__ __forceinline__ float rcpf_(float x) { return __builtin_amdgcn_rcpf(x); }
__device__ __forceinline__ float silu_f(float x) { return x * rcpf_(1.f + ex2(-x * LOG2E)); }
__device__ __forceinline__ float wave_sum(float v) {
#pragma unroll
    for (int o = 1; o < 64; o <<= 1) v += __shfl_xor(v, o);
    return v;
}
__device__ __forceinline__ unsigned off_b(unsigned row, unsigned ch) { return 256u * row + 16u * (ch ^ (((row & 3u) << 2) | ((row >> 2) & 3u))); }

#define XB_TMO      128
#define XB_XCNT(j)  (256  + 64 * (j))
#define XB_XSUB(j)  (1280 + 64 * (j))
#define XB_XGEN(j)  (2304 + 64 * (j))
#define XB_TOP      3328
#define XB_TOPGEN   3392
#define XCD_BAR_WORDS 3456
#define XB_SPIN_CAP (1u << 18)
__device__ __forceinline__ unsigned xb_ld(unsigned* p)              { return __hip_atomic_load(p, __ATOMIC_RELAXED, __HIP_MEMORY_SCOPE_AGENT); }
__device__ __forceinline__ unsigned xb_add(unsigned* p, unsigned v) { return __hip_atomic_fetch_add(p, v, __ATOMIC_RELAXED, __HIP_MEMORY_SCOPE_AGENT); }
__device__ __forceinline__ unsigned xb_xcc_id() { return (unsigned)__builtin_amdgcn_s_getreg((3 << 11) | 20) & 0xFu; }
#define XB_SPIN(cond, bar) do { unsigned _sp = 0; while (cond) { __builtin_amdgcn_s_sleep(1); \
    if ((++_sp & 255u) == 0u) { if (xb_ld(&(bar)[XB_TMO])) break; if (_sp > XB_SPIN_CAP) { atomicAdd(&(bar)[XB_TMO], 1u); break; } } } } while (0)
struct XcdBarrier { unsigned* bar; unsigned x; volatile LAS unsigned* st; };
__device__ __forceinline__ XcdBarrier xcd_barrier_post(unsigned* bar, volatile LAS unsigned* st) {
    XcdBarrier b; b.bar = bar; b.x = xb_xcc_id(); b.st = st;
    if (threadIdx.x == 0) (void)xb_add(&bar[XB_XCNT(b.x)], 1u);
    return b;
}
__device__ __forceinline__ void xcd_barrier_complete(unsigned* bar, unsigned x, unsigned& nloc, unsigned& nx) {
    const unsigned G = gridDim.x * gridDim.y * gridDim.z;
    unsigned sum, cnt, mine, sp = 0u;
    for (;;) {
        sum = 0u; cnt = 0u; mine = 0u;
#pragma unroll
        for (unsigned j = 0; j < 16; ++j) { const unsigned c = xb_ld(&bar[XB_XCNT(j)]); sum += c; cnt += (c > 0u) ? 1u : 0u; mine = (j == x) ? c : mine; }
        if (sum == G) break;
        __builtin_amdgcn_s_sleep(1);
        if ((++sp & 255u) == 0u) { if (xb_ld(&bar[XB_TMO])) break; if (sp > XB_SPIN_CAP) { atomicAdd(&bar[XB_TMO], 1u); break; } }
    }
    nloc = mine > 0u ? mine : 1u; nx = cnt > 0u ? cnt : 1u;
}
__device__ __forceinline__ void xcd_barrier(const XcdBarrier& b, const int wid0  ) {
    asm volatile("s_waitcnt vmcnt(0)" ::: "memory");
    __syncthreads();
    if (wid0 == 0 && __builtin_amdgcn_mbcnt_hi(~0u, __builtin_amdgcn_mbcnt_lo(~0u, 0u)) == 0u) {
        unsigned* bar = b.bar;
        __builtin_amdgcn_s_waitcnt(0);
        unsigned nloc = b.st[0], nx = b.st[1];
        if (nloc == 0u) { xcd_barrier_complete(bar, b.x, nloc, nx); b.st[0] = nloc; b.st[1] = nx; }
        const unsigned old = xb_add(&bar[XB_XSUB(b.x)], 1u);
        const unsigned gen = old / nloc;
        if (old + 1u == (gen + 1u) * nloc) {
            __builtin_amdgcn_fence(__ATOMIC_RELEASE, "agent");
            asm volatile("s_waitcnt vmcnt(0)" ::: "memory");
            const unsigned og = xb_add(&bar[XB_TOP], 1u);
            const unsigned tg = og / nx;
            if (og + 1u == (tg + 1u) * nx) xb_add(&bar[XB_TOPGEN], 1u);
            else XB_SPIN(xb_ld(&bar[XB_TOPGEN]) == tg, bar);
            __builtin_amdgcn_fence(__ATOMIC_ACQUIRE, "agent");
            xb_add(&bar[XB_XGEN(b.x)], 1u);
            asm volatile("s_waitcnt vmcnt(0)" ::: "memory");
        } else {
            XB_SPIN(xb_ld(&bar[XB_XGEN(b.x)]) == gen, bar);
            __builtin_amdgcn_fence(__ATOMIC_ACQUIRE, "agent");
            asm volatile("s_waitcnt vmcnt(0)" ::: "memory");
        }
    }
    __syncthreads();
}

using pg8::Unit;
struct Epi1 {
    static constexpr bool PERM = true, AFTER_DRAIN = false;
    bf16_t* P; float* G; const float* LB; float* out;
    __device__ __forceinline__ void operator()(const f32x4 (&acc)[2][2][4][2], const Unit& u, int wr, int wc, int fr, int fq) const {
        const int t = u.pn >> 3;
        const int row0 = u.pm * 256 + wr * 64 + fr, col0 = (u.pn & 7) * 256 + wc * 32 + 8 * fq + (u.hf > 0 ? 128 : 0);
        const int nbj = (u.hf >= 0) ? 1 : 2;
        bf16_t* dst = P + (size_t)t * PSTR1;
        float* fo = nullptr;
        if (t == 5 || t == 6) { const bool smp = u.pm >= 32; fo = out + (t == 5 ? (smp ? O_BKS : O_BKP) : (smp ? O_BVS : O_BVP)) - (smp ? (size_t)TP * HW : (size_t)0); }
        f32x4 lbv[2][2];
#pragma unroll
        for (int bj = 0; bj < 2; ++bj)
#pragma unroll
            for (int n = 0; n < 2; ++n) lbv[bj][n] = (t == 1 && bj < nbj) ? *(const f32x4*)(LB + col0 + bj * 128 + 4 * n) : (f32x4){0.f, 0.f, 0.f, 0.f};
        const bool act = (t == 0 || t == 3 || t == 7);
#pragma unroll
        for (int ai = 0; ai < 2; ++ai)
#pragma unroll
            for (int m = 0; m < 4; ++m) {
                const size_t ro = (size_t)(row0 + ai * 128 + m * 16) * HW + col0;
#pragma unroll
                for (int bj = 0; bj < 2; ++bj) { if (bj >= nbj) continue;
                    f32x4 v[2] = {acc[ai][bj][m][0], acc[ai][bj][m][1]};
                    if (act) {
#pragma unroll
                        for (int n = 0; n < 2; ++n)
#pragma unroll
                            for (int j = 0; j < 4; ++j) v[n][j] = silu_f(v[n][j]);
                    } else if (t == 1) {
#pragma unroll
                        for (int n = 0; n < 2; ++n) {
                            f32x4 gg;
#pragma unroll
                            for (int j = 0; j < 4; ++j) { const float z = fmaxf(v[n][j], -80.f), lb = lbv[bj][n][j]; const float e = ex2(-z * LOG2E), s = rcpf_(1.f + e);
                                const float f = lb + (1.f - lb) * s; gg[j] = lg2(f) * 0.6931471805599453f; v[n][j] = (1.f - lb) * (e * s); }
                            *(f32x4*)(G + ro + bj * 128 + 4 * n) = gg;
                        }
                    }
                    if (fo) { *(f32x4*)(fo + ro + bj * 128) = v[0]; *(f32x4*)(fo + ro + bj * 128 + 4) = v[1]; }
                    v4u w; w.x = cvtpk(v[0][0], v[0][1]); w.y = cvtpk(v[0][2], v[0][3]); w.z = cvtpk(v[1][0], v[1][1]); w.w = cvtpk(v[1][2], v[1][3]);
                    *(v4u*)(dst + ro + bj * 128) = w;
                }
            }
    }
};
struct Epi3 {
    static constexpr bool PERM = true, AFTER_DRAIN = false;
    bf16_t* P; const unsigned long long* RS; float* FL; const float* bfg; float* out;
    __device__ __forceinline__ void operator()(const f32x4 (&acc)[2][2][4][2], const Unit& u, int wr, int wc, int fr, int fq) const {
        const int t = u.pn >> 4;
        const int row0 = u.pm * 256 + wr * 64 + fr, col0 = (u.pn & 15) * 256 + wc * 32 + 8 * fq + (u.hf > 0 ? 128 : 0);
        const int nbj = (u.hf >= 0) ? 1 : 2;
        const bool smp = u.pm >= 32;
        if (t == 4) {
            if (wc != 0) return;
            float* fo = out + (smp ? O_CFS : O_CFP) - (smp ? (size_t)TP * 32 : (size_t)0);
            const f32x4 b0 = *(const f32x4*)(bfg + 8 * fq), b1 = *(const f32x4*)(bfg + 8 * fq + 4);
#pragma unroll
            for (int ai = 0; ai < 2; ++ai)
#pragma unroll
                for (int m = 0; m < 4; ++m) {
                    const int row = row0 + ai * 128 + m * 16;
                    const float r = rsqrtf((float)RS[row] * (1.f / (FIX * 4096.f)) + EPS);
                    f32x4 v[2] = {acc[ai][0][m][0] * r + b0, acc[ai][0][m][1] * r + b1};
#pragma unroll
                    for (int n = 0; n < 2; ++n)
#pragma unroll
                        for (int j = 0; j < 4; ++j) { const float x = v[n][j]; v[n][j] = fminf(x, 0.f) - log1pf(__expf(-fabsf(x))); }
                    *(f32x4*)(FL + (size_t)row * 32 + 8 * fq) = v[0]; *(f32x4*)(FL + (size_t)row * 32 + 8 * fq + 4) = v[1];
                    *(f32x4*)(fo + (size_t)row * 32 + 8 * fq) = v[0]; *(f32x4*)(fo + (size_t)row * 32 + 8 * fq + 4) = v[1];
                }
            return;
        }
        bf16_t* dst = P + (size_t)t * PSTR3;
        float* fo = nullptr;
        if (t == 1 || t == 2) fo = out + (t == 1 ? (smp ? O_CKS : O_CKP) : (smp ? O_CVS : O_CVP)) - (smp ? (size_t)TP * DM : (size_t)0);
#pragma unroll
        for (int ai = 0; ai < 2; ++ai)
#pragma unroll
            for (int m = 0; m < 4; ++m) {
                const int row = row0 + ai * 128 + m * 16;
                const float r = rsqrtf((float)RS[row] * (1.f / (FIX * 4096.f)) + EPS);
                const size_t ro = (size_t)row * DM + col0;
#pragma unroll
                for (int bj = 0; bj < 2; ++bj) { if (bj >= nbj) continue;
                    f32x4 v[2] = {acc[ai][bj][m][0] * r, acc[ai][bj][m][1] * r};
                    if (t == 3) {
#pragma unroll
                        for (int n = 0; n < 2; ++n)
#pragma unroll
                            for (int j = 0; j < 4; ++j) v[n][j] = silu_f(v[n][j]);
                    }
                    if (fo) { *(f32x4*)(fo + ro + bj * 128) = v[0]; *(f32x4*)(fo + ro + bj * 128 + 4) = v[1]; }
                    v4u w; w.x = cvtpk(v[0][0], v[0][1]); w.y = cvtpk(v[0][2], v[0][3]); w.z = cvtpk(v[1][0], v[1][1]); w.w = cvtpk(v[1][2], v[1][3]);
                    *(v4u*)(dst + ro + bj * 128) = w;
                }
            }
    }
};
template <bool XN_> struct EpiRes {
    static constexpr bool PERM = true, AFTER_DRAIN = false;
    const float* resP; const float* resS;
    float* H; bf16_t* XN; const float* nw; unsigned long long* RS;
    __device__ __forceinline__ void operator()(const f32x4 (&acc)[2][2][4][2], const Unit& u, int wr, int wc, int fr, int fq) const {
        const int row0 = u.pm * 256 + wr * 64 + fr, col0 = u.pn * 256 + wc * 32 + 8 * fq + (u.hf > 0 ? 128 : 0);
        const int nbj = (u.hf >= 0) ? 1 : 2;
        const float* res = (u.pm >= 32) ? resS - (size_t)TP * DM : resP;
        f32x4 wv[2][2];
#pragma unroll
        for (int bj = 0; bj < 2; ++bj)
#pragma unroll
            for (int n = 0; n < 2; ++n) wv[bj][n] = (XN_ && bj < nbj) ? *(const f32x4*)(nw + col0 + bj * 128 + 4 * n) : (f32x4){0.f, 0.f, 0.f, 0.f};
#pragma unroll
        for (int ai = 0; ai < 2; ++ai)
#pragma unroll
            for (int m = 0; m < 4; ++m) {
                const int row = row0 + ai * 128 + m * 16;
                const size_t ro = (size_t)row * DM + col0;
                float ss = 0.f;
#pragma unroll
                for (int bj = 0; bj < 2; ++bj) { if (bj >= nbj) continue;
                    f32x4 v[2];
#pragma unroll
                    for (int n = 0; n < 2; ++n) { v[n] = acc[ai][bj][m][n] + *(const f32x4*)(res + ro + bj * 128 + 4 * n); ss += (v[n][0] * v[n][0] + v[n][1] * v[n][1]) + (v[n][2] * v[n][2] + v[n][3] * v[n][3]); }
                    *(f32x4*)(H + ro + bj * 128) = v[0]; *(f32x4*)(H + ro + bj * 128 + 4) = v[1];
                    if (XN_) { v[0] = v[0] * wv[bj][0]; v[1] = v[1] * wv[bj][1];
                        v4u w; w.x = cvtpk(v[0][0], v[0][1]); w.y = cvtpk(v[0][2], v[0][3]); w.z = cvtpk(v[1][0], v[1][1]); w.w = cvtpk(v[1][2], v[1][3]);
                        *(v4u*)(XN + ro + bj * 128) = w; }
                }
                ss += __shfl_xor(ss, 16); ss += __shfl_xor(ss, 32);
                if (fq == 0) atomicAdd(RS + row, (unsigned long long)__float2ull_rn(ss * FIX));
            }
    }
};

template <int E>
__device__ __forceinline__ void wg_scan(float (&vals)[E], LAS float* scr, int tid, int wid, int lane) {
    float run = 0.f;
#pragma unroll
    for (int j = 0; j < E; ++j) { run += vals[j]; vals[j] = run; }
    float inc = run;
#pragma unroll
    for (int o = 1; o < 64; o <<= 1) { const float t = __shfl_up(inc, o); if (lane >= o) inc += t; }
    if (lane == 63) scr[wid] = inc;
    __syncthreads();
    float woff = 0.f;
#pragma unroll
    for (int w = 0; w < 8; ++w) woff += (w < wid) ? scr[w] : 0.f;
    const float offs = woff + (inc - run);
#pragma unroll
    for (int j = 0; j < E; ++j) vals[j] += offs;
    __syncthreads();
}


__device__ __forceinline__ unsigned f2bf(float f) { unsigned u = __builtin_bit_cast(unsigned, f); return (u + 0x7fffu + ((u >> 16) & 1u)) >> 16; }
__device__ __forceinline__ unsigned pk2(float lo, float hi) { return f2bf(lo) | (f2bf(hi) << 16); }
__device__ __forceinline__ void p0_transpose_item(const float* W, int K, int N, bf16_t* WT, LAS float* scr, int item, int lane) {
    const int nblk = N / 32, kb = item / nblk, nb = item % nblk, k0 = 64 * kb, n0 = 32 * nb;
#pragma unroll 8
    for (int i = 0; i < 32; ++i) { const int kk = 2 * i + (lane >> 5); scr[kk * 33 + (lane & 31)] = W[(size_t)(k0 + kk) * N + n0 + (lane & 31)]; }
    LDS_WAIT(); asm volatile("" ::: "memory");
    const int c = lane & 7;
#pragma unroll
    for (int j = 0; j < 4; ++j) { const int n = (lane >> 3) + 8 * j; const LAS float* s = scr + (8 * c) * 33 + n;
        v4u o; o.x = pk2(s[0 * 33], s[1 * 33]); o.y = pk2(s[2 * 33], s[3 * 33]); o.z = pk2(s[4 * 33], s[5 * 33]); o.w = pk2(s[6 * 33], s[7 * 33]);
        *(v4u*)(WT + (size_t)(n0 + n) * K + k0 + 8 * c) = o; }
    LDS_WAIT(); asm volatile("" ::: "memory");
}
__device__ __forceinline__ void p0_transpose_item64(const float* W, int K, int N, bf16_t* WT, LAS float* scr, int item, int lane) {
    const int nblk = N / 64, kb = item / nblk, nb = item % nblk, k0 = 64 * kb, n0 = 64 * nb;
    const int r4 = lane >> 4, g4 = lane & 15;
    f32x4 v[16];
#pragma unroll
    for (int i = 0; i < 16; ++i) v[i] = *(const f32x4*)(W + (size_t)(k0 + 4 * i + r4) * N + n0 + 4 * g4);
#pragma unroll
    for (int i = 0; i < 16; ++i) { const int kk = 4 * i + r4; *(LAS f32x4*)(scr + kk * 64 + ((g4 ^ (kk >> 3)) << 2)) = v[i]; }
    LDS_WAIT(); asm volatile("" ::: "memory");
    const int c = lane & 7;
#pragma unroll
    for (int j = 0; j < 8; ++j) { const int n = (lane >> 3) + 8 * j; const LAS float* s = scr + (8 * c) * 64 + ((((n >> 2) ^ c)) << 2) + (n & 3);
        v4u o; o.x = cvtpk(s[0 * 64], s[1 * 64]); o.y = cvtpk(s[2 * 64], s[3 * 64]); o.z = cvtpk(s[4 * 64], s[5 * 64]); o.w = cvtpk(s[6 * 64], s[7 * 64]);
        *(v4u*)(WT + (size_t)(n0 + n) * K + k0 + 8 * c) = o; }
    LDS_WAIT(); asm volatile("" ::: "memory");
}
__device__ __forceinline__ void norm_row_to_bf16(const float* xrow, const float* w, bf16_t* orow, int lane) {
    const f32x4* xr = (const f32x4*)xrow + lane;
    f32x4 v[16]; float s = 0.f;
#pragma unroll
    for (int j = 0; j < 16; ++j) { v[j] = xr[64 * j]; s += (v[j].x * v[j].x + v[j].y * v[j].y) + (v[j].z * v[j].z + v[j].w * v[j].w); }
    const float r = rsqrtf(wave_sum(s) * (1.f / DM) + EPS);
    const f32x4* wr_ = (const f32x4*)w + lane;
    v2u* o8 = (v2u*)orow + lane;
#pragma unroll
    for (int j = 0; j < 16; ++j) { const f32x4 ww = wr_[64 * j]; v2u o; o.x = cvtpk(v[j].x * r * ww.x, v[j].y * r * ww.y); o.y = cvtpk(v[j].z * r * ww.z, v[j].w * r * ww.w); o8[64 * j] = o; }
}

#define DBG_FLAG(cond, bit) do { if (dbg && __any(cond)) { if ((threadIdx.x & 63) == 0) atomicOr(dbg, 1u << (bit)); } } while (0)
__device__ __forceinline__ bool nonfin(float v) { return (__float_as_uint(v) & 0x7f800000u) == 0x7f800000u; }
__device__ __forceinline__ void attn_pv(const LAS unsigned char* Vt, int blk, const bf16x8 (&pk)[2], f32x16 (&o)[4], int lane) {
    const unsigned h = (unsigned)lane >> 5, q4 = (lane & 15) >> 2, pp = lane & 3, bc = (lane >> 4) & 1;
#pragma unroll
    for (int ks = 0; ks < 2; ++ks) {
        const unsigned row0 = 32u * blk + 16u * ks + 4u * h + q4, row1 = row0 + 8u;
        const unsigned x0 = (q4 << 2) | (h & 3u), x1 = (q4 << 2) | ((h + 2u) & 3u);
#pragma unroll
        for (int c = 0; c < 4; ++c) {
            const unsigned chn = 4u * c + 2u * bc + (pp >> 1);
            const s16x4 lo = __builtin_amdgcn_ds_read_tr16_b64_v4i16((LAS s16x4*)(Vt + 256u * row0 + 16u * (chn ^ x0) + 8u * (pp & 1)));
            const s16x4 hi = __builtin_amdgcn_ds_read_tr16_b64_v4i16((LAS s16x4*)(Vt + 256u * row1 + 16u * (chn ^ x1) + 8u * (pp & 1)));
            const bf16x8 a = {lo[0], lo[1], lo[2], lo[3], hi[0], hi[1], hi[2], hi[3]};
            o[c] = __builtin_amdgcn_mfma_f32_32x32x16_bf16(a, pk[ks], o[c], 0, 0, 0);
        }
    }
}
__device__ __forceinline__ void attn_v_load(const LAS unsigned char* Vt, int blk, s16x4 (&vl)[8], s16x4 (&vh)[8], int lane) {
    const unsigned h = (unsigned)lane >> 5, q4 = (lane & 15) >> 2, pp = lane & 3, bc = (lane >> 4) & 1;
#pragma unroll
    for (int ks = 0; ks < 2; ++ks) {
        const unsigned row0 = 32u * blk + 16u * ks + 4u * h + q4, row1 = row0 + 8u;
        const unsigned x0 = (q4 << 2) | (h & 3u), x1 = (q4 << 2) | ((h + 2u) & 3u);
#pragma unroll
        for (int c = 0; c < 4; ++c) {
            const unsigned chn = 4u * c + 2u * bc + (pp >> 1);
            vl[4 * ks + c] = __builtin_amdgcn_ds_read_tr16_b64_v4i16((LAS s16x4*)(Vt + 256u * row0 + 16u * (chn ^ x0) + 8u * (pp & 1)));
            vh[4 * ks + c] = __builtin_amdgcn_ds_read_tr16_b64_v4i16((LAS s16x4*)(Vt + 256u * row1 + 16u * (chn ^ x1) + 8u * (pp & 1)));
        }
    }
}
__device__ __forceinline__ void attn_v_mma(const s16x4 (&vl)[8], const s16x4 (&vh)[8], const bf16x8 (&pk)[2], f32x16 (&o)[4]) {
#pragma unroll
    for (int ks = 0; ks < 2; ++ks)
#pragma unroll
        for (int c = 0; c < 4; ++c) { const s16x4 lo = vl[4 * ks + c], hi = vh[4 * ks + c];
            const bf16x8 a = {lo[0], lo[1], lo[2], lo[3], hi[0], hi[1], hi[2], hi[3]};
            o[c] = __builtin_amdgcn_mfma_f32_32x32x16_bf16(a, pk[ks], o[c], 0, 0, 0); }
}
template <int MODE, bool FK_LDS = false>
__device__ __forceinline__ void attn_block(const LAS unsigned char* Kt, const LAS unsigned char* Vt, int blk, const bf16x8 (&qf)[8], f32x16 (&o)[4],
                                           float& m, float& l, float& carry, int key0, int qpos, float fq2, const float* fk, int lane, unsigned* dbg = nullptr, const LAS float* fkl = nullptr, bool need_mask = true) {
    const int r32 = lane & 31, h = lane >> 5;
    f32x16 p = {};
    {
        const unsigned krow = 32u * blk + r32, kx = ((krow & 3u) << 2) | ((krow >> 2) & 3u);
        const LAS unsigned char* kb = Kt + 256u * krow;
        __builtin_amdgcn_s_setprio(1);
#pragma unroll
        for (int s = 0; s < 8; ++s) { const bf16x8 a = *(const LAS bf16x8*)(kb + 16u * ((unsigned)(2 * s + h) ^ kx)); p = __builtin_amdgcn_mfma_f32_32x32x16_bf16(a, qf[s], p, 0, 0, 0); }
        __builtin_amdgcn_s_setprio(0);
    }
    { bool bad = false;
#pragma unroll
      for (int r = 0; r < 16; ++r) bad |= nonfin(p[r]);
      DBG_FLAG(bad, 1); }
    float x[16];
    if (MODE == 1) {
        f32x4 nf[4];
#pragma unroll
        for (int g = 0; g < 4; ++g) nf[g] = FK_LDS ? *(const LAS f32x4*)(fkl + 8 * g + 4 * h) : *(const f32x4*)(fk + 8 * g + 4 * h);
        f32x2 xv[8];
#pragma unroll
        for (int i = 0; i < 8; ++i) { const f32x2 pp = {p[2 * i], p[2 * i + 1]}, nn = {nf[i >> 1][2 * (i & 1)], nf[i >> 1][2 * (i & 1) + 1]}; xv[i] = (pp + nn) * QK2; }
        if (need_mask) {
#pragma unroll
            for (int i = 0; i < 8; ++i) { const int key = key0 + ((2 * i) & 3) + 8 * ((2 * i) >> 2) + 4 * h;
                xv[i].x = (key > qpos) ? -__builtin_inff() : xv[i].x; xv[i].y = (key + 1 > qpos) ? -__builtin_inff() : xv[i].y; }
        }
        float bm = fmaxf(xv[0].x, xv[0].y);
#pragma unroll
        for (int i = 1; i < 8; ++i) bm = fmaxf(bm, fmaxf(xv[i].x, xv[i].y));
        { auto rr = __builtin_amdgcn_permlane32_swap(__float_as_uint(bm), __float_as_uint(bm), false, false); bm = fmaxf(__uint_as_float(rr[0]), __uint_as_float(rr[1])); }
        const float mn = fmaxf(m, bm), alpha = ex2(m - mn); m = mn;
        f32x2 ls2 = {0.f, 0.f};
#pragma unroll
        for (int i = 0; i < 8; ++i) { f32x2 e = xv[i] - mn; e.x = ex2(e.x); e.y = ex2(e.y); ls2 += e; x[2 * i] = e.x; x[2 * i + 1] = e.y; }
        float ls = ls2.x + ls2.y;
        { auto rr = __builtin_amdgcn_permlane32_swap(__float_as_uint(ls), __float_as_uint(ls), false, false); ls = __uint_as_float(rr[0]) + __uint_as_float(rr[1]); }
        l = l * alpha + ls;
        if (__any(alpha != 1.f)) {
#pragma unroll
            for (int c = 0; c < 4; ++c)
#pragma unroll
                for (int r = 0; r < 16; ++r) o[c][r] *= alpha;
        }
    } else {
        float lm[16];
#pragma unroll
        for (int r = 0; r < 16; ++r) { const int key = key0 + (r & 3) + 8 * (r >> 2) + 4 * h; const float z2 = p[r] * QK2, e = ex2(-fabsf(z2)), sp = fmaxf(z2, 0.f) + lg2(1.f + e);
            const bool valid = key < qpos; lm[r] = valid ? -sp : 0.f; x[r] = valid ? (z2 - sp) : -__builtin_inff(); }
        float gs0 = (lm[0] + lm[1]) + (lm[2] + lm[3]), gs1 = (lm[4] + lm[5]) + (lm[6] + lm[7]), gs2 = (lm[8] + lm[9]) + (lm[10] + lm[11]), gs3 = (lm[12] + lm[13]) + (lm[14] + lm[15]);
        float a0, b0, a1, b1, a2, b2, a3, b3;
        { auto rr = __builtin_amdgcn_permlane32_swap(__float_as_uint(gs0), __float_as_uint(gs0), false, false); a0 = __uint_as_float(rr[0]); b0 = __uint_as_float(rr[1]); }
        { auto rr = __builtin_amdgcn_permlane32_swap(__float_as_uint(gs1), __float_as_uint(gs1), false, false); a1 = __uint_as_float(rr[0]); b1 = __uint_as_float(rr[1]); }
        { auto rr = __builtin_amdgcn_permlane32_swap(__float_as_uint(gs2), __float_as_uint(gs2), false, false); a2 = __uint_as_float(rr[0]); b2 = __uint_as_float(rr[1]); }
        { auto rr = __builtin_amdgcn_permlane32_swap(__float_as_uint(gs3), __float_as_uint(gs3), false, false); a3 = __uint_as_float(rr[0]); b3 = __uint_as_float(rr[1]); }
        const float T7 = 0.f, T6 = b3, T5 = T6 + a3, T4 = T5 + b2, T3 = T4 + a2, T2 = T3 + b1, T1 = T2 + a1, T0 = T1 + b0;
        const float total = T0 + a0;
        const float tb0 = carry + (h ? T1 : T0), tb1 = carry + (h ? T3 : T2), tb2 = carry + (h ? T5 : T4), tb3 = carry + (h ? T7 : T6);
#define SB_GRP(g, tb) do { const float t3 = (tb), t2 = t3 + lm[4 * (g) + 3], t1 = t2 + lm[4 * (g) + 2], t0 = t1 + lm[4 * (g) + 1]; \
            x[4 * (g) + 3] = ex2(x[4 * (g) + 3] + t3); x[4 * (g) + 2] = ex2(x[4 * (g) + 2] + t2); x[4 * (g) + 1] = ex2(x[4 * (g) + 1] + t1); x[4 * (g)] = ex2(x[4 * (g)] + t0); } while (0)
        SB_GRP(0, tb0); SB_GRP(1, tb1); SB_GRP(2, tb2); SB_GRP(3, tb3);
#undef SB_GRP
        carry += total;
        { bool bad = false;
#pragma unroll
          for (int r = 0; r < 16; ++r) bad |= nonfin(x[r]);
          DBG_FLAG(bad, 2); DBG_FLAG(nonfin(carry), 3); }
    }
    bf16x8 pk[2];
#pragma unroll
    for (int ks = 0; ks < 2; ++ks) { v4u w; w.x = cvtpk(x[8 * ks], x[8 * ks + 1]); w.y = cvtpk(x[8 * ks + 2], x[8 * ks + 3]); w.z = cvtpk(x[8 * ks + 4], x[8 * ks + 5]); w.w = cvtpk(x[8 * ks + 6], x[8 * ks + 7]); pk[ks] = __builtin_bit_cast(bf16x8, w); }
    __builtin_amdgcn_s_setprio(1);
    attn_pv(Vt, blk, pk, o, lane);
    __builtin_amdgcn_s_setprio(0);
}

__device__ __forceinline__ float vmax3(float a, float b, float c) { float r; asm("v_max3_f32 %0, %1, %2, %3" : "=v"(r) : "v"(a), "v"(b), "v"(c)); return r; }
__device__ __forceinline__ void attn_tile64_fox(const LAS unsigned char* Kt, const LAS unsigned char* Vt, const bf16x8 (&qf)[8], f32x16 (&o)[4], float& m, float& l, int lane, const LAS float* fkl) {
    const int r32 = lane & 31, h = lane >> 5;
    f32x16 p1, p0;
#pragma unroll
    for (int g = 0; g < 4; ++g) { const f32x4 n1 = *(const LAS f32x4*)(fkl + 32 + 8 * g + 4 * h), n0 = *(const LAS f32x4*)(fkl + 8 * g + 4 * h);
#pragma unroll
        for (int j = 0; j < 4; ++j) { p1[4 * g + j] = n1[j]; p0[4 * g + j] = n0[j]; } }
    {
        const unsigned kx = ((r32 & 3u) << 2) | ((r32 >> 2) & 3u);
        const LAS unsigned char* kb = Kt + 256u * r32;
#pragma unroll
        for (int s = 0; s < 8; ++s) { const unsigned co = 16u * ((unsigned)(2 * s + h) ^ kx);
            const bf16x8 a1 = *(const LAS bf16x8*)(kb + 8192u + co), a0 = *(const LAS bf16x8*)(kb + co);
            p1 = __builtin_amdgcn_mfma_f32_32x32x16_bf16(a1, qf[s], p1, 0, 0, 0); p0 = __builtin_amdgcn_mfma_f32_32x32x16_bf16(a0, qf[s], p0, 0, 0, 0); }
    }
    s16x4 fl[4], fh[4];
    int lv = lane; asm volatile("" : "+v"(lv));
    const unsigned vh_ = ((unsigned)lv >> 5) & 1u, vq4 = (lv & 15) >> 2, vpp = lv & 3, vbc = (lv >> 4) & 1;
#define VLD(blk_, ks_, c_) do { const unsigned row0_ = 32u * (blk_) + 16u * (ks_) + 4u * vh_ + vq4, x0_ = (vq4 << 2) | (vh_ & 3u), x1_ = (vq4 << 2) | ((vh_ + 2u) & 3u), chn_ = 4u * (c_) + 2u * vbc + (vpp >> 1); \
        fl[c_] = __builtin_amdgcn_ds_read_tr16_b64_v4i16((LAS s16x4*)(Vt + 256u * row0_ + 16u * (chn_ ^ x0_) + 8u * (vpp & 1))); \
        fh[c_] = __builtin_amdgcn_ds_read_tr16_b64_v4i16((LAS s16x4*)(Vt + 256u * (row0_ + 8u) + 16u * (chn_ ^ x1_) + 8u * (vpp & 1))); } while (0)
#define VMMA(c_, pk_) do { const bf16x8 a_ = {fl[c_][0], fl[c_][1], fl[c_][2], fl[c_][3], fh[c_][0], fh[c_][1], fh[c_][2], fh[c_][3]}; o[c_] = __builtin_amdgcn_mfma_f32_32x32x16_bf16(a_, pk_, o[c_], 0, 0, 0); } while (0)
    VLD(1, 0, 0); VLD(1, 0, 1); VLD(1, 0, 2); VLD(1, 0, 3);
    __builtin_amdgcn_sched_barrier(0);
    float bmA = vmax3(p1[0], p1[1], p1[2]), bmB = vmax3(p0[0], p0[1], p0[2]);
#pragma unroll
    for (int i = 3; i < 15; i += 2) { bmA = vmax3(bmA, p1[i], p1[i + 1]); bmB = vmax3(bmB, p0[i], p0[i + 1]); }
    float bm = vmax3(bmA, bmB, p1[15]); bm = fmaxf(bm, p0[15]);
    { auto rr = __builtin_amdgcn_permlane32_swap(__float_as_uint(bm), __float_as_uint(bm), false, false); bm = fmaxf(__uint_as_float(rr[0]), __uint_as_float(rr[1])) * QK2; }
    const float mn = fmaxf(m, bm), alpha = ex2(m - mn); m = mn;
    if (__any(alpha != 1.f)) {
#pragma unroll
        for (int c = 0; c < 4; ++c)
#pragma unroll
            for (int r = 0; r < 16; ++r) o[c][r] *= alpha;
    }
    f32x2 ls2 = {0.f, 0.f};
    bf16x8 pk1[2], pk0[2];
    { v4u w[2];
#pragma unroll
      for (int i = 0; i < 8; ++i) { f32x2 e = (f32x2){p1[2 * i], p1[2 * i + 1]} * QK2 - mn; e.x = ex2(e.x); e.y = ex2(e.y); ls2 += e; w[i >> 2][i & 3] = cvtpk(e.x, e.y); }
      pk1[0] = __builtin_bit_cast(bf16x8, w[0]); pk1[1] = __builtin_bit_cast(bf16x8, w[1]); }
    __builtin_amdgcn_sched_barrier(0);
#define VSTEP(c_, pk_, nb_, nk_) do { VMMA(c_, pk_); VLD(nb_, nk_, c_); __builtin_amdgcn_sched_barrier(0); } while (0)
#define VSTEPF(c_, pk_, nb_, nk_) do { VMMA(c_, pk_); VLD(nb_, nk_, c_); } while (0)
    VSTEPF(0, pk1[0], 1, 1); VSTEPF(1, pk1[0], 1, 1); VSTEPF(2, pk1[0], 1, 1); VSTEPF(3, pk1[0], 1, 1);
    VSTEPF(0, pk1[1], 0, 0); VSTEPF(1, pk1[1], 0, 0); VSTEPF(2, pk1[1], 0, 0); VSTEPF(3, pk1[1], 0, 0);
    { v4u w[2];
#pragma unroll
      for (int i = 0; i < 8; ++i) { f32x2 e = (f32x2){p0[2 * i], p0[2 * i + 1]} * QK2 - mn; e.x = ex2(e.x); e.y = ex2(e.y); ls2 += e; w[i >> 2][i & 3] = cvtpk(e.x, e.y); }
      pk0[0] = __builtin_bit_cast(bf16x8, w[0]); pk0[1] = __builtin_bit_cast(bf16x8, w[1]); }
#pragma unroll
    for (int i = 0; i < 8; ++i) { __builtin_amdgcn_sched_group_barrier(0x008, 1, 0); __builtin_amdgcn_sched_group_barrier(0x100, 2, 0); __builtin_amdgcn_sched_group_barrier(0x402, 6, 0); }
    __builtin_amdgcn_sched_barrier(0);
    VSTEP(0, pk0[0], 0, 1); VSTEP(1, pk0[0], 0, 1); VSTEP(2, pk0[0], 0, 1); VSTEP(3, pk0[0], 0, 1);
    VMMA(0, pk0[1]); VMMA(1, pk0[1]); VMMA(2, pk0[1]); VMMA(3, pk0[1]);
#undef VSTEP
#undef VSTEPF
#undef VMMA
#undef VLD
    float ls = ls2.x + ls2.y;
    { auto rr = __builtin_amdgcn_permlane32_swap(__float_as_uint(ls), __float_as_uint(ls), false, false); ls = __uint_as_float(rr[0]) + __uint_as_float(rr[1]); }
    l = l * alpha + ls;
}

template <int MODE>
__device__ __forceinline__ void attn_prompt_unit(LAS unsigned char* lds, const bf16_t* Qb, const bf16_t* Kb, const bf16_t* Vb, const bf16_t* Gate, int ld, int hd, int qb,
                                                 bf16_t* Out, int ocol0, const float* FCh, int tid, int wid, int lane, float kn2 = 0.f  ) {
    asm volatile("" : "+v"(tid)); lane = tid & 63;
    const int r32 = lane & 31, h = lane >> 5;
    const int qlo = qb * 256 + wid * 32, qrow = qlo + r32;
    bf16x8 qf[8];
    { const bf16_t* qp = Qb + (size_t)qrow * ld + hd * HD + 8 * h;
#pragma unroll
      for (int s = 0; s < 8; ++s) qf[s] = *(const bf16x8*)(qp + 16 * s); }
    f32x16 o[4] = {};
    float m = -1e30f, l = 0.f, carry = 0.f;
    const float fq2 = MODE ? FCh[qrow] : 0.f;
    float qnk = 0.f;
    if (MODE == 1) { float s2 = 0.f;
#pragma unroll
        for (int s = 0; s < 8; ++s)
#pragma unroll
            for (int e = 0; e < 8; ++e) { const float qv = bf2f((unsigned short)qf[s][e]); s2 += qv * qv; }
        { auto rr = __builtin_amdgcn_permlane32_swap(__float_as_uint(s2), __float_as_uint(s2), false, false); s2 = __uint_as_float(rr[0]) + __uint_as_float(rr[1]); }
        qnk = sqrtf(s2) * kn2; }
    LAS float* Fl = (LAS float*)(lds + 65536 + 128);
    float sf = 0.f;
    volatile LAS int* flags = (volatile LAS int*)(lds + 65536);
    const int ktop = 4 * qb + 3;
    const int srow = tid >> 4, sch = tid & 15;
    const bf16_t* kg = Kb + (size_t)srow * ld + hd * HD + sch * 8;
    const bf16_t* vg = Vb + (size_t)srow * ld + hd * HD + sch * 8;
    const unsigned so0 = off_b(srow, sch), so1 = off_b(srow + 32, sch);
    v4u sk0, sk1, sv0, sv1;
#define AP_ISSUE(kt) do { if (MODE == 1 && tid < 64) sf = FCh[(kt) * 64 + tid]; const size_t go = (size_t)(kt) * 64 * ld; sk0 = *(const v4u*)(kg + go); sk1 = *(const v4u*)(kg + go + (size_t)32 * ld); sv0 = *(const v4u*)(vg + go); sv1 = *(const v4u*)(vg + go + (size_t)32 * ld); } while (0)
#define AP_WRITE(b) do { if (MODE == 1 && tid < 64) Fl[(b) * 64 + tid] = sf; LAS unsigned char* kb_ = lds + (b) * 32768; *(LAS v4u*)(kb_ + so0) = sk0; *(LAS v4u*)(kb_ + so1) = sk1; *(LAS v4u*)(kb_ + 16384 + so0) = sv0; *(LAS v4u*)(kb_ + 16384 + so1) = sv1; } while (0)
    if (tid < 16) flags[tid] = 0;
    int cur = 0, it = 0; bool wdone = false;
    AP_ISSUE(ktop);
    for (int kt = ktop; kt >= 0; --kt, ++it) {
        AP_WRITE(cur);
        __syncthreads();
        if (it > 0) { const volatile LAS int* f = flags + ((it - 1) & 1) * 8; int all = 1;
#pragma unroll
            for (int w = 0; w < 8; ++w) all &= f[w];
            if (all) break; }
        if (kt > 0) AP_ISSUE(kt - 1);
        if (!wdone) {
#pragma unroll
            for (int blk = 1; blk >= 0; --blk) {
                const int key0 = kt * 64 + blk * 32;
                if (key0 > qlo + 31) continue;
                attn_block<MODE, MODE == 1>(lds + cur * 32768, lds + cur * 32768 + 16384, blk, qf, o, m, l, carry, key0, qrow, fq2, nullptr, lane, nullptr, Fl + cur * 64 + blk * 32, key0 + 31 > qlo);
            }
            if (MODE == 0) wdone = __all(carry < -136.f);
            else wdone = __all(m > -1e29f && qnk + Fl[cur * 64] * QK2 < m - 136.f);
        }
        if (lane == 0) flags[(it & 1) * 8 + wid] = wdone ? 1 : 0;
        cur ^= 1;
    }
#undef AP_ISSUE
#undef AP_WRITE
    const float inv = MODE ? 1.f / l : 1.f;
    const bf16_t* gp = Gate + (size_t)qrow * ld + hd * HD + 4 * h;
    bf16_t* op = Out + (size_t)qrow * DM + ocol0 + 4 * h;
#pragma unroll
    for (int c = 0; c < 4; ++c)
#pragma unroll
        for (int g = 0; g < 4; ++g) { const v2u gw = *(const v2u*)(gp + 32 * c + 8 * g);
            v2u w; w.x = cvtpk(o[c][4 * g] * inv * bflo(gw.x), o[c][4 * g + 1] * inv * bfhi(gw.x)); w.y = cvtpk(o[c][4 * g + 2] * inv * bflo(gw.y), o[c][4 * g + 3] * inv * bfhi(gw.y));
            *(v2u*)(op + 32 * c + 8 * g) = w; }
    __syncthreads();
}

struct GBar { volatile LAS unsigned* cnt; unsigned tgt; };
__device__ __forceinline__ void gbar_sync(GBar& g, int lane) {
    g.tgt += 4u;
    asm volatile("s_waitcnt lgkmcnt(0)" ::: "memory");
    if (lane == 0) __hip_atomic_fetch_add((LAS unsigned*)g.cnt, 1u, __ATOMIC_RELAXED, __HIP_MEMORY_SCOPE_WORKGROUP);
    while ((int)(__hip_atomic_load((LAS unsigned*)g.cnt, __ATOMIC_RELAXED, __HIP_MEMORY_SCOPE_WORKGROUP) - g.tgt) < 0) __builtin_amdgcn_s_sleep(1);
    asm volatile("" ::: "memory");
}
template <int MODE>
__device__ __forceinline__ void attn_prompt_group(LAS unsigned char* gl, LAS unsigned char* gx, GBar& gb, const bf16_t* Qb, const bf16_t* Kb, const bf16_t* Vb, const bf16_t* Gate, int ld, int hd, int qb,
                                                  bf16_t* Out, int ocol0, const float* FCh, int gtid, int gw, float kn2) {
    asm volatile("" : "+v"(gtid)); const int lane = gtid & 63;
    const int r32 = lane & 31, h = lane >> 5;
    const int qlo = qb * 128 + gw * 32, qrow = qlo + r32;
    bf16x8 qf[8];
    { const bf16_t* qp = Qb + (size_t)qrow * ld + hd * HD + 8 * h;
#pragma unroll
      for (int s = 0; s < 8; ++s) qf[s] = *(const bf16x8*)(qp + 16 * s); }
    f32x16 o[4] = {};
    float m = -1e30f, l = 0.f, carry = 0.f;
    float qnk = 0.f;
    if (MODE == 1) { float s2 = 0.f;
#pragma unroll
        for (int s = 0; s < 8; ++s)
#pragma unroll
            for (int e = 0; e < 8; ++e) { const float qv = bf2f((unsigned short)qf[s][e]); s2 += qv * qv; }
        { auto rr = __builtin_amdgcn_permlane32_swap(__float_as_uint(s2), __float_as_uint(s2), false, false); s2 = __uint_as_float(rr[0]) + __uint_as_float(rr[1]); }
        qnk = sqrtf(s2) * kn2; }
    LAS float* Fl = (LAS float*)(gx + 128);
    volatile LAS int* flags = (volatile LAS int*)gx;
    const int ktop = 2 * qb + 1;
#define AG_DMA(kt, b) do { const size_t go_ = (size_t)(kt) * 64 * ld * 2; LAS unsigned char* kb_ = gl + (b) * 32768 + gw * 4096; int l_ = gtid; asm volatile("" : "+v"(l_)); l_ &= 63; unsigned voff[4]; \
        _Pragma("unroll") for (int i_ = 0; i_ < 4; ++i_) { const int row_ = 16 * gw + 4 * i_ + (l_ >> 4), ch_ = (l_ & 15) ^ ((((l_ >> 4) & 3) << 2) | i_); voff[i_] = (unsigned)((row_ * ld + hd * HD + 8 * ch_) * 2); } \
        _Pragma("unroll") for (int i_ = 0; i_ < 4; ++i_) { \
            __builtin_amdgcn_global_load_lds((const unsigned*)((const char*)Kb + go_ + voff[i_]), (LAS unsigned*)(kb_ + i_ * 1024), 16, 0, 0); \
            __builtin_amdgcn_global_load_lds((const unsigned*)((const char*)Vb + go_ + voff[i_]), (LAS unsigned*)(kb_ + 16384 + i_ * 1024), 16, 0, 0); } \
        if (MODE == 1 && gw == 0) __builtin_amdgcn_global_load_lds((const unsigned*)(FCh + (kt) * 64 + l_), (LAS unsigned*)(Fl + (b) * 64), 4, 0, 0); } while (0)
    if (gtid < 8) flags[gtid] = 0;
    int cur = 0, it = 0; bool wdone = false;
    AG_DMA(ktop, 0);
    for (int kt = ktop; kt >= 0; --kt, ++it) {
        asm volatile("s_waitcnt vmcnt(0)" ::: "memory");
        gbar_sync(gb, lane);
        if (it > 0) { const volatile LAS int* f = flags + ((it - 1) & 1) * 4; if (f[0] & f[1] & f[2] & f[3]) break; }
        if (kt > 0) AG_DMA(kt - 1, cur ^ 1);
        if (!wdone) {
            if (MODE == 1 && kt * 64 + 63 <= qlo) attn_tile64_fox(gl + cur * 32768, gl + cur * 32768 + 16384, qf, o, m, l, lane, Fl + cur * 64);
            else {
            int ld_ = gtid; if (MODE == 1) asm volatile("" : "+v"(ld_));
            const int lane_d = ld_ & 63, qrow_d = qlo + (ld_ & 31);
#pragma unroll
            for (int blk = 1; blk >= 0; --blk) {
                const int key0 = kt * 64 + blk * 32;
                if (key0 > qlo + 31) continue;
                attn_block<MODE, MODE == 1>(gl + cur * 32768, gl + cur * 32768 + 16384, blk, qf, o, m, l, carry, key0, qrow_d, 0.f, nullptr, lane_d, nullptr, Fl + cur * 64 + blk * 32, key0 + 31 > qlo);
            } }
            if (MODE == 0) wdone = __all(carry < -136.f);
            else wdone = __all(m > -1e29f && qnk + Fl[cur * 64] * QK2 < m - 136.f);
        }
        { int lf_ = gtid; if (MODE == 1) asm volatile("" : "+v"(lf_)); if ((lf_ & 63) == 0) flags[(it & 1) * 4 + gw] = wdone ? 1 : 0; }
        cur ^= 1;
    }
#undef AG_DMA
    const float inv = MODE ? 1.f / l : 1.f;
    int le = gtid; asm volatile("" : "+v"(le));
    const int qrow_e = qlo + (le & 31), he = (le >> 5) & 1;
    const bf16_t* gp = Gate + (size_t)qrow_e * ld + hd * HD + 4 * he;
    bf16_t* op = Out + (size_t)qrow_e * DM + ocol0 + 4 * he;
#pragma unroll
    for (int c = 0; c < 4; ++c)
#pragma unroll
        for (int g = 0; g < 4; ++g) { const v2u gw_ = *(const v2u*)(gp + 32 * c + 8 * g);
            v2u w; w.x = cvtpk(o[c][4 * g] * inv * bflo(gw_.x), o[c][4 * g + 1] * inv * bfhi(gw_.x)); w.y = cvtpk(o[c][4 * g + 2] * inv * bflo(gw_.y), o[c][4 * g + 3] * inv * bfhi(gw_.y));
            *(v2u*)(op + 32 * c + 8 * g) = w; }
    gbar_sync(gb, lane);
}

__device__ __forceinline__ void fl_rows(LAS unsigned char* lds, const bf16_t* XN, const bf16_t* W3fl, const unsigned long long* RS, const float* bfg, float* FL, float* outF, int row0, int tid, int wid) {
    asm volatile("" : "+v"(tid)); const int lane = tid & 63;
    const int r32 = lane & 31, h = lane >> 5;
    f32x16 acc = {};
    const bf16_t* ap = XN + (size_t)(row0 + r32) * DM + wid * 512 + 8 * h;
    const bf16_t* bp = W3fl + (size_t)r32 * DM + wid * 512 + 8 * h;
#pragma unroll 8
    for (int s = 0; s < 32; ++s) { const bf16x8 a = *(const bf16x8*)(ap + 16 * s), bb = *(const bf16x8*)(bp + 16 * s); acc = __builtin_amdgcn_mfma_f32_32x32x16_bf16(a, bb, acc, 0, 0, 0); }
    LAS float* red = (LAS float*)lds;
#pragma unroll
    for (int r = 0; r < 16; ++r) red[(wid * 32 + (r & 3) + 8 * (r >> 2) + 4 * h) * 32 + r32] = acc[r];
    __syncthreads();
    { const int row = tid >> 4, c2 = (tid & 15) * 2;
      float s0 = 0.f, s1 = 0.f;
#pragma unroll
      for (int w = 0; w < 8; ++w) { const f32x2 v = *(const LAS f32x2*)(red + (w * 32 + row) * 32 + c2); s0 += v.x; s1 += v.y; }
      const float r = rsqrtf((float)RS[row0 + row] * (1.f / (FIX * 4096.f)) + EPS);
      float x0 = s0 * r + bfg[c2], x1 = s1 * r + bfg[c2 + 1];
      x0 = fminf(x0, 0.f) - log1pf(__expf(-fabsf(x0))); x1 = fminf(x1, 0.f) - log1pf(__expf(-fabsf(x1)));
      *(f32x2*)(FL + (size_t)(row0 + row) * 32 + c2) = (f32x2){x0, x1}; *(f32x2*)(outF + (size_t)(row0 + row) * 32 + c2) = (f32x2){x0, x1}; }
    __syncthreads();
}

template <int NB>
__device__ __forceinline__ void stage_block_f32(LAS unsigned char* T, const float* src  , size_t rs, int lane) {
#pragma unroll
    for (int hf = 0; hf < 16 / NB; ++hf) {
        f32x4 v[NB];
#pragma unroll
        for (int i = 0; i < NB; ++i) { const int id = lane + 64 * (NB * hf + i), row = id >> 5, c4 = id & 31; v[i] = *(const f32x4*)(src + (size_t)row * rs + c4 * 4); }
#pragma unroll
        for (int i = 0; i < NB; ++i) { const int id = lane + 64 * (NB * hf + i), row = id >> 5, c4 = id & 31; v2u w; w.x = cvtpk(v[i].x, v[i].y); w.y = cvtpk(v[i].z, v[i].w);
            *(LAS v2u*)(T + off_b(row, c4 >> 1) + (c4 & 1) * 8) = w; }
        asm volatile("" ::: "memory");
    }
}
__device__ __forceinline__ void stage_block_new(LAS unsigned char* T, const bf16_t* src  , int ld, int lane) {
#pragma unroll
    for (int i = 0; i < 8; ++i) { const int id = lane + 64 * i, row = id >> 4, ch = id & 15; v4u w = {0u, 0u, 0u, 0u}; if (row < 16) w = *(const v4u*)(src + (size_t)row * ld + ch * 8);
        *(LAS v4u*)(T + off_b(row, ch)) = w; }
    asm volatile("" ::: "memory");
}
__device__ __forceinline__ void attn_sample_sb_unit(LAS unsigned char* lds, int b, int hd, const bf16_t* QB, const bf16_t* KB, const bf16_t* VB, const bf16_t* GB,
                                                    const float* ck, const float* cv, bf16_t* Out, int tid_, int wid) {
    int lane = tid_ & 63; asm volatile("" : "+v"(lane));
    const int r32 = lane & 31, h = lane >> 5, t = r32 & 15; const bool real = r32 < 16;
    const int qrow = TP + 16 * b + t, qpos = real ? PAST + t : -1;
    bf16x8 qf[8];
    { const bf16_t* qp = QB + (size_t)qrow * HW + hd * HD + 8 * h;
#pragma unroll
      for (int s = 0; s < 8; ++s) { qf[s] = *(const bf16x8*)(qp + 16 * s); if (!real) qf[s] = (bf16x8){0, 0, 0, 0, 0, 0, 0, 0}; } }
    f32x16 o[4] = {};
    float m = 0.f, l = 0.f, carry = 0.f;
    volatile LAS int* flag = (volatile LAS int*)(lds + 65536);
    for (int tl = 16; tl >= 0; --tl) {
        int tid = wid * 64 + lane; asm volatile("" : "+v"(tid));
        if (tl == 16) {
#pragma unroll
            for (int i = 0; i < 2; ++i) { const int id = tid + 512 * i, row = id >> 4, ch = id & 15; v4u wk = {0u, 0u, 0u, 0u}, wv = {0u, 0u, 0u, 0u};
                if (row < 16) { const size_t go = (size_t)(TP + 16 * b + row) * HW + hd * HD + ch * 8; wk = *(const v4u*)(KB + go); wv = *(const v4u*)(VB + go); }
                *(LAS v4u*)(lds + off_b(row, ch)) = wk; *(LAS v4u*)(lds + 16384 + off_b(row, ch)) = wv; }
        } else {
            const size_t ro = (((size_t)b * PAST + 64 * tl) * NH_B + hd) * HD;
            f32x4 vk[4], vv[4];
#pragma unroll
            for (int i = 0; i < 4; ++i) { const int id = tid + 512 * i, row = id >> 5, c4 = id & 31; const size_t go = ro + (size_t)row * (NH_B * HD) + c4 * 4; vk[i] = *(const f32x4*)(ck + go); vv[i] = *(const f32x4*)(cv + go); }
#pragma unroll
            for (int i = 0; i < 4; ++i) { const int id = tid + 512 * i, row = id >> 5, c4 = id & 31; const unsigned lo = off_b(row, c4 >> 1) + (c4 & 1) * 8;
                v2u w; w.x = cvtpk(vk[i].x, vk[i].y); w.y = cvtpk(vk[i].z, vk[i].w); *(LAS v2u*)(lds + lo) = w;
                w.x = cvtpk(vv[i].x, vv[i].y); w.y = cvtpk(vv[i].z, vv[i].w); *(LAS v2u*)(lds + 16384 + lo) = w; }
        }
        __syncthreads();
        if (wid == 0) {
            attn_block<0>(lds, lds + 16384, 1, qf, o, m, l, carry, 64 * tl + 32, qpos, 0.f, nullptr, lane);
            attn_block<0>(lds, lds + 16384, 0, qf, o, m, l, carry, 64 * tl, qpos, 0.f, nullptr, lane);
            if (lane == 0) flag[0] = __all(carry < -136.f || !real) ? 1 : 0;
        }
        __syncthreads();
        if (flag[0]) break;
    }
    if (wid == 0 && real) {
        const bf16_t* gp = GB + (size_t)qrow * HW + hd * HD + 4 * h;
        bf16_t* op = Out + (size_t)qrow * DM + HW + hd * HD + 4 * h;
#pragma unroll
        for (int c = 0; c < 4; ++c)
#pragma unroll
            for (int g = 0; g < 4; ++g) { const v2u gw = *(const v2u*)(gp + 32 * c + 8 * g);
                v2u w; w.x = cvtpk(o[c][4 * g] * bflo(gw.x), o[c][4 * g + 1] * bfhi(gw.x)); w.y = cvtpk(o[c][4 * g + 2] * bflo(gw.y), o[c][4 * g + 3] * bfhi(gw.y));
                *(v2u*)(op + 32 * c + 8 * g) = w; }
    }
    __syncthreads();
}
__device__ __forceinline__ void attn_sample_fox_unit(LAS unsigned char* lds, int b, int hd, const bf16_t* QC, const bf16_t* KC, const bf16_t* VC, const bf16_t* GC,
                                                     const float* ck, const float* cv, const float* clf  , const float* FL, bf16_t* Out, int tid, int wid, int lane) {
    asm volatile("" : "+v"(tid)); lane = tid & 63;
    const int r32 = lane & 31, h = lane >> 5, t = r32 & 15; const bool real = r32 < 16;
    const int qrow = TP + 16 * b + t, qpos = real ? PAST + t : -1;
    LAS float* NFl = (LAS float*)(lds + RING_BYTES + 2048);
    { float v[3];
#pragma unroll
      for (int j = 0; j < 3; ++j) { const int s = tid * 3 + j; float x = 0.f;
          if (s < PAST) x = clf[((size_t)b * PAST + s) * NH_C + hd]; else if (s < PAST + TSQ) x = FL[(size_t)(TP + 16 * b + s - PAST) * 32 + hd];
          v[j] = x * -NFRS; }
      wg_scan<3>(v, (LAS float*)(lds + RING_BYTES + 1536), tid, wid, lane);
#pragma unroll
      for (int j = 0; j < 3; ++j) { const int s = tid * 3 + j; if (s < FCS_LD) NFl[s] = v[j]; }
      __syncthreads(); }
    LAS unsigned char* wl = lds + wid * 16384;
    bf16x8 qf[8];
    { const bf16_t* qp = QC + (size_t)qrow * DM + hd * HD + 8 * h;
#pragma unroll
      for (int s = 0; s < 8; ++s) { qf[s] = *(const bf16x8*)(qp + 16 * s); if (!real) qf[s] = (bf16x8){0, 0, 0, 0, 0, 0, 0, 0}; } }
    f32x16 o[4] = {};
    float m = -1e30f, l = 0.f, carry = 0.f;
    const float fq2 = 0.f;
    const int nb = (wid == 7) ? 5 : 4;
    for (int j = 0; j < nb; ++j) {
        const int bi = (j == 4) ? 32 : 4 * wid + j;
        if (bi == 32) { stage_block_new(wl, KC + (size_t)(TP + 16 * b) * DM + hd * HD, DM, lane); stage_block_new(wl + 8192, VC + (size_t)(TP + 16 * b) * DM + hd * HD, DM, lane); }
        else { const size_t ro = (((size_t)b * PAST + 32 * bi) * NH_C + hd) * HD; stage_block_f32<8>(wl, ck + ro, (size_t)NH_C * HD, lane); stage_block_f32<8>(wl + 8192, cv + ro, (size_t)NH_C * HD, lane); }
        attn_block<1, true>(wl, wl + 8192, 0, qf, o, m, l, carry, 32 * bi, qpos, fq2, nullptr, lane, nullptr, NFl + 32 * bi, bi == 32);
    }
    __syncthreads();
    LAS float* co = (LAS float*)lds;
    LAS float* cm = (LAS float*)(lds + 65536);
    if (real) {
        if (h == 0) { cm[wid * 16 + t] = m; cm[128 + wid * 16 + t] = l; }
#pragma unroll
        for (int c = 0; c < 4; ++c)
#pragma unroll
            for (int g = 0; g < 4; ++g) *(LAS f32x4*)(co + (wid * 16 + t) * 128 + 32 * c + 8 * g + 4 * h) = (f32x4){o[c][4 * g], o[c][4 * g + 1], o[c][4 * g + 2], o[c][4 * g + 3]};
    }
    __syncthreads();
    {
        const int tq = tid >> 5, d4 = (tid & 31) * 4;
        float M = -1e30f;
#pragma unroll
        for (int w = 0; w < 8; ++w) M = fmaxf(M, cm[w * 16 + tq]);
        float L = 0.f; f32x4 acc = {0.f, 0.f, 0.f, 0.f};
#pragma unroll
        for (int w = 0; w < 8; ++w) { const float sc = ex2(cm[w * 16 + tq] - M); L += cm[128 + w * 16 + tq] * sc; acc += *(const LAS f32x4*)(co + (w * 16 + tq) * 128 + d4) * sc; }
        const float inv = 1.f / L;
        const int orow = TP + 16 * b + tq;
        const v2u gw = *(const v2u*)(GC + (size_t)orow * DM + hd * HD + d4);
        v2u w; w.x = cvtpk(acc[0] * inv * bflo(gw.x), acc[1] * inv * bfhi(gw.x)); w.y = cvtpk(acc[2] * inv * bflo(gw.y), acc[3] * inv * bfhi(gw.y));
        *(v2u*)(Out + (size_t)orow * DM + hd * HD + d4) = w;
    }
    __syncthreads();
}

__device__ __forceinline__ void hg_load_g(const float* Gp  , int ntok, int k, int a, float (&g)[16]) {
#pragma unroll
    for (int j = 0; j < 16; ++j) { const int i = 16 * a + j; g[j] = (i < ntok) ? Gp[(size_t)i * HW + k] : 0.f; }
}
__device__ __forceinline__ void hg_scan(const float (&g)[16], LAS float* tot, int k, int a, float (&Gc)[16], float& Glast, float& Gmid) {
    float run = 0.f;
#pragma unroll
    for (int j = 0; j < 16; ++j) { run += g[j]; Gc[j] = run; }
    tot[a * 128 + k] = run;
    __syncthreads();
    const float t0 = tot[k], t1 = tot[128 + k], t2 = tot[256 + k], t3 = tot[384 + k];
    const float offs = (a > 0 ? t0 : 0.f) + (a > 1 ? t1 : 0.f) + (a > 2 ? t2 : 0.f);
#pragma unroll
    for (int j = 0; j < 16; ++j) Gc[j] += offs;
    Glast = (t0 + t1) + (t2 + t3); Gmid = t0 + t1;
}
__device__ __forceinline__ void hg_tile_load(const bf16_t* src, int ntok, int tid, v4u (&w)[2]) {
#pragma unroll
    for (int i = 0; i < 2; ++i) { const int id = tid + 512 * i, row = id >> 4, ch = id & 15; w[i] = (v4u){0u, 0u, 0u, 0u}; if (row < ntok) w[i] = *(const v4u*)(src + (size_t)row * HW + ch * 8); }
}
__device__ __forceinline__ void hg_tile_write(LAS unsigned char* T, int tid, const v4u (&w)[2]) {
#pragma unroll
    for (int i = 0; i < 2; ++i) { const int id = tid + 512 * i, row = id >> 4, ch = id & 15; *(LAS v4u*)(T + off_b(row, ch)) = w[i]; }
}
constexpr int HG_V = 0, HG_KT = 16384, HG_QP = 32768, HG_QM = 49152, HG_KM = 65536, HG_SST = 81920, HG_TOT = 114688, HG_RED = 116736;

struct HgIn { float g[16]; unsigned short kr[16]; v4u vt[2]; };
__device__ __forceinline__ void hg_local_load(HgIn& I, const bf16_t* KAp, const bf16_t* VAp, const float* Gp, int ntok, int tid) {
    const int k = tid & 127, a = tid >> 7;
    hg_load_g(Gp, ntok, k, a, I.g);
    hg_tile_load(VAp, ntok, tid, I.vt);
#pragma unroll
    for (int j = 0; j < 16; ++j) { const int i = 16 * a + j; I.kr[j] = (i < ntok) ? KAp[(size_t)i * HW + k] : (unsigned short)0; }
}
template <bool SAMPLE>
__device__ __forceinline__ void hg_local_compute(LAS unsigned char* lds, const HgIn& I, const float* S0, float* Sout, float* Dout, int tid, int wid) {
    const int lane = tid & 63;
    const int k = tid & 127, a = tid >> 7;
    float Gc[16], Glast, Gmid;
    hg_scan(I.g, (LAS float*)(lds + HG_TOT), k, a, Gc, Glast, Gmid);
    hg_tile_write(lds + HG_V, tid, I.vt);
    {
        unsigned w[8];
#pragma unroll
        for (int j = 0; j < 16; j += 2) {
            const float k0 = bf2f(I.kr[j]) * ex2((Glast - Gc[j]) * LOG2E);
            const float k1 = bf2f(I.kr[j + 1]) * ex2((Glast - Gc[j + 1]) * LOG2E);
            w[j >> 1] = cvtpk(k0, k1); }
        const unsigned sx = (k >> 1) & 7;
        *(LAS v4u*)(lds + HG_KT + 128 * k + 16 * ((2 * a) ^ sx)) = (v4u){w[0], w[1], w[2], w[3]};
        *(LAS v4u*)(lds + HG_KT + 128 * k + 16 * ((2 * a + 1) ^ sx)) = (v4u){w[4], w[5], w[6], w[7]};
    }
    if (!SAMPLE && a == 0) Dout[k] = ex2(Glast * LOG2E);
    __syncthreads();
    const int r32 = lane & 31, h = lane >> 5, kb = wid >> 1;
    const unsigned q4 = (lane & 15) >> 2, pp = lane & 3, bc = (lane >> 4) & 1;
    f32x16 acc[2] = {};
    const int krow = 32 * kb + r32; const unsigned sx = (krow >> 1) & 7;
#pragma unroll
    for (int s = 0; s < 4; ++s) {
        const bf16x8 af = *(const LAS bf16x8*)(lds + HG_KT + 128 * krow + 16 * ((unsigned)(2 * s + h) ^ sx));
#pragma unroll
        for (int vv = 0; vv < 2; ++vv) { const int vb = 2 * (wid & 1) + vv;
            const unsigned row0 = 16u * s + 8u * h + q4, row1 = row0 + 4u, chn = 4u * vb + 2u * bc + (pp >> 1);
            const unsigned x0 = (q4 << 2) | ((row0 >> 2) & 3u), x1 = (q4 << 2) | ((row1 >> 2) & 3u);
            const s16x4 lo = __builtin_amdgcn_ds_read_tr16_b64_v4i16((LAS s16x4*)(lds + HG_V + 256u * row0 + 16u * (chn ^ x0) + 8u * (pp & 1)));
            const s16x4 hi = __builtin_amdgcn_ds_read_tr16_b64_v4i16((LAS s16x4*)(lds + HG_V + 256u * row1 + 16u * (chn ^ x1) + 8u * (pp & 1)));
            const bf16x8 bfg = {lo[0], lo[1], lo[2], lo[3], hi[0], hi[1], hi[2], hi[3]};
            acc[vv] = __builtin_amdgcn_mfma_f32_32x32x16_bf16(af, bfg, acc[vv], 0, 0, 0); }
    }
    const LAS float* tot = (const LAS float*)(lds + HG_TOT);
#pragma unroll
    for (int vv = 0; vv < 2; ++vv) { const int v = 32 * (2 * (wid & 1) + vv) + r32;
#pragma unroll
        for (int r = 0; r < 16; ++r) { const int kk = 32 * kb + (r & 3) + 8 * (r >> 2) + 4 * h;
            float val = acc[vv][r];
            if (SAMPLE) { const float gl = (tot[kk] + tot[128 + kk]) + (tot[256 + kk] + tot[384 + kk]); val += ex2(gl * LOG2E) * S0[kk * 128 + v]; }
            if (SAMPLE) Sout[kk * 128 + v] = val;
            else { const float nb_ = __shfl_xor(val, 1);
                   if ((lane & 1) == 0) *(unsigned*)((bf16_t*)Sout + kk * 128 + v) = cvtpk(val, nb_); } } }
    __syncthreads();
}

template <bool SAMPLE>
__device__ __forceinline__ void hg_local(LAS unsigned char* lds, const bf16_t* KAp, const bf16_t* VAp, const float* Gp, int ntok, const float* S0, float* Sout, float* Dout, int tid, int wid, int lane) {
    asm volatile("" : "+v"(tid));
    HgIn I; hg_local_load(I, KAp, VAp, Gp, ntok, tid);
    hg_local_compute<SAMPLE>(lds, I, S0, Sout, Dout, tid, wid);
}

__device__ __forceinline__ void hg_output(LAS unsigned char* lds, const bf16_t* QAp, const bf16_t* KAp, const bf16_t* VAp, const float* Gp, const bf16_t* GAp, int ntok,
                                          const bf16_t* Sst16, const float* S0f, const float* anw, bf16_t* Outp  , int tid, int wid, int lane) {
    asm volatile("" : "+v"(tid)); lane = tid & 63;
    const int k = tid & 127, a = tid >> 7;
    float g[16]; hg_load_g(Gp, ntok, k, a, g);
    v4u vt[2]; hg_tile_load(VAp, ntok, tid, vt);
    unsigned short qr[16], kr[16];
#pragma unroll
    for (int j = 0; j < 16; ++j) { const int i = 16 * a + j; qr[j] = 0; kr[j] = 0; if (i < ntok) { qr[j] = QAp[(size_t)i * HW + k]; kr[j] = KAp[(size_t)i * HW + k]; } }
    v4u s16[4]; f32x4 s32[8];
    if (Sst16) {
#pragma unroll
        for (int i = 0; i < 4; ++i) { const int id = tid + 512 * i, row = id >> 4, ch = id & 15; s16[i] = *(const v4u*)(Sst16 + (size_t)row * 128 + ch * 8); }
    } else {
#pragma unroll
        for (int i = 0; i < 8; ++i) { const int id = tid + 512 * i, row = id >> 5, c4 = id & 31; s32[i] = *(const f32x4*)(S0f + (size_t)row * 128 + c4 * 4); }
    }
    float Gc[16], Glast, Gmid;
    hg_scan(g, (LAS float*)(lds + HG_TOT), k, a, Gc, Glast, Gmid);
    hg_tile_write(lds + HG_V, tid, vt);
    if (Sst16) {
#pragma unroll
        for (int i = 0; i < 4; ++i) { const int id = tid + 512 * i, row = id >> 4, ch = id & 15; *(LAS v4u*)(lds + HG_SST + off_b(row, ch)) = s16[i]; }
    } else {
#pragma unroll
        for (int i = 0; i < 8; ++i) { const int id = tid + 512 * i, row = id >> 5, c4 = id & 31; const f32x4 v = s32[i];
            v2u w; w.x = cvtpk(v.x, v.y); w.y = cvtpk(v.z, v.w); *(LAS v2u*)(lds + HG_SST + off_b(row, c4 >> 1) + (c4 & 1) * 8) = w; }
    }
#pragma unroll
    for (int j = 0; j < 16; ++j) { const int i = 16 * a + j;
        const float q = bf2f(qr[j]), kk = bf2f(kr[j]);
        const float eq = ex2(Gc[j] * LOG2E), em = ex2(fminf((Gc[j] - Gmid) * LOG2E, 115.f)), ek = ex2(fminf((Gmid - Gc[j]) * LOG2E, 115.f));
        const unsigned o2 = off_b(i, k >> 3) + (k & 7) * 2;
        *(LAS bf16_t*)(lds + HG_QP + o2) = (bf16_t)(cvtpk(q * eq, 0.f) & 0xffffu);
        *(LAS bf16_t*)(lds + HG_QM + o2) = (bf16_t)(cvtpk(q * em, 0.f) & 0xffffu);
        *(LAS bf16_t*)(lds + HG_KM + o2) = (bf16_t)(cvtpk(kk * ek, 0.f) & 0xffffu); }
    __syncthreads();
    const int r32 = lane & 31, h = lane >> 5, vb = wid & 3, ib = wid >> 2;
    const unsigned q4 = (lane & 15) >> 2, pp = lane & 3, bc = (lane >> 4) & 1;
    f32x16 o = {};
    const bool active = (32 * ib < ntok);
    if (active) {
        const unsigned irow = 32u * ib + r32, ix = ((irow & 3u) << 2) | ((irow >> 2) & 3u);
#pragma unroll
        for (int s = 0; s < 8; ++s) {
            const bf16x8 bq = *(const LAS bf16x8*)(lds + HG_QP + 256u * irow + 16u * ((unsigned)(2 * s + h) ^ ix));
            const unsigned row0 = 16u * s + 8u * h + q4, row1 = row0 + 4u, chn = 4u * vb + 2u * bc + (pp >> 1);
            const unsigned x0 = (q4 << 2) | ((row0 >> 2) & 3u), x1 = (q4 << 2) | ((row1 >> 2) & 3u);
            const s16x4 lo = __builtin_amdgcn_ds_read_tr16_b64_v4i16((LAS s16x4*)(lds + HG_SST + 256u * row0 + 16u * (chn ^ x0) + 8u * (pp & 1)));
            const s16x4 hi = __builtin_amdgcn_ds_read_tr16_b64_v4i16((LAS s16x4*)(lds + HG_SST + 256u * row1 + 16u * (chn ^ x1) + 8u * (pp & 1)));
            const bf16x8 as = {lo[0], lo[1], lo[2], lo[3], hi[0], hi[1], hi[2], hi[3]};
            o = __builtin_amdgcn_mfma_f32_32x32x16_bf16(as, bq, o, 0, 0, 0);
        }
#pragma unroll
        for (int jb = 0; jb < 2; ++jb) {
            if (jb > ib) continue;
            f32x16 p = {};
            const unsigned jrow = 32u * jb + r32, jx = ((jrow & 3u) << 2) | ((jrow >> 2) & 3u);
#pragma unroll
            for (int s = 0; s < 8; ++s) {
                const bf16x8 ak = *(const LAS bf16x8*)(lds + HG_KM + 256u * jrow + 16u * ((unsigned)(2 * s + h) ^ jx));
                const bf16x8 bq = *(const LAS bf16x8*)(lds + HG_QM + 256u * irow + 16u * ((unsigned)(2 * s + h) ^ ix));
                p = __builtin_amdgcn_mfma_f32_32x32x16_bf16(ak, bq, p, 0, 0, 0);
            }
            float x[16];
#pragma unroll
            for (int r = 0; r < 16; ++r) { const int j = 32 * jb + (r & 3) + 8 * (r >> 2) + 4 * h, i = 32 * ib + r32; x[r] = (j <= i) ? p[r] : 0.f; }
#pragma unroll
            for (int ks = 0; ks < 2; ++ks) {
                v4u w; w.x = cvtpk(x[8 * ks], x[8 * ks + 1]); w.y = cvtpk(x[8 * ks + 2], x[8 * ks + 3]); w.z = cvtpk(x[8 * ks + 4], x[8 * ks + 5]); w.w = cvtpk(x[8 * ks + 6], x[8 * ks + 7]);
                const bf16x8 pk = __builtin_bit_cast(bf16x8, w);
                const unsigned row0 = 32u * jb + 16u * ks + 4u * h + q4, row1 = row0 + 8u, chn = 4u * vb + 2u * bc + (pp >> 1);
                const unsigned x0 = (q4 << 2) | ((unsigned)h & 3u), x1 = (q4 << 2) | (((unsigned)h + 2u) & 3u);
                const s16x4 lo = __builtin_amdgcn_ds_read_tr16_b64_v4i16((LAS s16x4*)(lds + HG_V + 256u * row0 + 16u * (chn ^ x0) + 8u * (pp & 1)));
                const s16x4 hi = __builtin_amdgcn_ds_read_tr16_b64_v4i16((LAS s16x4*)(lds + HG_V + 256u * row1 + 16u * (chn ^ x1) + 8u * (pp & 1)));
                const bf16x8 av = {lo[0], lo[1], lo[2], lo[3], hi[0], hi[1], hi[2], hi[3]};
                o = __builtin_amdgcn_mfma_f32_32x32x16_bf16(av, pk, o, 0, 0, 0);
            }
        }
    }
    float ss = 0.f;
#pragma unroll
    for (int r = 0; r < 16; ++r) ss += o[r] * o[r];
    { auto rr = __builtin_amdgcn_permlane32_swap(__float_as_uint(ss), __float_as_uint(ss), false, false); ss = __uint_as_float(rr[0]) + __uint_as_float(rr[1]); }
    LAS float* red = (LAS float*)(lds + HG_RED);
    if (h == 0) red[(ib * 4 + vb) * 32 + r32] = ss;
    __syncthreads();
    const int i = 32 * ib + r32;
    if (active && i < ntok) {
        const float tot = (red[(ib * 4 + 0) * 32 + r32] + red[(ib * 4 + 1) * 32 + r32]) + (red[(ib * 4 + 2) * 32 + r32] + red[(ib * 4 + 3) * 32 + r32]);
        const float rn = rsqrtf(tot * (1.f / 128.f) + EPS);
        const bf16_t* gp = GAp + (size_t)i * HW + 32 * vb + 4 * h;
        bf16_t* op = Outp + (size_t)i * DM + 32 * vb + 4 * h;
        const float* wp = anw + 32 * vb + 4 * h;
#pragma unroll
        for (int g = 0; g < 4; ++g) { const v2u gw = *(const v2u*)(gp + 8 * g); const f32x4 ww = *(const f32x4*)(wp + 8 * g);
            v2u w; w.x = cvtpk(o[4 * g] * rn * ww.x * bflo(gw.x), o[4 * g + 1] * rn * ww.y * bfhi(gw.x)); w.y = cvtpk(o[4 * g + 2] * rn * ww.z * bflo(gw.y), o[4 * g + 3] * rn * ww.w * bfhi(gw.y));
            *(v2u*)(op + 8 * g) = w; }
    }
    __syncthreads();
}
#ifndef MK_FUSED
#define MK_FUSED 1
#endif
#ifndef MK_DEBUG
#define MK_DEBUG 0
#endif

constexpr int FI3 = (DM / 64) * (N1 / 64) + DM / 64, FI4 = (DM / 64) * (DM / 64), FILL_P1 = 6000;
__device__ __forceinline__ void w3_item(const float* w_in_odd, bf16_t* W3T, LAS float* scr, int it, int lane) {
    if (it < (DM / 64) * (N1 / 64)) p0_transpose_item64(w_in_odd, DM, N3R, W3T, scr, it, lane);
    else p0_transpose_item(w_in_odd, DM, N3R, W3T, scr, (it - (DM / 64) * (N1 / 64)) * (N3R / 32) + (N3R / 32 - 1), lane);
}
__device__ __forceinline__ void filler_static(bool w3, int first, int stride, int lo, int hi, const float* w_in_odd, const float* w_out_odd, bf16_t* W3T, bf16_t* W4T, LAS float* scr, int lane) {
    for (int it = lo + first; it < hi; it += stride) { if (w3) w3_item(w_in_odd, W3T, scr, it, lane); else p0_transpose_item64(w_out_odd, DM, DM, W4T, scr, it, lane); }
}
__device__ __forceinline__ void filler_drain(unsigned* fq, int lo, int hi, const float* w_in_odd, bf16_t* W3T, LAS float* scr, int lane) {
    for (;;) {
        int it = 0; if (lane == 0) it = (int)atomicAdd(fq, 4u);
        it = lo + __builtin_amdgcn_readfirstlane(it);
        if (it >= hi) break;
        const int e4 = (it + 4 < hi) ? it + 4 : hi;
        for (; it < e4; ++it) w3_item(w_in_odd, W3T, scr, it, lane);
    }
}
struct OneUnit { int pm, pn, hf;
    __device__ __forceinline__ bool next(int i, pg8::Unit& u) const { if (i) return false; u.pm = pm; u.pn = pn; u.hf = hf; return true; }
    __device__ __forceinline__ void a_ready(const pg8::Unit&) const {}
    __device__ __forceinline__ void done(const pg8::Unit&) const {} };
struct Args { const float* in[17]; float* out; unsigned char* ws; int ph_lo, ph_hi; };
constexpr int NPHASE = 11;

#define TIDX (wid0 * 64 + (int)__builtin_amdgcn_mbcnt_hi(~0u, __builtin_amdgcn_mbcnt_lo(~0u, 0u)))
#define PH_TID int tid = TIDX; asm volatile("" : "+v"(tid)); const int lane = tid & 63; (void)lane;
#define PH_PTRS const int wid = wid0; const int gw = bx * NWAVES + wid; (void)gw; unsigned char* ws_ = args.ws; unsigned* ctl_ = (unsigned*)(ws_ + WS_CTL); (void)ctl_; const float* x_prompt = args.in[0]; const float* x_sample = args.in[1]; const float* state_a = args.in[2]; const float* cache_b_k = args.in[3]; const float* cache_b_v = args.in[4]; const float* cache_c_k = args.in[5]; const float* cache_c_v = args.in[6]; const float* cache_c_logf = args.in[7]; const float* norm_w = args.in[8]; const float* final_w = args.in[9]; const float* w_in_even = args.in[10]; const float* w_out_even = args.in[11]; const float* lb_logits = args.in[12]; const float* a_norm_w = args.in[13]; const float* w_in_odd = args.in[14]; const float* b_forget = args.in[15]; const float* w_out_odd = args.in[16]; float* out = args.out; bf16_t* W1T = (bf16_t*)(ws_ + WS_W1T); bf16_t* W2T = (bf16_t*)(ws_ + WS_W2T); bf16_t* W3T = (bf16_t*)(ws_ + WS_W3T); bf16_t* W4T = (bf16_t*)(ws_ + WS_W4T); bf16_t* XN = (bf16_t*)(ws_ + WS_XN); bf16_t* P = (bf16_t*)(ws_ + WS_P); float* Gb = (float*)(ws_ + WS_G); bf16_t* A = (bf16_t*)(ws_ + WS_A); float* H1 = (float*)(ws_ + WS_H1); float* SLOC = (float*)(ws_ + WS_SLOC); bf16_t* SST = (bf16_t*)(ws_ + WS_SST); float* DEC = (float*)(ws_ + WS_DEC); float* FL = (float*)(ws_ + WS_FL); float* FCP = (float*)(ws_ + WS_FCP); float* FCS = (float*)(ws_ + WS_FCS); float* LB = (float*)(ws_ + WS_LB); unsigned long long* RS1 = (unsigned long long*)(ctl_ + CW_RS1); unsigned long long* RS2 = (unsigned long long*)(ctl_ + CW_RS2); bf16_t* QA = P; bf16_t* KA = P + PSTR1; bf16_t* VA = P + 2 * PSTR1; bf16_t* GA = P + 3 * PSTR1; bf16_t* QB = P + 4 * PSTR1; bf16_t* KB = P + 5 * PSTR1; bf16_t* VB = P + 6 * PSTR1; bf16_t* GB = P + 7 * PSTR1; bf16_t* P3 = (bf16_t*)(ws_ + WS_P3); bf16_t* QC = P3; bf16_t* KC = P3 + PSTR3; bf16_t* VC = P3 + 2 * PSTR3; bf16_t* GC = P3 + 3 * PSTR3;
__global__ void __launch_bounds__(NWAVES * 64, 2) fwd_kernel(Args args) {
    extern __shared__ __attribute__((aligned(16))) unsigned char lds_raw[];
    LAS unsigned char* lds = (LAS unsigned char*)lds_raw;
    const int tid0 = threadIdx.x;
    const int wid0 = __builtin_amdgcn_readfirstlane(tid0 >> 6);
    const int G = gridDim.x, bx = blockIdx.x;
    const int NGW = G * NWAVES;
    unsigned char* ws = args.ws;
    unsigned* ctl = (unsigned*)(ws + WS_CTL);
    volatile LAS unsigned* MISC = (volatile LAS unsigned*)(lds + MISC_OFF);
    for (int u = tid0; u < (LDS_BYTES - RING_BYTES) / 4; u += NWAVES * 64) ((LAS unsigned*)(lds + RING_BYTES))[u] = 0u;
    __syncthreads();
    const int lo = args.ph_lo, hi = args.ph_hi;
    const bool fused = (hi - lo) > 1;
    XcdBarrier bar; bar.bar = ctl + CW_BAR; bar.x = 0; bar.st = nullptr;
    if (fused) bar = xcd_barrier_post(ctl + CW_BAR, MISC + 8);
#ifdef ONLY
#define IN(k) ((k) == ONLY && lo <= (k) && (k) < hi)
#else
#define IN(k) (lo <= (k) && (k) < hi)
#endif
#ifndef DUP_MASK
#define DUP_MASK 0
#endif
#define REP(k) for (int rep_ = 0; rep_ < (((DUP_MASK >> (k)) & 1) ? 2 : 1); ++rep_)
#define SEAM(k) do { if (IN(k) && IN((k) + 1)) xcd_barrier(bar, wid0); } while (0)

    if (IN(0)) REP(0) { PH_PTRS PH_TID
        LAS float* scr = (LAS float*)(lds + wid * 16384);
        constexpr int I1 = (DM / 64) * (N1 / 64), I2 = (DM / 64) * (DM / 64);
        for (int it = gw; it < I1 + I2; it += NGW) {
            if (it < I1) p0_transpose_item64(w_in_even, DM, N1, W1T, scr, it, lane);
            else p0_transpose_item64(w_out_even, DM, DM, W2T, scr, it - I1, lane);
        }
        for (int m = gw; m < MROWS; m += NGW) norm_row_to_bf16(m < TP ? x_prompt + (size_t)m * DM : x_sample + (size_t)(m - TP) * DM, norm_w, XN + (size_t)m * DM, lane);
        {
            v4u* z = (v4u*)(W3T + (size_t)N3R * DM); const size_t n16 = (size_t)(N3 - N3R) * DM / 8;
            for (size_t i = (size_t)bx * 512 + tid; i < n16; i += (size_t)G * 512) z[i] = (v4u){0u, 0u, 0u, 0u};
        }
        for (int c = bx * 512 + tid; c < HW; c += G * 512) LB[c] = rcpf_(1.f + __expf(lb_logits[HW + c] - lb_logits[c]));
    }
    SEAM(0);
    if (IN(1)) REP(1) { PH_PTRS PH_TID
        { pg8::Gemm g{XN, W1T, TP, N1, DM}; pg8::StaticOrder S; S.init(TP, N1, G, bx);
          Epi1 E{P, Gb, LB, out};
          pg8::gemm_phase<Epi1, pg8::StaticOrder, true, true>(lds, g, S, E, tid); }
        for (int hu = bx; hu < 128; hu += G) { pg8::Gemm g{XN, W1T, MROWS, N1, DM}; OneUnit S{32, hu >> 1, hu & 1};
            Epi1 E{P, Gb, LB, out};
            pg8::gemm_phase<Epi1, OneUnit, true, true, true>(lds, g, S, E, tid); }
        if (G > 128) { if (bx >= 128) filler_static(true, (bx - 128) * NWAVES + wid, (G - 128) * NWAVES, 0, FILL_P1, w_in_odd, w_out_odd, W3T, W4T, (LAS float*)(lds + wid * 16384), lane); }
        else filler_static(true, gw, NGW, 0, FILL_P1, w_in_odd, w_out_odd, W3T, W4T, (LAS float*)(lds + wid * 16384), lane);
    }
    SEAM(1);
    if (IN(2)) REP(2) { PH_PTRS
#ifndef P2SUB
#define P2SUB 31
#endif
#ifndef P2REP
#define P2REP 0
#endif
#define R2(bit) for (int r2_ = 0; r2_ < ((P2REP & (bit)) ? 3 : 1); ++r2_)
        if (P2SUB & 2) R2(2) for (int u = bx; u < NSB * NH_B; u += G) attn_sample_sb_unit(lds, u >> 4, u & 15, QB, KB, VB, GB, cache_b_k, cache_b_v, A, TIDX, wid);
        if (P2SUB & 4) R2(4) {
            int tid = TIDX; asm volatile("" : "+v"(tid));
            HgIn I;
            if (bx < NH_A * 128) { const size_t ro = (size_t)(64 * (bx & 127)) * HW + (bx >> 7) * HD; hg_local_load(I, KA + ro, VA + ro, Gb + ro, 64, tid); }
            for (int u = bx; u < NH_A * 128; u += G) {
                HgIn N; const int un = u + G;
                if (un < NH_A * 128) { const size_t ro = (size_t)(64 * (un & 127)) * HW + (un >> 7) * HD; hg_local_load(N, KA + ro, VA + ro, Gb + ro, 64, tid); }
                hg_local_compute<false>(lds, I, nullptr, SLOC + (size_t)u * 8192  , DEC + (size_t)u * 128, tid, wid);
                if (un < NH_A * 128) I = N;
            }
        }
        if (P2SUB & 8) R2(8) for (int u = bx; u < NSB * NH_A; u += G) { const int b = u >> 4, hd = u & 15; const size_t ro = (size_t)(TP + 16 * b) * HW + hd * HD; const float* S0 = state_a + (size_t)u * 16384;
            hg_local<true>(lds, KA + ro, VA + ro, Gb + ro, 16, S0, out + O_SAS + (size_t)u * 16384, nullptr, TIDX, wid, 0); }
        if (P2SUB & 16) R2(16) for (int u = bx; u < NSB * NH_A; u += G) { const int b = u >> 4, hd = u & 15; const size_t ro = (size_t)(TP + 16 * b) * HW + hd * HD; const float* S0 = state_a + (size_t)u * 16384;
            hg_output(lds, QA + ro, KA + ro, VA + ro, Gb + ro, GA + ro, 16, nullptr, S0, a_norm_w, A + (size_t)(TP + 16 * b) * DM + hd * HD, TIDX, wid, 0); }
    }
    SEAM(2);
    if (IN(3)) REP(3) { PH_PTRS PH_TID
        const int NG = (G >= 128) ? 32 : 0, NSCAN = (G >= 128) ? 64 : G;
        if (bx < NG) {
            pg8::Gemm g{A, W2T, MROWS, DM, DM}; OneUnit S{32, bx >> 1, bx & 1};
            EpiRes<true> E{x_prompt, x_sample, H1, XN, norm_w + DM, RS1};
            pg8::gemm_phase<EpiRes<true>, OneUnit, true, true, true>(lds, g, S, E, tid);
        } else if (bx < NG + NSCAN) { const int sb = bx - NG;
            if (NSCAN == 64) {
                const unsigned* sl[4]; const float* dc[4]; unsigned* so[4]; float s0[4], s1[4];
#pragma unroll
                for (int j = 0; j < 4; ++j) { const int e = sb * 512 + tid + j * 32768; const int hd = e >> 13, k = (e >> 6) & 127, vp = e & 63;
                    sl[j] = (const unsigned*)SLOC + (size_t)hd * 128 * 8192 + k * 64 + vp; dc[j] = DEC + (size_t)hd * 128 * 128 + k; so[j] = (unsigned*)(SST + (size_t)hd * 128 * 16384 + k * 128 + 2 * vp); s0[j] = 0.f; s1[j] = 0.f; }
#pragma unroll 4
                for (int c = 0; c < 128; ++c) {
#pragma unroll
                    for (int j = 0; j < 4; ++j) { const unsigned lw = sl[j][(size_t)c * 8192]; const float d = dc[j][c * 128];
                        so[j][(size_t)c * 8192] = cvtpk(s0[j], s1[j]); s0[j] = fmaf(d, s0[j], bflo(lw)); s1[j] = fmaf(d, s1[j], bfhi(lw)); } }
#pragma unroll
                for (int j = 0; j < 4; ++j) { const int e = sb * 512 + tid + j * 32768; const int hd = e >> 13, k = (e >> 6) & 127, vp = e & 63;
                    *(f32x2*)(out + O_SAP + (size_t)hd * 16384 + k * 128 + 2 * vp) = (f32x2){s0[j], s1[j]}; }
            } else
            for (int e = sb * 512 + tid; e < NH_A * 128 * 64; e += NSCAN * 512) {
                const int hd = e >> 13, k = (e >> 6) & 127, vp = e & 63;
                const unsigned* sl = (const unsigned*)SLOC + (size_t)hd * 128 * 8192 + k * 64 + vp;
                const float* dc = DEC + (size_t)hd * 128 * 128 + k;
                unsigned* so = (unsigned*)(SST + (size_t)hd * 128 * 16384 + k * 128 + 2 * vp);
                float s0 = 0.f, s1 = 0.f;
#pragma unroll 16
                for (int c = 0; c < 128; ++c) { const unsigned lw = sl[(size_t)c * 8192]; const float d = dc[c * 128];
                    so[(size_t)c * 8192] = cvtpk(s0, s1); s0 = fmaf(d, s0, bflo(lw)); s1 = fmaf(d, s1, bfhi(lw)); }
                *(f32x2*)(out + O_SAP + (size_t)hd * 16384 + k * 128 + 2 * vp) = (f32x2){s0, s1};
            }
        }
        if (G < 128) {
            for (int u = bx; u < 32; u += G) { pg8::Gemm g{A, W2T, MROWS, DM, DM}; OneUnit S{32, u >> 1, u & 1}; EpiRes<true> E{x_prompt, x_sample, H1, XN, norm_w + DM, RS1};
                pg8::gemm_phase<EpiRes<true>, OneUnit, true, true, true>(lds, g, S, E, tid); } }
        __syncthreads();
        {
            unsigned* wq = ctl_ + CW_WQ3;
            const int grp = wid >> 2, gw = wid & 3; const int gtid = gw * 64 + (TIDX & 63);
            LAS unsigned char* gl = lds + grp * 65536; LAS unsigned char* gx = lds + RING_BYTES + 2048 + grp * 1024;
            GBar gb; gb.cnt = (volatile LAS unsigned*)(gx + 832); gb.tgt = 0u;
            if (gtid == 0) *gb.cnt = 0u;
            __syncthreads();
            volatile LAS int* wqg = (volatile LAS int*)(gx + 768);
            for (;;) {
                if (gtid == 0) wqg[0] = (int)atomicAdd(wq, 1u);
                gbar_sync(gb, gtid & 63);
                const int u = wqg[0];
                gbar_sync(gb, gtid & 63);
                if (u >= NH_B * 64) break;
                const int hd = u & 15, qb = 63 - (u >> 4);
                attn_prompt_group<0>(gl, gx, gb, QB, KB, VB, GB, HW, hd, qb, A, HW + hd * HD, nullptr, gtid, gw, 0.f);
            }
        }
        __syncthreads();
        filler_drain(ctl_ + CW_FQ, FILL_P1, FI3, w_in_odd, W3T, (LAS float*)(lds + wid * 16384), TIDX & 63);
    }
    SEAM(3);
    if (IN(4)) REP(4) { PH_PTRS
        unsigned* wq = ctl_ + CW_WQ4;
        volatile LAS int* wql = (volatile LAS int*)(lds + RING_BYTES + 1024);
        for (;;) {
            if (TIDX == 0) wql[0] = (int)atomicAdd(wq, 1u);
            __syncthreads();
            const int item = wql[0];
            __syncthreads();
            if (item >= 129 + NH_A * 128) break;
            if (item < 129) {
                int tid = TIDX; asm volatile("" : "+v"(tid));
                pg8::Gemm g{XN, W3T, MROWS, N3, DM}; OneUnit S{32, item >> 1, item & 1};
                Epi3 E{P3, RS1, FL, b_forget, out};
                pg8::gemm_phase<Epi3, OneUnit, true, true, true>(lds, g, S, E, tid);
            } else { const int u = item - 129, hd = u >> 7, c = u & 127; const size_t ro = (size_t)(64 * c) * HW + hd * HD;
                hg_output(lds, QA + ro, KA + ro, VA + ro, Gb + ro, GA + ro, 64, SST + (size_t)u * 16384, nullptr, a_norm_w, A + (size_t)(64 * c) * DM + hd * HD, TIDX, wid, 0); }
        }
        { unsigned* fq = ctl_ + CW_FQ + 64;
          const int lane_ = TIDX & 63; LAS float* scr_ = (LAS float*)(lds + wid * 16384);
          for (;;) { int it = 0; if (lane_ == 0) it = (int)atomicAdd(fq, 4u); it = __builtin_amdgcn_readfirstlane(it); if (it >= FI4) break;
              const int e4 = (it + 4 < FI4) ? it + 4 : FI4; for (; it < e4; ++it) p0_transpose_item64(w_out_odd, DM, DM, W4T, scr_, it, lane_); } }
    }
    SEAM(4);
    if (IN(5)) REP(5) { PH_PTRS PH_TID
        pg8::Gemm g{A, W2T, TP, DM, DM}; pg8::StaticOrder S; S.init(TP, DM, G, bx);
        EpiRes<true> E{x_prompt, x_sample, H1, XN, norm_w + DM, RS1};
        pg8::gemm_phase<EpiRes<true>, pg8::StaticOrder, true, true>(lds, g, S, E, tid);
    }
    SEAM(5);
    if (IN(6)) REP(6) { PH_PTRS PH_TID
        pg8::Gemm g{XN, W3T, TP, N1, DM}; pg8::StaticOrder S; S.init(TP, N1, G, bx);
        Epi3 E{P3, RS1, FL, b_forget, out};
        pg8::gemm_phase<Epi3, pg8::StaticOrder, true, true>(lds, g, S, E, tid);
        for (int rb = bx; rb < TP / 32; rb += G) fl_rows(lds, XN, W3T + (size_t)N1 * DM, RS1, b_forget, FL, out + O_CFP, 32 * rb, tid, wid);
    }
    SEAM(6);
    if (IN(7)) REP(7) { PH_PTRS PH_TID
        LAS float* scr = (LAS float*)(lds + 1024);
        for (int u = bx; u < NH_C; u += G) { const int hd = u; float v[16];
#pragma unroll
            for (int j = 0; j < 16; ++j) v[j] = FL[(size_t)(tid * 16 + j) * 32 + hd] * -NFRS;
            wg_scan<16>(v, scr, tid, wid, lane);
#pragma unroll
            for (int j = 0; j < 16; j += 4) *(f32x4*)(FCP + (size_t)hd * TP + tid * 16 + j) = (f32x4){v[j], v[j + 1], v[j + 2], v[j + 3]};
        }
        {
            unsigned* KN2 = ctl_ + CW_KN2;
            for (int u = bx; u < NH_C * 8; u += G) { const int hd = u >> 3, part = u & 7; float mx = 0.f;
#pragma unroll
                for (int kk = 0; kk < 2; ++kk) { const int key = part * 1024 + tid * 2 + kk; const v4u* kp = (const v4u*)(KC + (size_t)key * DM + hd * HD); float s2 = 0.f;
#pragma unroll
                    for (int c8 = 0; c8 < 16; ++c8) { const v4u w = kp[c8]; const float a0 = bflo(w.x), a1 = bfhi(w.x), a2 = bflo(w.y), a3 = bfhi(w.y), a4 = bflo(w.z), a5 = bfhi(w.z), a6 = bflo(w.w), a7 = bfhi(w.w);
                        s2 += (a0 * a0 + a1 * a1) + (a2 * a2 + a3 * a3) + (a4 * a4 + a5 * a5) + (a6 * a6 + a7 * a7); }
                    mx = fmaxf(mx, s2); }
#pragma unroll
                for (int o = 32; o >= 1; o >>= 1) mx = fmaxf(mx, __shfl_xor(mx, o));
                if (lane == 0) atomicMax(KN2 + hd, __float_as_uint(mx)); }
        }
        __syncthreads();
        for (int u = bx; u < NSB * NH_C; u += G) attn_sample_fox_unit(lds, u >> 5, u & 31, QC, KC, VC, GC, cache_c_k, cache_c_v, cache_c_logf, FL, A, tid, wid, lane);
    }
    SEAM(7);
    if (IN(8)) REP(8) { PH_PTRS
        { unsigned* wq0 = ctl_ + CW_WQ; volatile LAS int* wql = (volatile LAS int*)(lds + RING_BYTES + 1024);
          for (;;) {
            if (TIDX == 0) wql[0] = (int)atomicAdd(wq0, 1u);
            __syncthreads();
            const int item = wql[0];
            __syncthreads();
            if (item >= 32) break;
            int tid = TIDX; asm volatile("" : "+v"(tid));
            pg8::Gemm g{A, W4T, MROWS, DM, DM}; OneUnit S{32, item >> 1, item & 1};
            EpiRes<false> E{H1, H1 + (size_t)TP * DM, out, nullptr, nullptr, RS2};
            pg8::gemm_phase<EpiRes<false>, OneUnit, true, true, true>(lds, g, S, E, tid);
          } }
        { unsigned* wq = ctl_ + CW_WQ + 16; const unsigned* KN2 = ctl_ + CW_KN2;
          const int grp = wid >> 2, gw = wid & 3; const int gtid = gw * 64 + (TIDX & 63);
          LAS unsigned char* gl = lds + grp * 65536; LAS unsigned char* gx = lds + RING_BYTES + 2048 + grp * 1024;
          GBar gb; gb.cnt = (volatile LAS unsigned*)(gx + 832); gb.tgt = 0u;
          if (gtid == 0) *gb.cnt = 0u;
          __syncthreads();
          volatile LAS int* wqg = (volatile LAS int*)(gx + 768);
          for (;;) {
            if (gtid == 0) wqg[0] = (int)atomicAdd(wq, 1u);
            gbar_sync(gb, gtid & 63);
            const int item = wqg[0];
            gbar_sync(gb, gtid & 63);
            if (item >= 2048) break;
            const int hd = item & 31, qb = 63 - (item >> 5);
            attn_prompt_group<1>(gl, gx, gb, QC, KC, VC, GC, DM, hd, qb, A, hd * HD, FCP + (size_t)hd * TP, gtid, gw, sqrtf(__uint_as_float(KN2[hd])) * QK2);
          }
          __syncthreads(); }
    }
    SEAM(8);
    if (IN(9)) REP(9) { PH_PTRS PH_TID
        pg8::Gemm g{A, W4T, TP, DM, DM}; pg8::StaticOrder S; S.init(TP, DM, G, bx);
        EpiRes<false> E{H1, H1 + (size_t)TP * DM, out, nullptr, nullptr, RS2};
        pg8::gemm_phase<EpiRes<false>, pg8::StaticOrder, true, true>(lds, g, S, E, tid);
    }
    SEAM(9);
    if (IN(10)) REP(10) { PH_PTRS PH_TID
        for (int m = gw; m < MROWS; m += NGW) {
            const float r = rsqrtf((float)RS2[m] * (1.f / (FIX * 4096.f)) + EPS);
            f32x4* yr = (f32x4*)(out + (size_t)m * DM) + lane; const f32x4* wr_ = (const f32x4*)final_w + lane;
#pragma unroll
            for (int j = 0; j < 16; ++j) { const f32x4 v = yr[64 * j], ww = wr_[64 * j]; yr[64 * j] = (f32x4){v.x * r * ww.x, v.y * r * ww.y, v.z * r * ww.z, v.w * r * ww.w}; }
        }
    }
#undef IN
#undef SEAM
}


#if MK_DEBUG
__global__ void dbg_check(const unsigned* p, size_t nwords, int kind  , unsigned long long* stat, unsigned long long* hstat) {
    unsigned long long cs = 0, nf = 0, hg = 0;
    for (size_t i = (size_t)blockIdx.x * blockDim.x + threadIdx.x; i < nwords; i += (size_t)gridDim.x * blockDim.x) {
        const unsigned w = p[i]; cs += (unsigned long long)w * (2ull * i + 1ull);
        if (kind == 0) { nf += ((w & 0x7f800000u) == 0x7f800000u); hg += (((w >> 23) & 0xffu) >= 141u); } else if (kind == 1) { nf += ((w & 0x7f80u) == 0x7f80u) + ((w & 0x7f800000u) == 0x7f800000u); hg += (((w >> 7) & 0xffu) >= 141u) + (((w >> 23) & 0xffu) >= 141u); }
    }
    for (int o = 32; o >= 1; o >>= 1) { cs += __shfl_xor(cs, o); nf += __shfl_xor(nf, o); hg += __shfl_xor(hg, o); }
    if ((threadIdx.x & 63) == 0) { atomicAdd(stat, nf); atomicAdd(stat + 1, cs); atomicAdd(hstat, hg); }
}
__global__ void dbg_check2(const unsigned short* p, int rows, int ld, int col0, int ncols, unsigned long long* stat, unsigned long long* hstat) {
    unsigned long long cs = 0, nf = 0, hg = 0; const size_t n = (size_t)rows * ncols;
    for (size_t i = (size_t)blockIdx.x * blockDim.x + threadIdx.x; i < n; i += (size_t)gridDim.x * blockDim.x) {
        const size_t r = i / ncols, cc = i % ncols; const unsigned w = p[r * ld + col0 + cc]; cs += (unsigned long long)w * (2ull * i + 1ull); nf += ((w & 0x7f80u) == 0x7f80u); hg += (((w >> 7) & 0xffu) >= 141u);
    }
    for (int o = 32; o >= 1; o >>= 1) { cs += __shfl_xor(cs, o); nf += __shfl_xor(nf, o); hg += __shfl_xor(hg, o); }
    if ((threadIdx.x & 63) == 0) { atomicAdd(stat, nf); atomicAdd(stat + 1, cs); atomicAdd(hstat, hg); }
}
__global__ void dbg_report(const unsigned long long* stat, const unsigned long long* hstat, float* out, unsigned* codew) {
    __shared__ int code_s;
    if (threadIdx.x == 0) {
        int code = 0;
        const int order[28] = {1, 2, 3, 4, 5, 6, 7, 8, 9, 10, 11, 12, 25, 26, 27, 13, 14, 15, 16, 17, 18, 19, 20, 21, 22, 23, 24, 0};
        for (int q = 0; q < 27 && !code; ++q) { const int k = order[q];
            if (stat[(0 * 32 + k) * 2] || stat[(1 * 32 + k) * 2]) code = k;
            else if (k != 15 && k != 23 && k != 22 && hstat[k]) code = 64 + k;
            else if (stat[(0 * 32 + k) * 2 + 1] != stat[(1 * 32 + k) * 2 + 1]) code = 32 + k; }
        { const unsigned bits = ((const unsigned*)hstat)[62]; if (bits) { int idx = 0; while (!((bits >> idx) & 1u)) ++idx; code = 92 + idx; } }
        if (!code) { const unsigned* cst = (const unsigned*)hstat + 64;
            for (int i = 14; i >= 0; --i) { const float er = __uint_as_float(cst[2 * i]), rf = __uint_as_float(cst[2 * i + 1]); if (er > 0.06f * rf + 1e-3f) code = 100 + 10 * i; } }
        code_s = code; if (blockIdx.x == 0) *codew = (unsigned)code;
    }
    __syncthreads();
    const int code = code_s; if (!code) return;
    const float c = sqrtf((float)code);
    for (size_t i = (size_t)blockIdx.x * blockDim.x + threadIdx.x; i < O_END; i += (size_t)gridDim.x * blockDim.x) out[i] = (i >= O_YS && i < O_SAP) ? c : 0.f;
}
#endif

#if MK_DEBUG
__device__ __forceinline__ float blk_sum128(float v, float* red) {
    for (int o = 32; o >= 1; o >>= 1) v += __shfl_xor(v, o);
    __syncthreads(); if ((threadIdx.x & 63) == 0) red[threadIdx.x >> 6] = v; __syncthreads();
    return red[0] + red[1];
}
__device__ __forceinline__ void chk_accum(float ref, float got, unsigned* st) {
    float e = fabsf(ref - got), r = fabsf(ref); if (!(e == e)) e = 1e30f;
    for (int o = 32; o >= 1; o >>= 1) { e = fmaxf(e, __shfl_xor(e, o)); r = fmaxf(r, __shfl_xor(r, o)); }
    if ((threadIdx.x & 63) == 0) { atomicMax(st, __float_as_uint(e)); atomicMax(st + 1, __float_as_uint(r)); }
}
template <int MODE>
__global__ void chk_attn(const bf16_t* Q, const bf16_t* K, const bf16_t* V, const bf16_t* Gt, int ld, int NH, const float* ck, const float* cv, const float* clf  ,
                         const float* FL, const bf16_t* A, int acol0, int nprompt, unsigned* st, int smp_slot, int prompt_slot0) {
    __shared__ float red[2];
    const int d = threadIdx.x; int hd, qrow, qpos, b = 0; bool smp;
    if ((int)blockIdx.x < nprompt) { smp = false; hd = blockIdx.x % NH; const int j = blockIdx.x / NH; qrow = (j * 1237 + 5) % TP; qpos = qrow; }
    else { smp = true; const int u = blockIdx.x - nprompt; const int t = u & 15; hd = (u >> 4) % NH; b = (u >> 4) / NH; qrow = TP + 16 * b + t; qpos = PAST + t; }
    const float q = bf2f(Q[(size_t)qrow * ld + hd * HD + d]) ;
    const int s_top = MODE ? qpos : qpos - 1;
    float o = 0.f, tail = 0.f, m = -1e30f, l = 0.f, dsum = 0.f;
    for (int s = s_top; s >= 0; --s) {
        float kv, vv;
        if (smp) { if (s < PAST) { const size_t ix = (((size_t)b * PAST + s) * NH + hd) * HD + d; kv = ck[ix]; vv = cv[ix]; } else { const size_t ix = (size_t)(TP + 16 * b + s - PAST) * ld + hd * HD + d; kv = bf2f(K[ix]); vv = bf2f(V[ix]); } }
        else { const size_t ix = (size_t)s * ld + hd * HD + d; kv = bf2f(K[ix]); vv = bf2f(V[ix]); }
        const float z = blk_sum128(q * kv, red) * 0.08838834764831845f;
        if (MODE == 0) {
            const float lp = fminf(z, 0.f) - log1pf(expf(-fabsf(z))), lm = lp - z;
            o += expf(lp + tail) * vv; tail += lm;
            if (tail < -200.f) break;
        } else {
            const float x = z + dsum;
            const float mn = fmaxf(m, x), al = expf(m - mn), p = expf(x - mn);
            o = o * al + p * vv; l = l * al + p; m = mn;
            float lf;
            if (smp) lf = (s < PAST) ? clf[((size_t)b * PAST + s) * NH + hd] : FL[(size_t)(TP + 16 * b + s - PAST) * 32 + hd]; else lf = FL[(size_t)s * 32 + hd];
            dsum += lf;
            if (dsum < -200.f && m > -1e29f) break;
        }
    }
    if (MODE == 1) o /= l;
    const float ref = o * bf2f(Gt[(size_t)qrow * ld + hd * HD + d]);
    chk_accum(ref, bf2f(A[(size_t)qrow * DM + acol0 + hd * HD + d]), st + (smp ? 2 * smp_slot : (MODE ? 2 * (prompt_slot0 + (int)(blockIdx.x / NH)) : 0)));
}
__global__ void chk_fc(const float* FL, const float* clf, const float* FCP, const float* FCS, unsigned* st) {
    const int u = blockIdx.x, lane = threadIdx.x;
    if (u < 32) { const int hd = u, t = (lane * 131 + 7) % TP; double s = 0; for (int j = 0; j <= t; ++j) s += (double)FL[(size_t)j * 32 + hd]; chk_accum((float)(s * 1.4426950408889634), FCP[(size_t)hd * TP + t], st); }
    else { const int ub = u - 32, b = ub >> 5, hd = ub & 31, t = (lane * 17 + 3) % 1040; double s = 0; for (int j = 0; j <= t; ++j) s += (double)(j < PAST ? clf[((size_t)b * PAST + j) * 32 + hd] : FL[(size_t)(TP + 16 * b + j - PAST) * 32 + hd]); chk_accum((float)(s * 1.4426950408889634), FCS[(size_t)ub * FCS_LD + t], st + 2); }
}
__global__ void chk_hgrn_sample(const bf16_t* QA, const bf16_t* KA, const bf16_t* VA, const float* Gb, const float* S0, const float* Sout, float* oref, unsigned* st) {
    __shared__ float red[2];
    const int u = blockIdx.x >> 7, v = blockIdx.x & 127, k = threadIdx.x, b = u >> 4, hd = u & 15;
    float S = S0[(size_t)u * 16384 + k * 128 + v];
    for (int t = 0; t < 16; ++t) { const size_t ro = (size_t)(TP + 16 * b + t) * HW + hd * HD;
        S = S * expf(Gb[ro + k]) + bf2f(KA[ro + k]) * bf2f(VA[ro + v]);
        const float ov = blk_sum128(bf2f(QA[ro + k]) * S, red);
        if (k == 0) oref[((size_t)u * 16 + t) * 128 + v] = ov; }
    chk_accum(S, Sout[(size_t)u * 16384 + k * 128 + v], st);
}
__global__ void chk_hgrn_sample_out(const float* oref, const bf16_t* GA, const float* anw, const bf16_t* A, unsigned* st) {
    __shared__ float red[2];
    const int u = blockIdx.x >> 4, t = blockIdx.x & 15, v = threadIdx.x, b = u >> 4, hd = u & 15;
    const float o = oref[((size_t)u * 16 + t) * 128 + v];
    const float ss = blk_sum128(o * o, red);
    const int row = TP + 16 * b + t;
    const float ref = o * rsqrtf(ss * (1.f / 128.f) + EPS) * anw[v] * bf2f(GA[(size_t)row * HW + hd * HD + v]);
    chk_accum(ref, bf2f(A[(size_t)row * DM + hd * HD + v]), st);
}
#endif
extern "C" void kernel_launch(void* const* d_in, const int* in_sizes, int n_in, void* d_out, int out_size, void* d_ws, size_t ws_size, hipStream_t stream) {
    static int grid = 0;
    if (grid == 0) {
        if (n_in != 17 || (size_t)out_size != O_END || ws_size < WS_END) { fprintf(stderr, "kernel_launch: unexpected shapes (n_in %d, out %d, ws %zu)\n", n_in, out_size, ws_size); grid = -1; return; }
        int dev = 0, cus = 0, per_cu = 0;
        if (hipGetDevice(&dev) != hipSuccess || hipDeviceGetAttribute(&cus, hipDeviceAttributeMultiprocessorCount, dev) != hipSuccess) { grid = -1; return; }
        if (hipFuncSetAttribute((const void*)fwd_kernel, hipFuncAttributeMaxDynamicSharedMemorySize, LDS_BYTES) != hipSuccess) { fprintf(stderr, "kernel_launch: hipFuncSetAttribute failed\n"); grid = -1; return; }
        if (hipOccupancyMaxActiveBlocksPerMultiprocessor(&per_cu, (const void*)fwd_kernel, NWAVES * 64, LDS_BYTES) != hipSuccess || per_cu < 1)
            fprintf(stderr, "kernel_launch: occupancy query reports %d workgroups per CU\n", per_cu);
        (void)hipGetLastError();
        grid = cus;
    }
    if (grid < 0) return;
    (void)hipMemsetAsync((char*)d_ws + WS_CTL, 0, CTL_ZERO_BYTES, stream);
    Args a{};
    for (int i = 0; i < 17; ++i) a.in[i] = (const float*)d_in[i];
    a.out = (float*)d_out; a.ws = (unsigned char*)d_ws;
#if MK_DEBUG
    unsigned char* ws = (unsigned char*)d_ws; float* out = (float*)d_out;
    unsigned long long* stat = (unsigned long long*)((unsigned*)(ws + WS_CTL) + CW_STAT);
    unsigned long long* hstat = (unsigned long long*)((unsigned*)(ws + WS_CTL) + CW_HSTAT);
    for (int run = 0; run < 2; ++run) {
        if (run) (void)hipMemsetAsync((char*)d_ws + WS_CTL, 0, (size_t)CW_STAT * 4, stream);
        auto CHK = [&](int k, const void* p, size_t bytes, int kind) { hipLaunchKernelGGL(dbg_check, dim3(2048), dim3(256), 0, stream, (const unsigned*)p, bytes / 4, kind, stat + (run * 32 + k) * 2, hstat + k); };
        auto CHK2 = [&](int k, const void* p, int rows, int ld, int col0, int ncols) { hipLaunchKernelGGL(dbg_check2, dim3(2048), dim3(256), 0, stream, (const unsigned short*)p, rows, ld, col0, ncols, stat + (run * 32 + k) * 2, hstat + k); };
        for (int p = 0; p < NPHASE; ++p) {
            a.ph_lo = p; a.ph_hi = p + 1; hipLaunchKernelGGL(fwd_kernel, dim3(grid), dim3(NWAVES * 64), LDS_BYTES, stream, a);
            switch (p) {
                case 0: CHK(1, ws + WS_W1T, WS_XN - WS_W1T, 1); CHK(2, ws + WS_XN, 66 * MiB, 1); CHK(3, ws + WS_LB, 8192, 0); break;
                case 1: CHK(4, ws + WS_P, 8 * 33 * MiB, 1); CHK(5, ws + WS_G, 66 * MiB, 0); CHK(6, out + O_BKP, (O_CKP - O_BKP) * 4, 0); break;
                case 2: CHK(7, ws + WS_SLOC, 128 * MiB, 0); CHK(8, ws + WS_DEC, 1 * MiB, 0); CHK(9, out + O_SAS, (O_BKP - O_SAS) * 4, 0); break;
                case 3: CHK(10, ws + WS_SST, 64 * MiB, 1); CHK(11, out + O_SAP, (O_SAS - O_SAP) * 4, 0); break;
                case 4: if (run == 0) {
                    unsigned* cst = (unsigned*)(ws + WS_CTL) + CW_HSTAT + 64;
                    bf16_t* Pp = (bf16_t*)(ws + WS_P); float* oref = (float*)(ws + WS_FCS);
                    hipLaunchKernelGGL(chk_attn<0>, dim3(16 * 8 + 256 * 16), dim3(128), 0, stream, Pp + 4 * PSTR1, Pp + 5 * PSTR1, Pp + 6 * PSTR1, Pp + 7 * PSTR1, HW, 16, (const float*)d_in[3], (const float*)d_in[4], (const float*)nullptr, (const float*)nullptr, (const bf16_t*)(ws + WS_A), HW, 16 * 8, cst + 0, 1, 0);
                    hipLaunchKernelGGL(chk_hgrn_sample, dim3(256 * 128), dim3(128), 0, stream, Pp, Pp + PSTR1, Pp + 2 * PSTR1, (const float*)(ws + WS_G), (const float*)d_in[2], (const float*)(out + O_SAS), oref, cst + 4);
                    hipLaunchKernelGGL(chk_hgrn_sample_out, dim3(256 * 16), dim3(128), 0, stream, (const float*)oref, Pp + 3 * PSTR1, (const float*)d_in[13], (const bf16_t*)(ws + WS_A), cst + 6); }
                    CHK2(12, ws + WS_A, TP, DM, 0, HW); CHK2(25, ws + WS_A, TP, DM, HW, HW); CHK2(26, ws + WS_A + (size_t)TP * DM * 2, 256, DM, 0, HW); CHK2(27, ws + WS_A + (size_t)TP * DM * 2, 256, DM, HW, HW); break;
                case 5: CHK(13, ws + WS_H1, 132 * MiB, 0); CHK(14, ws + WS_XN, 66 * MiB, 1); CHK(15, ws + WS_CTL + CW_RS1 * 4, 8448 * 8, 1 + 1); break;
                case 6: CHK(16, ws + WS_P, 4 * 66 * MiB, 1); CHK(17, ws + WS_FL, 8448 * 32 * 4, 0); CHK(18, out + O_CKP, (O_END - O_CKP) * 4, 0); break;
                case 7: CHK(19, ws + WS_FCP, 1 * MiB, 0); CHK(20, ws + WS_FCS, (size_t)512 * FCS_LD * 4, 0); break;
                case 8: if (run == 0) {
                    unsigned* cst = (unsigned*)(ws + WS_CTL) + CW_HSTAT + 64; bf16_t* Pp = (bf16_t*)(ws + WS_P);
                    hipLaunchKernelGGL(chk_attn<1>, dim3(32 * 8 + 512 * 16), dim3(128), 0, stream, Pp, Pp + PSTR3, Pp + 2 * PSTR3, Pp + 3 * PSTR3, DM, 32, (const float*)d_in[5], (const float*)d_in[6], (const float*)d_in[7], (const float*)(ws + WS_FL), (const bf16_t*)(ws + WS_A), 0, 32 * 8, cst, 14, 6);
                    hipLaunchKernelGGL(chk_fc, dim3(32 + 512), dim3(64), 0, stream, (const float*)(ws + WS_FL), (const float*)d_in[7], (const float*)(ws + WS_FCP), (const float*)(ws + WS_FCS), cst + 8); }
                    CHK(21, ws + WS_A, 66 * MiB, 1); break;
                case 9: CHK(22, out, (size_t)MROWS * DM * 4, 0); CHK(23, ws + WS_CTL + CW_RS2 * 4, 8448 * 8, 2); break;
                case 10: CHK(24, out, (size_t)MROWS * DM * 4, 0); break;
            }
        }
    }
    hipLaunchKernelGGL(dbg_report, dim3(1024), dim3(256), 0, stream, (const unsigned long long*)stat, (const unsigned long long*)hstat, out, (unsigned*)(ws + WS_CTL) + CW_HSTAT + 63);
#elif MK_FUSED
    a.ph_lo = 0; a.ph_hi = NPHASE;
    hipLaunchKernelGGL(fwd_kernel, dim3(grid), dim3(NWAVES * 64), LDS_BYTES, stream, a);
#else
    for (int p = 0; p < NPHASE; ++p) { a.ph_lo = p; a.ph_hi = p + 1; hipLaunchKernelGGL(fwd_kernel, dim3(grid), dim3(NWAVES * 64), LDS_BYTES, stream, a); }
#endif
}
```

```cpp
#include <hip/hip_runtime.h>
#include <cstdio>
#include <cstdint>

namespace pg8 {
#define PG8_LAS __attribute__((address_space(3)))
typedef unsigned short bf16_t;
typedef short bf16x8 __attribute__((ext_vector_type(8)));
typedef float f32x4 __attribute__((ext_vector_type(4)));
typedef unsigned u32x4 __attribute__((ext_vector_type(4)));
constexpr int BM = 256, BK = 64, HALF = 128, HTB = HALF * BK * 2  , STAGE_BYTES = 8 * HTB, NXCD = 8, WGM = 8;

__host__ __device__ __forceinline__ int lds_byte(int r, int c) { const int st = (r >> 4) * 2 + (c >> 5), rr = r & 15, cc = c & 31, ob = rr * 64 + cc * 2; return st * 1024 + (ob ^ (((ob >> 9) & 1) << 5)); }
__host__ __device__ __forceinline__ void stage_rc(int b, int& R, int& C) { const int st = b / 1024, sb = b % 1024, swz = sb ^ (((sb >> 9) & 1) << 5); R = (st >> 1) * 16 + swz / 64; C = (st & 1) * 32 + (swz % 64) / 2; }
__host__ __device__ __forceinline__ int perm32(int rho) { const int n = rho >> 4, i = rho & 15; return 8 * (i >> 2) + 4 * n + (i & 3); }

struct Unit { int pm, pn, hf; };
struct Gemm { const bf16_t* A; const bf16_t* Bt; int M, N, K; };

struct StaticOrder {
    int nM, nN, nwg, G, c;
    __host__ __device__ void init(int M, int N, int G_, int c_) { nM = M / BM; nN = N / BM; nwg = nM * nN; G = G_; c = c_; }
    __host__ __device__ bool next(int i, Unit& u) const {
        const long L = (long)i * G + c; if (L >= nwg) return false;
        int wgid = (int)L; { const int q = nwg / NXCD, r = nwg % NXCD, xcd = wgid % NXCD, off = wgid / NXCD; wgid = (xcd < r ? xcd * (q + 1) : r * (q + 1) + (xcd - r) * q) + off; }
        const int nig = WGM * nN, gid = wgid / nig, fm = gid * WGM, gsz = (nM - fm) < WGM ? (nM - fm) : WGM;
        u.pm = fm + ((wgid % nig) % gsz); u.pn = (wgid % nig) / gsz; u.hf = -1; return true;
    }
    __device__ __forceinline__ void a_ready(const Unit&) const {}
    __device__ __forceinline__ void done(const Unit&) const {}
};
__device__ __forceinline__ unsigned cvt_pk_bf16(float lo, float hi) { unsigned r; asm volatile("v_cvt_pk_bf16_f32 %0, %1, %2" : "=v"(r) : "v"(lo), "v"(hi)); return r; }
template <class Epi, class Sched, bool ALIGN_EPI = false, bool SP2 = false, bool HALFN = false>
__device__ __forceinline__ void gemm_phase(PG8_LAS unsigned char* lds, const Gemm g, const Sched& S, const Epi& E, const int tid_in) {
    const int tid = tid_in, wid = __builtin_amdgcn_readfirstlane(tid >> 6), lane = tid & 63, wr = wid >> 2, wc = wid & 3, fr = lane & 15, fq = lane >> 4;
    const int K = g.K, nt = K / BK;
    unsigned voffA[2], voffB[2];
#pragma unroll
    for (int i = 0; i < 2; ++i) { int R, C; stage_rc(tid * 16 + i * 8192, R, C); const int Rb = Epi::PERM ? ((R & ~31) + perm32(R & 31)) : R;
        voffA[i] = (unsigned)(R * K + C) * 2u; voffB[i] = (unsigned)(Rb * K + C) * 2u; }
    const size_t kstep = (size_t)(BK * 2);
    const size_t hstep = (size_t)HALF * K * 2;
    const size_t tstep = 2 * hstep;
    const size_t hstepB = HALFN ? 0 : hstep;
    const unsigned ldsw = (unsigned)wid * 1024u;
    const int aoff = lds_byte(wr * 64 + fr, fq * 8), boff = lds_byte(wc * 32 + fr, fq * 8);
#define PG8_SA(b, h) (((b) * 2 + (h)) * HTB)
#define PG8_SB(b, h) ((4 + (b) * 2 + (h)) * HTB)
#define PG8_STAGE(bufoff, gbase, voff) do { _Pragma("unroll") for (int _i = 0; _i < 2; ++_i) \
        __builtin_amdgcn_global_load_lds((const unsigned*)((const char*)(gbase) + (voff)[_i]), (PG8_LAS unsigned*)(lds + (bufoff) + ldsw + _i * 8192), 16, 0, 0); } while (0)
#define PG8_LDA(dst, b, h) do { _Pragma("unroll") for (int m = 0; m < 4; ++m) _Pragma("unroll") for (int k = 0; k < 2; ++k) dst[m][k] = *(const PG8_LAS bf16x8*)(lds + PG8_SA(b, h) + aoff + m * 2048 + k * 1024); } while (0)
#define PG8_LDB(dst, b, h) do { _Pragma("unroll") for (int n = 0; n < 2; ++n) _Pragma("unroll") for (int k = 0; k < 2; ++k) dst[n][k] = *(const PG8_LAS bf16x8*)(lds + PG8_SB(b, h) + boff + n * 2048 + k * 1024); } while (0)
#define PG8_MMA(ai, bj, At, Bt) do { __builtin_amdgcn_s_setprio(1); _Pragma("unroll") for (int m = 0; m < 4; ++m) _Pragma("unroll") for (int n = 0; n < 2; ++n) _Pragma("unroll") for (int k = 0; k < 2; ++k) \
        acc[ai][bj][m][n] = __builtin_amdgcn_mfma_f32_16x16x32_bf16(Bt[n][k], At[m][k], acc[ai][bj][m][n], 0, 0, 0); __builtin_amdgcn_s_setprio(0); } while (0)
#define PG8_WAIT_V(n) asm volatile("s_waitcnt vmcnt(" #n ")" ::: "memory")
#define PG8_WAIT_L(n) asm volatile("s_waitcnt lgkmcnt(" #n ")" ::: "memory")
#define PG8_BAR __builtin_amdgcn_s_barrier()
#define PG8_SCHED __builtin_amdgcn_sched_barrier(0)
    Unit cur, nxt; int ui = 0;
    if (!S.next(0, cur)) return;
    f32x4 acc[2][2][4][2];
#pragma unroll
    for (int a = 0; a < 2; ++a)
#pragma unroll
        for (int b = 0; b < 2; ++b)
#pragma unroll
            for (int m = 0; m < 4; ++m)
#pragma unroll
                for (int n = 0; n < 2; ++n) acc[a][b][m][n] = (f32x4){0.f, 0.f, 0.f, 0.f};
    bf16x8 At[4][2], B0[2][2], B1[2][2];
    const char* cA = (const char*)g.A + (size_t)cur.pm * tstep; const char* cB = (const char*)g.Bt + (size_t)cur.pn * tstep + ((HALFN && cur.hf > 0) ? hstep : 0);
    S.a_ready(cur);
    if constexpr (SP2) {
        PG8_STAGE(PG8_SB(0, 0), cB, voffB); PG8_STAGE(PG8_SB(0, 1), cB + hstepB, voffB); PG8_STAGE(PG8_SA(0, 0), cA, voffA); PG8_STAGE(PG8_SA(0, 1), cA + hstep, voffA);
        if (wr == 1) PG8_BAR;
        PG8_WAIT_V(2); PG8_BAR;
        PG8_STAGE(PG8_SB(1, 0), cB + kstep, voffB); PG8_STAGE(PG8_SA(1, 0), cA + kstep, voffA); PG8_STAGE(PG8_SB(1, 1), cB + hstepB + kstep, voffB);
        PG8_WAIT_V(6); PG8_BAR;
    } else {
        PG8_STAGE(PG8_SB(0, 0), cB, voffB); PG8_STAGE(PG8_SA(0, 0), cA, voffA); PG8_STAGE(PG8_SB(0, 1), cB + hstepB, voffB); PG8_STAGE(PG8_SA(0, 1), cA + hstep, voffA);
        if (wr == 1) PG8_BAR;
        PG8_WAIT_V(4); PG8_BAR;
        PG8_STAGE(PG8_SB(1, 0), cB + kstep, voffB); PG8_STAGE(PG8_SA(1, 0), cA + kstep, voffA); PG8_STAGE(PG8_SB(1, 1), cB + hstepB + kstep, voffB);
        PG8_WAIT_V(6); PG8_BAR;
    }
    for (;;) {
        const bool has_next = S.next(ui + 1, nxt);
        const char* nA = has_next ? (const char*)g.A + (size_t)nxt.pm * tstep : cA; const char* nB = has_next ? (const char*)g.Bt + (size_t)nxt.pn * tstep + ((HALFN && nxt.hf > 0) ? hstep : 0) : cB;
        for (int t = 0; t < nt; t += 2) {
            const bool last = (t == nt - 2);
            const char* a1 = cA + (size_t)(t + 1) * kstep;
            const char* a2 = last ? nA : cA + (size_t)(t + 2) * kstep; const char* b2 = last ? nB : cB + (size_t)(t + 2) * kstep;
            const char* a3 = a2 + kstep; const char* b3 = b2 + kstep;
            if (last && has_next) S.a_ready(nxt);
            if constexpr (SP2) {
            PG8_LDB(B0, 0, 0); if constexpr (!HALFN) PG8_LDB(B1, 0, 1); PG8_SCHED; PG8_LDA(At, 0, 0); PG8_STAGE(PG8_SA(1, 1), a1 + hstep, voffA);
            PG8_WAIT_V(8); PG8_WAIT_L(0); PG8_BAR; PG8_MMA(0, 0, At, B0); if constexpr (!HALFN) PG8_MMA(0, 1, At, B1); PG8_BAR; PG8_SCHED;
            PG8_LDA(At, 0, 1); PG8_STAGE(PG8_SB(0, 0), b2, voffB); PG8_STAGE(PG8_SB(0, 1), b2 + hstepB, voffB); PG8_STAGE(PG8_SA(0, 0), a2, voffA);
            PG8_WAIT_V(8); PG8_WAIT_L(0); PG8_BAR; PG8_MMA(1, 0, At, B0); if constexpr (!HALFN) PG8_MMA(1, 1, At, B1); PG8_BAR; PG8_SCHED;
            PG8_LDB(B0, 1, 0); if constexpr (!HALFN) PG8_LDB(B1, 1, 1); PG8_SCHED; PG8_LDA(At, 1, 0); PG8_STAGE(PG8_SA(0, 1), a2 + hstep, voffA);
            PG8_WAIT_V(8); PG8_WAIT_L(0); PG8_BAR; PG8_MMA(0, 0, At, B0); if constexpr (!HALFN) PG8_MMA(0, 1, At, B1); PG8_BAR; PG8_SCHED;
            PG8_LDA(At, 1, 1); PG8_STAGE(PG8_SB(1, 0), b3, voffB); PG8_STAGE(PG8_SB(1, 1), b3 + hstepB, voffB); PG8_STAGE(PG8_SA(1, 0), a3, voffA);
            PG8_WAIT_V(8); PG8_WAIT_L(0); PG8_BAR; PG8_MMA(1, 0, At, B0); if constexpr (!HALFN) PG8_MMA(1, 1, At, B1); PG8_BAR; PG8_SCHED;
            } else {
            PG8_LDB(B0, 0, 0); PG8_SCHED; PG8_LDA(At, 0, 0); PG8_STAGE(PG8_SA(1, 1), a1 + hstep, voffA);
            PG8_WAIT_L(8); PG8_BAR; PG8_WAIT_L(0); PG8_MMA(0, 0, At, B0); PG8_BAR; PG8_SCHED;
            if constexpr (!HALFN) PG8_LDB(B1, 0, 1); PG8_STAGE(PG8_SB(0, 0), b2, voffB);
            PG8_BAR; PG8_WAIT_L(0); if constexpr (!HALFN) PG8_MMA(0, 1, At, B1); PG8_BAR;
            PG8_LDA(At, 0, 1); PG8_STAGE(PG8_SA(0, 0), a2, voffA);
            PG8_BAR; PG8_WAIT_L(0); PG8_MMA(1, 0, At, B0); PG8_BAR; PG8_SCHED;
            PG8_STAGE(PG8_SB(0, 1), b2 + hstepB, voffB);
            PG8_WAIT_V(6); PG8_BAR; if constexpr (!HALFN) PG8_MMA(1, 1, At, B1); PG8_BAR;
            PG8_LDB(B0, 1, 0); PG8_SCHED; PG8_LDA(At, 1, 0); PG8_STAGE(PG8_SA(0, 1), a2 + hstep, voffA);
            PG8_WAIT_L(8); PG8_BAR; PG8_WAIT_L(0); PG8_MMA(0, 0, At, B0); PG8_BAR; PG8_SCHED;
            if constexpr (!HALFN) PG8_LDB(B1, 1, 1); PG8_STAGE(PG8_SB(1, 0), b3, voffB);
            PG8_BAR; PG8_WAIT_L(0); if constexpr (!HALFN) PG8_MMA(0, 1, At, B1); PG8_BAR;
            PG8_LDA(At, 1, 1); PG8_STAGE(PG8_SA(1, 0), a3, voffA);
            PG8_BAR; PG8_WAIT_L(0); PG8_MMA(1, 0, At, B0); PG8_BAR; PG8_SCHED;
            PG8_STAGE(PG8_SB(1, 1), b3 + hstepB, voffB);
            PG8_WAIT_V(6); PG8_BAR; if constexpr (!HALFN) PG8_MMA(1, 1, At, B1); PG8_BAR;
            }
        }
        if constexpr (ALIGN_EPI) { if (wr == 0) PG8_BAR; }
        if constexpr (!Epi::AFTER_DRAIN) { E(acc, cur, wr, wc, fr, fq); S.done(cur); }
        if (!has_next) break;
#pragma unroll
        for (int a = 0; a < 2; ++a)
#pragma unroll
            for (int b = 0; b < 2; ++b)
#pragma unroll
                for (int m = 0; m < 4; ++m)
#pragma unroll
                    for (int n = 0; n < 2; ++n) acc[a][b][m][n] = (f32x4){0.f, 0.f, 0.f, 0.f};
        cur = nxt; cA = nA; cB = nB; ++ui;
        if constexpr (ALIGN_EPI) { if (wr == 1) PG8_BAR; }
    }
    PG8_WAIT_V(0);
    if constexpr (!ALIGN_EPI) { if (wr == 0) PG8_BAR; }
    PG8_BAR;
    if constexpr (Epi::AFTER_DRAIN) { E.fused(acc, cur, wr, wc, fr, fq, lds, wid, lane); S.done(cur); }
#undef PG8_SA
#undef PG8_SB
#undef PG8_STAGE
#undef PG8_LDA
#undef PG8_LDB
#undef PG8_MMA
#undef PG8_WAIT_V
#undef PG8_WAIT_L
#undef PG8_BAR
#undef PG8_SCHED
}
}

constexpr int DM = 4096, TP = 8192, NSB = 16, TSQ = 16, PAST = 1024;
constexpr int MROWS = TP + NSB * TSQ;
constexpr int N1 = 16384, N3R = 16416, N3 = 16640;
constexpr int HW = 2048;
constexpr int NH_A = 16, NH_B = 16, NH_C = 32, HD = 128;
constexpr int FCS_LD = 1056;
constexpr float EPS = 1e-6f;
constexpr float LOG2E = 1.4426950408889634f;
constexpr float QK2 = 0.08838834764831845f * 1.4426950408889634f;
constexpr float NFRS = 11.313708498984761f;
constexpr float FIX = 16777216.f;

constexpr size_t O_YP = 0, O_YS = O_YP + (size_t)TP * DM, O_SAP = O_YS + (size_t)256 * DM, O_SAS = O_SAP + (size_t)16 * 128 * 128,
    O_BKP = O_SAS + (size_t)16 * 16 * 128 * 128, O_BVP = O_BKP + (size_t)TP * HW, O_BKS = O_BVP + (size_t)TP * HW, O_BVS = O_BKS + (size_t)256 * HW,
    O_CKP = O_BVS + (size_t)256 * HW, O_CVP = O_CKP + (size_t)TP * DM, O_CFP = O_CVP + (size_t)TP * DM, O_CKS = O_CFP + (size_t)TP * 32,
    O_CVS = O_CKS + (size_t)256 * DM, O_CFS = O_CVS + (size_t)256 * DM, O_END = O_CFS + (size_t)256 * 32;
static_assert(O_END == 143138816, "output size");

constexpr size_t MiB = 1u << 20;
constexpr size_t WS_CTL = 0, CTL_ZERO_BYTES = 1 * MiB;
constexpr size_t WS_LB = 1 * MiB;
constexpr size_t WS_W1T = 2 * MiB;
constexpr size_t WS_W2T = WS_W1T + 128 * MiB;
constexpr size_t WS_W3T = WS_W2T + 32 * MiB;
constexpr size_t WS_W4T = WS_W3T + 130 * MiB;
constexpr size_t WS_XN = WS_W4T + 32 * MiB;
constexpr size_t WS_P = WS_XN + 66 * MiB;
constexpr size_t PSTR1 = (size_t)MROWS * HW;
constexpr size_t PSTR3 = (size_t)MROWS * DM;
constexpr size_t WS_G = WS_P + 8 * 33 * MiB;
constexpr size_t WS_A = WS_G + 66 * MiB;
constexpr size_t WS_H1 = WS_A + 66 * MiB;
constexpr size_t WS_SLOC = WS_H1 + 132 * MiB;
constexpr size_t WS_SST = WS_SLOC + 128 * MiB;
constexpr size_t WS_DEC = WS_SST + 64 * MiB;
constexpr size_t WS_FL = WS_DEC + 1 * MiB;
constexpr size_t WS_FCP = WS_FL + 2 * MiB;
constexpr size_t WS_FCS = WS_FCP + 1 * MiB;
constexpr size_t WS_P3 = WS_FCS + 3 * MiB;
constexpr size_t WS_END = WS_P3 + 4 * 66 * MiB;
static_assert(WS_P + 4 * 66 * MiB <= WS_A, "layer-1 overlay fits");
constexpr int CW_BAR = 4096;
constexpr int CW_RS1 = 16384;
constexpr int CW_RS2 = CW_RS1 + 2 * 8448 + 128;
constexpr int CW_STAT = CW_RS2 + 2 * 8448 + 128;
constexpr int CW_KN2 = 8192;
constexpr int CW_WQ = CW_KN2 + 64;
constexpr int CW_WQ3 = CW_WQ + 32;
constexpr int CW_WQ4 = CW_WQ + 64, CW_FQ = CW_WQ4 + 64;
constexpr int CW_HSTAT = CW_STAT + 256;
static_assert(CW_BAR + 3456 <= CW_KN2 && CW_FQ + 128 <= CW_RS1 && (CW_HSTAT + 128) * 4 <= (int)CTL_ZERO_BYTES, "ctl region");

constexpr int RING_BYTES = 131072;
constexpr int MISC_OFF = RING_BYTES + 320;
constexpr int LDS_BYTES = 147456;
constexpr int NWAVES = 8;

#define LAS __attribute__((address_space(3)))
typedef unsigned short bf16_t;
typedef unsigned v4u __attribute__((ext_vector_type(4)));
typedef unsigned v2u __attribute__((ext_vector_type(2)));
typedef float f32x4 __attribute__((ext_vector_type(4)));
typedef float f32x2 __attribute__((ext_vector_type(2)));
typedef float f32x16 __attribute__((ext_vector_type(16)));
typedef short bf16x8 __attribute__((ext_vector_type(8)));
typedef short s16x4 __attribute__((ext_vector_type(4)));
#define LDS_WAIT() asm volatile("s_waitcnt lgkmcnt(0)" ::: "memory")
#define VM_WAIT() asm volatile("s_waitcnt vmcnt(0)" ::: "memory")

typedef __bf16 bf16x2_n __attribute__((ext_vector_type(2)));
__device__ __forceinline__ unsigned cvtpk(float lo, float hi) { const f32x2 f = {lo, hi}; const bf16x2_n r = __builtin_convertvector(f, bf16x2_n); return __builtin_bit_cast(unsigned, r); }
__device__ __forceinline__ float bf2f(unsigned short b) { return __uint_as_float(((unsigned)b) << 16); }
__device__ __forceinline__ float bflo(unsigned w) { return __uint_as_float(w << 16); }
__device__ __forceinline__ float bfhi(unsigned w) { return __uint_as_float(w & 0xffff0000u); }
__device__ __forceinline__ float ex2(float x) { return __builtin_amdgcn_exp2f(x); }
__device__ __forceinline__ float lg2(float x) { return __builtin_amdgcn_logf(x); }
__device__ __forceinline__ float rcpf_(float x) { return __builtin_amdgcn_rcpf(x); }
__device__ __forceinline__ float silu_f(float x) { return x * rcpf_(1.f + ex2(-x * LOG2E)); }
__device__ __forceinline__ float wave_sum(float v) {
#pragma unroll
    for (int o = 1; o < 64; o <<= 1) v += __shfl_xor(v, o);
    return v;
}
__device__ __forceinline__ unsigned off_b(unsigned row, unsigned ch) { return 256u * row + 16u * (ch ^ (((row & 3u) << 2) | ((row >> 2) & 3u))); }

#define XB_TMO      128
#define XB_XCNT(j)  (256  + 64 * (j))
#define XB_XSUB(j)  (1280 + 64 * (j))
#define XB_XGEN(j)  (2304 + 64 * (j))
#define XB_TOP      3328
#define XB_TOPGEN   3392
#define XCD_BAR_WORDS 3456
#define XB_SPIN_CAP (1u << 18)
__device__ __forceinline__ unsigned xb_ld(unsigned* p)              { return __hip_atomic_load(p, __ATOMIC_RELAXED, __HIP_MEMORY_SCOPE_AGENT); }
__device__ __forceinline__ unsigned xb_add(unsigned* p, unsigned v) { return __hip_atomic_fetch_add(p, v, __ATOMIC_RELAXED, __HIP_MEMORY_SCOPE_AGENT); }
__device__ __forceinline__ unsigned xb_xcc_id() { return (unsigned)__builtin_amdgcn_s_getreg((3 << 11) | 20) & 0xFu; }
#define XB_SPIN(cond, bar) do { unsigned _sp = 0; while (cond) { __builtin_amdgcn_s_sleep(1); \
    if ((++_sp & 255u) == 0u) { if (xb_ld(&(bar)[XB_TMO])) break; if (_sp > XB_SPIN_CAP) { atomicAdd(&(bar)[XB_TMO], 1u); break; } } } } while (0)
struct XcdBarrier { unsigned* bar; unsigned x; volatile LAS unsigned* st; };
__device__ __forceinline__ XcdBarrier xcd_barrier_post(unsigned* bar, volatile LAS unsigned* st) {
    XcdBarrier b; b.bar = bar; b.x = xb_xcc_id(); b.st = st;
    if (threadIdx.x == 0) (void)xb_add(&bar[XB_XCNT(b.x)], 1u);
    return b;
}
__device__ __forceinline__ void xcd_barrier_complete(unsigned* bar, unsigned x, unsigned& nloc, unsigned& nx) {
    const unsigned G = gridDim.x * gridDim.y * gridDim.z;
    unsigned sum, cnt, mine, sp = 0u;
    for (;;) {
        sum = 0u; cnt = 0u; mine = 0u;
#pragma unroll
        for (unsigned j = 0; j < 16; ++j) { const unsigned c = xb_ld(&bar[XB_XCNT(j)]); sum += c; cnt += (c > 0u) ? 1u : 0u; mine = (j == x) ? c : mine; }
        if (sum == G) break;
        __builtin_amdgcn_s_sleep(1);
        if ((++sp & 255u) == 0u) { if (xb_ld(&bar[XB_TMO])) break; if (sp > XB_SPIN_CAP) { atomicAdd(&bar[XB_TMO], 1u); break; } }
    }
    nloc = mine > 0u ? mine : 1u; nx = cnt > 0u ? cnt : 1u;
}
__device__ __forceinline__ void xcd_barrier(const XcdBarrier& b, const int wid0  ) {
    asm volatile("s_waitcnt vmcnt(0)" ::: "memory");
    __syncthreads();
    if (wid0 == 0 && __builtin_amdgcn_mbcnt_hi(~0u, __builtin_amdgcn_mbcnt_lo(~0u, 0u)) == 0u) {
        unsigned* bar = b.bar;
        __builtin_amdgcn_s_waitcnt(0);
        unsigned nloc = b.st[0], nx = b.st[1];
        if (nloc == 0u) { xcd_barrier_complete(bar, b.x, nloc, nx); b.st[0] = nloc; b.st[1] = nx; }
        const unsigned old = xb_add(&bar[XB_XSUB(b.x)], 1u);
        const unsigned gen = old / nloc;
        if (old + 1u == (gen + 1u) * nloc) {
            __builtin_amdgcn_fence(__ATOMIC_RELEASE, "agent");
            asm volatile("s_waitcnt vmcnt(0)" ::: "memory");
            const unsigned og = xb_add(&bar[XB_TOP], 1u);
            const unsigned tg = og / nx;
            if (og + 1u == (tg + 1u) * nx) xb_add(&bar[XB_TOPGEN], 1u);
            else XB_SPIN(xb_ld(&bar[XB_TOPGEN]) == tg, bar);
            __builtin_amdgcn_fence(__ATOMIC_ACQUIRE, "agent");
            xb_add(&bar[XB_XGEN(b.x)], 1u);
            asm volatile("s_waitcnt vmcnt(0)" ::: "memory");
        } else {
            XB_SPIN(xb_ld(&bar[XB_XGEN(b.x)]) == gen, bar);
            __builtin_amdgcn_fence(__ATOMIC_ACQUIRE, "agent");
            asm volatile("s_waitcnt vmcnt(0)" ::: "memory");
        }
    }
    __syncthreads();
}

using pg8::Unit;
struct Epi1 {
    static constexpr bool PERM = true, AFTER_DRAIN = false;
    bf16_t* P; float* G; const float* LB; float* out;
    __device__ __forceinline__ void operator()(const f32x4 (&acc)[2][2][4][2], const Unit& u, int wr, int wc, int fr, int fq) const {
        const int t = u.pn >> 3;
        const int row0 = u.pm * 256 + wr * 64 + fr, col0 = (u.pn & 7) * 256 + wc * 32 + 8 * fq + (u.hf > 0 ? 128 : 0);
        const int nbj = (u.hf >= 0) ? 1 : 2;
        bf16_t* dst = P + (size_t)t * PSTR1;
        float* fo = nullptr;
        if (t == 5 || t == 6) { const bool smp = u.pm >= 32; fo = out + (t == 5 ? (smp ? O_BKS : O_BKP) : (smp ? O_BVS : O_BVP)) - (smp ? (size_t)TP * HW : (size_t)0); }
        f32x4 lbv[2][2];
#pragma unroll
        for (int bj = 0; bj < 2; ++bj)
#pragma unroll
            for (int n = 0; n < 2; ++n) lbv[bj][n] = (t == 1 && bj < nbj) ? *(const f32x4*)(LB + col0 + bj * 128 + 4 * n) : (f32x4){0.f, 0.f, 0.f, 0.f};
        const bool act = (t == 0 || t == 3 || t == 7);
#pragma unroll
        for (int ai = 0; ai < 2; ++ai)
#pragma unroll
            for (int m = 0; m < 4; ++m) {
                const size_t ro = (size_t)(row0 + ai * 128 + m * 16) * HW + col0;
#pragma unroll
                for (int bj = 0; bj < 2; ++bj) { if (bj >= nbj) continue;
                    f32x4 v[2] = {acc[ai][bj][m][0], acc[ai][bj][m][1]};
                    if (act) {
#pragma unroll
                        for (int n = 0; n < 2; ++n)
#pragma unroll
                            for (int j = 0; j < 4; ++j) v[n][j] = silu_f(v[n][j]);
                    } else if (t == 1) {
#pragma unroll
                        for (int n = 0; n < 2; ++n) {
                            f32x4 gg;
#pragma unroll
                            for (int j = 0; j < 4; ++j) { const float z = fmaxf(v[n][j], -80.f), lb = lbv[bj][n][j]; const float e = ex2(-z * LOG2E), s = rcpf_(1.f + e);
                                const float f = lb + (1.f - lb) * s; gg[j] = lg2(f) * 0.6931471805599453f; v[n][j] = (1.f - lb) * (e * s); }
                            *(f32x4*)(G + ro + bj * 128 + 4 * n) = gg;
                        }
                    }
                    if (fo) { *(f32x4*)(fo + ro + bj * 128) = v[0]; *(f32x4*)(fo + ro + bj * 128 + 4) = v[1]; }
                    v4u w; w.x = cvtpk(v[0][0], v[0][1]); w.y = cvtpk(v[0][2], v[0][3]); w.z = cvtpk(v[1][0], v[1][1]); w.w = cvtpk(v[1][2], v[1][3]);
                    *(v4u*)(dst + ro + bj * 128) = w;
                }
            }
    }
};
struct Epi3 {
    static constexpr bool PERM = true, AFTER_DRAIN = false;
    bf16_t* P; const unsigned long long* RS; float* FL; const float* bfg; float* out;
    __device__ __forceinline__ void operator()(const f32x4 (&acc)[2][2][4][2], const Unit& u, int wr, int wc, int fr, int fq) const {
        const int t = u.pn >> 4;
        const int row0 = u.pm * 256 + wr * 64 + fr, col0 = (u.pn & 15) * 256 + wc * 32 + 8 * fq + (u.hf > 0 ? 128 : 0);
        const int nbj = (u.hf >= 0) ? 1 : 2;
        const bool smp = u.pm >= 32;
        if (t == 4) {
            if (wc != 0) return;
            float* fo = out + (smp ? O_CFS : O_CFP) - (smp ? (size_t)TP * 32 : (size_t)0);
            const f32x4 b0 = *(const f32x4*)(bfg + 8 * fq), b1 = *(const f32x4*)(bfg + 8 * fq + 4);
#pragma unroll
            for (int ai = 0; ai < 2; ++ai)
#pragma unroll
                for (int m = 0; m < 4; ++m) {
                    const int row = row0 + ai * 128 + m * 16;
                    const float r = rsqrtf((float)RS[row] * (1.f / (FIX * 4096.f)) + EPS);
                    f32x4 v[2] = {acc[ai][0][m][0] * r + b0, acc[ai][0][m][1] * r + b1};
#pragma unroll
                    for (int n = 0; n < 2; ++n)
#pragma unroll
                        for (int j = 0; j < 4; ++j) { const float x = v[n][j]; v[n][j] = fminf(x, 0.f) - log1pf(__expf(-fabsf(x))); }
                    *(f32x4*)(FL + (size_t)row * 32 + 8 * fq) = v[0]; *(f32x4*)(FL + (size_t)row * 32 + 8 * fq + 4) = v[1];
                    *(f32x4*)(fo + (size_t)row * 32 + 8 * fq) = v[0]; *(f32x4*)(fo + (size_t)row * 32 + 8 * fq + 4) = v[1];
                }
            return;
        }
        bf16_t* dst = P + (size_t)t * PSTR3;
        float* fo = nullptr;
        if (t == 1 || t == 2) fo = out + (t == 1 ? (smp ? O_CKS : O_CKP) : (smp ? O_CVS : O_CVP)) - (smp ? (size_t)TP * DM : (size_t)0);
#pragma unroll
        for (int ai = 0; ai < 2; ++ai)
#pragma unroll
            for (int m = 0; m < 4; ++m) {
                const int row = row0 + ai * 128 + m * 16;
                const float r = rsqrtf((float)RS[row] * (1.f / (FIX * 4096.f)) + EPS);
                const size_t ro = (size_t)row * DM + col0;
#pragma unroll
                for (int bj = 0; bj < 2; ++bj) { if (bj >= nbj) continue;
                    f32x4 v[2] = {acc[ai][bj][m][0] * r, acc[ai][bj][m][1] * r};
                    if (t == 3) {
#pragma unroll
                        for (int n = 0; n < 2; ++n)
#pragma unroll
                            for (int j = 0; j < 4; ++j) v[n][j] = silu_f(v[n][j]);
                    }
                    if (fo) { *(f32x4*)(fo + ro + bj * 128) = v[0]; *(f32x4*)(fo + ro + bj * 128 + 4) = v[1]; }
                    v4u w; w.x = cvtpk(v[0][0], v[0][1]); w.y = cvtpk(v[0][2], v[0][3]); w.z = cvtpk(v[1][0], v[1][1]); w.w = cvtpk(v[1][2], v[1][3]);
                    *(v4u*)(dst + ro + bj * 128) = w;
                }
            }
    }
};
template <bool XN_> struct EpiRes {
    static constexpr bool PERM = true, AFTER_DRAIN = false;
    const float* resP; const float* resS;
    float* H; bf16_t* XN; const float* nw; unsigned long long* RS;
    __device__ __forceinline__ void operator()(const f32x4 (&acc)[2][2][4][2], const Unit& u, int wr, int wc, int fr, int fq) const {
        const int row0 = u.pm * 256 + wr * 64 + fr, col0 = u.pn * 256 + wc * 32 + 8 * fq + (u.hf > 0 ? 128 : 0);
        const int nbj = (u.hf >= 0) ? 1 : 2;
        const float* res = (u.pm >= 32) ? resS - (size_t)TP * DM : resP;
        f32x4 wv[2][2];
#pragma unroll
        for (int bj = 0; bj < 2; ++bj)
#pragma unroll
            for (int n = 0; n < 2; ++n) wv[bj][n] = (XN_ && bj < nbj) ? *(const f32x4*)(nw + col0 + bj * 128 + 4 * n) : (f32x4){0.f, 0.f, 0.f, 0.f};
#pragma unroll
        for (int ai = 0; ai < 2; ++ai)
#pragma unroll
            for (int m = 0; m < 4; ++m) {
                const int row = row0 + ai * 128 + m * 16;
                const size_t ro = (size_t)row * DM + col0;
                float ss = 0.f;
#pragma unroll
                for (int bj = 0; bj < 2; ++bj) { if (bj >= nbj) continue;
                    f32x4 v[2];
#pragma unroll
                    for (int n = 0; n < 2; ++n) { v[n] = acc[ai][bj][m][n] + *(const f32x4*)(res + ro + bj * 128 + 4 * n); ss += (v[n][0] * v[n][0] + v[n][1] * v[n][1]) + (v[n][2] * v[n][2] + v[n][3] * v[n][3]); }
                    *(f32x4*)(H + ro + bj * 128) = v[0]; *(f32x4*)(H + ro + bj * 128 + 4) = v[1];
                    if (XN_) { v[0] = v[0] * wv[bj][0]; v[1] = v[1] * wv[bj][1];
                        v4u w; w.x = cvtpk(v[0][0], v[0][1]); w.y = cvtpk(v[0][2], v[0][3]); w.z = cvtpk(v[1][0], v[1][1]); w.w = cvtpk(v[1][2], v[1][3]);
                        *(v4u*)(XN + ro + bj * 128) = w; }
                }
                ss += __shfl_xor(ss, 16); ss += __shfl_xor(ss, 32);
                if (fq == 0) atomicAdd(RS + row, (unsigned long long)__float2ull_rn(ss * FIX));
            }
    }
};

template <int E>
__device__ __forceinline__ void wg_scan(float (&vals)[E], LAS float* scr, int tid, int wid, int lane) {
    float run = 0.f;
#pragma unroll
    for (int j = 0; j < E; ++j) { run += vals[j]; vals[j] = run; }
    float inc = run;
#pragma unroll
    for (int o = 1; o < 64; o <<= 1) { const float t = __shfl_up(inc, o); if (lane >= o) inc += t; }
    if (lane == 63) scr[wid] = inc;
    __syncthreads();
    float woff = 0.f;
#pragma unroll
    for (int w = 0; w < 8; ++w) woff += (w < wid) ? scr[w] : 0.f;
    const float offs = woff + (inc - run);
#pragma unroll
    for (int j = 0; j < E; ++j) vals[j] += offs;
    __syncthreads();
}


__device__ __forceinline__ unsigned f2bf(float f) { unsigned u = __builtin_bit_cast(unsigned, f); return (u + 0x7fffu + ((u >> 16) & 1u)) >> 16; }
__device__ __forceinline__ unsigned pk2(float lo, float hi) { return f2bf(lo) | (f2bf(hi) << 16); }
__device__ __forceinline__ void p0_transpose_item(const float* W, int K, int N, bf16_t* WT, LAS float* scr, int item, int lane) {
    const int nblk = N / 32, kb = item / nblk, nb = item % nblk, k0 = 64 * kb, n0 = 32 * nb;
#pragma unroll 8
    for (int i = 0; i < 32; ++i) { const int kk = 2 * i + (lane >> 5); scr[kk * 33 + (lane & 31)] = W[(size_t)(k0 + kk) * N + n0 + (lane & 31)]; }
    LDS_WAIT(); asm volatile("" ::: "memory");
    const int c = lane & 7;
#pragma unroll
    for (int j = 0; j < 4; ++j) { const int n = (lane >> 3) + 8 * j; const LAS float* s = scr + (8 * c) * 33 + n;
        v4u o; o.x = pk2(s[0 * 33], s[1 * 33]); o.y = pk2(s[2 * 33], s[3 * 33]); o.z = pk2(s[4 * 33], s[5 * 33]); o.w = pk2(s[6 * 33], s[7 * 33]);
        *(v4u*)(WT + (size_t)(n0 + n) * K + k0 + 8 * c) = o; }
    LDS_WAIT(); asm volatile("" ::: "memory");
}
__device__ __forceinline__ void p0_transpose_item64(const float* W, int K, int N, bf16_t* WT, LAS float* scr, int item, int lane) {
    const int nblk = N / 64, kb = item / nblk, nb = item % nblk, k0 = 64 * kb, n0 = 64 * nb;
    const int r4 = lane >> 4, g4 = lane & 15;
    f32x4 v[16];
#pragma unroll
    for (int i = 0; i < 16; ++i) v[i] = *(const f32x4*)(W + (size_t)(k0 + 4 * i + r4) * N + n0 + 4 * g4);
#pragma unroll
    for (int i = 0; i < 16; ++i) { const int kk = 4 * i + r4; *(LAS f32x4*)(scr + kk * 64 + ((g4 ^ (kk >> 3)) << 2)) = v[i]; }
    LDS_WAIT(); asm volatile("" ::: "memory");
    const int c = lane & 7;
#pragma unroll
    for (int j = 0; j < 8; ++j) { const int n = (lane >> 3) + 8 * j; const LAS float* s = scr + (8 * c) * 64 + ((((n >> 2) ^ c)) << 2) + (n & 3);
        v4u o; o.x = cvtpk(s[0 * 64], s[1 * 64]); o.y = cvtpk(s[2 * 64], s[3 * 64]); o.z = cvtpk(s[4 * 64], s[5 * 64]); o.w = cvtpk(s[6 * 64], s[7 * 64]);
        *(v4u*)(WT + (size_t)(n0 + n) * K + k0 + 8 * c) = o; }
    LDS_WAIT(); asm volatile("" ::: "memory");
}
__device__ __forceinline__ void norm_row_to_bf16(const float* xrow, const float* w, bf16_t* orow, int lane) {
    const f32x4* xr = (const f32x4*)xrow + lane;
    f32x4 v[16]; float s = 0.f;
#pragma unroll
    for (int j = 0; j < 16; ++j) { v[j] = xr[64 * j]; s += (v[j].x * v[j].x + v[j].y * v[j].y) + (v[j].z * v[j].z + v[j].w * v[j].w); }
    const float r = rsqrtf(wave_sum(s) * (1.f / DM) + EPS);
    const f32x4* wr_ = (const f32x4*)w + lane;
    v2u* o8 = (v2u*)orow + lane;
#pragma unroll
    for (int j = 0; j < 16; ++j) { const f32x4 ww = wr_[64 * j]; v2u o; o.x = cvtpk(v[j].x * r * ww.x, v[j].y * r * ww.y); o.y = cvtpk(v[j].z * r * ww.z, v[j].w * r * ww.w); o8[64 * j] = o; }
}

#define DBG_FLAG(cond, bit) do { if (dbg && __any(cond)) { if ((threadIdx.x & 63) == 0) atomicOr(dbg, 1u << (bit)); } } while (0)
__device__ __forceinline__ bool nonfin(float v) { return (__float_as_uint(v) & 0x7f800000u) == 0x7f800000u; }
__device__ __forceinline__ void attn_pv(const LAS unsigned char* Vt, int blk, const bf16x8 (&pk)[2], f32x16 (&o)[4], int lane) {
    const unsigned h = (unsigned)lane >> 5, q4 = (lane & 15) >> 2, pp = lane & 3, bc = (lane >> 4) & 1;
#pragma unroll
    for (int ks = 0; ks < 2; ++ks) {
        const unsigned row0 = 32u * blk + 16u * ks + 4u * h + q4, row1 = row0 + 8u;
        const unsigned x0 = (q4 << 2) | (h & 3u), x1 = (q4 << 2) | ((h + 2u) & 3u);
#pragma unroll
        for (int c = 0; c < 4; ++c) {
            const unsigned chn = 4u * c + 2u * bc + (pp >> 1);
            const s16x4 lo = __builtin_amdgcn_ds_read_tr16_b64_v4i16((LAS s16x4*)(Vt + 256u * row0 + 16u * (chn ^ x0) + 8u * (pp & 1)));
            const s16x4 hi = __builtin_amdgcn_ds_read_tr16_b64_v4i16((LAS s16x4*)(Vt + 256u * row1 + 16u * (chn ^ x1) + 8u * (pp & 1)));
            const bf16x8 a = {lo[0], lo[1], lo[2], lo[3], hi[0], hi[1], hi[2], hi[3]};
            o[c] = __builtin_amdgcn_mfma_f32_32x32x16_bf16(a, pk[ks], o[c], 0, 0, 0);
        }
    }
}
__device__ __forceinline__ void attn_v_load(const LAS unsigned char* Vt, int blk, s16x4 (&vl)[8], s16x4 (&vh)[8], int lane) {
    const unsigned h = (unsigned)lane >> 5, q4 = (lane & 15) >> 2, pp = lane & 3, bc = (lane >> 4) & 1;
#pragma unroll
    for (int ks = 0; ks < 2; ++ks) {
        const unsigned row0 = 32u * blk + 16u * ks + 4u * h + q4, row1 = row0 + 8u;
        const unsigned x0 = (q4 << 2) | (h & 3u), x1 = (q4 << 2) | ((h + 2u) & 3u);
#pragma unroll
        for (int c = 0; c < 4; ++c) {
            const unsigned chn = 4u * c + 2u * bc + (pp >> 1);
            vl[4 * ks + c] = __builtin_amdgcn_ds_read_tr16_b64_v4i16((LAS s16x4*)(Vt + 256u * row0 + 16u * (chn ^ x0) + 8u * (pp & 1)));
            vh[4 * ks + c] = __builtin_amdgcn_ds_read_tr16_b64_v4i16((LAS s16x4*)(Vt + 256u * row1 + 16u * (chn ^ x1) + 8u * (pp & 1)));
        }
    }
}
__device__ __forceinline__ void attn_v_mma(const s16x4 (&vl)[8], const s16x4 (&vh)[8], const bf16x8 (&pk)[2], f32x16 (&o)[4]) {
#pragma unroll
    for (int ks = 0; ks < 2; ++ks)
#pragma unroll
        for (int c = 0; c < 4; ++c) { const s16x4 lo = vl[4 * ks + c], hi = vh[4 * ks + c];
            const bf16x8 a = {lo[0], lo[1], lo[2], lo[3], hi[0], hi[1], hi[2], hi[3]};
            o[c] = __builtin_amdgcn_mfma_f32_32x32x16_bf16(a, pk[ks], o[c], 0, 0, 0); }
}
template <int MODE, bool FK_LDS = false>
__device__ __forceinline__ void attn_block(const LAS unsigned char* Kt, const LAS unsigned char* Vt, int blk, const bf16x8 (&qf)[8], f32x16 (&o)[4],
                                           float& m, float& l, float& carry, int key0, int qpos, float fq2, const float* fk, int lane, unsigned* dbg = nullptr, const LAS float* fkl = nullptr, bool need_mask = true) {
    const int r32 = lane & 31, h = lane >> 5;
    f32x16 p = {};
    {
        const unsigned krow = 32u * blk + r32, kx = ((krow & 3u) << 2) | ((krow >> 2) & 3u);
        const LAS unsigned char* kb = Kt + 256u * krow;
        __builtin_amdgcn_s_setprio(1);
#pragma unroll
        for (int s = 0; s < 8; ++s) { const bf16x8 a = *(const LAS bf16x8*)(kb + 16u * ((unsigned)(2 * s + h) ^ kx)); p = __builtin_amdgcn_mfma_f32_32x32x16_bf16(a, qf[s], p, 0, 0, 0); }
        __builtin_amdgcn_s_setprio(0);
    }
    { bool bad = false;
#pragma unroll
      for (int r = 0; r < 16; ++r) bad |= nonfin(p[r]);
      DBG_FLAG(bad, 1); }
    float x[16];
    if (MODE == 1) {
        f32x4 nf[4];
#pragma unroll
        for (int g = 0; g < 4; ++g) nf[g] = FK_LDS ? *(const LAS f32x4*)(fkl + 8 * g + 4 * h) : *(const f32x4*)(fk + 8 * g + 4 * h);
        f32x2 xv[8];
#pragma unroll
        for (int i = 0; i < 8; ++i) { const f32x2 pp = {p[2 * i], p[2 * i + 1]}, nn = {nf[i >> 1][2 * (i & 1)], nf[i >> 1][2 * (i & 1) + 1]}; xv[i] = (pp + nn) * QK2; }
        if (need_mask) {
#pragma unroll
            for (int i = 0; i < 8; ++i) { const int key = key0 + ((2 * i) & 3) + 8 * ((2 * i) >> 2) + 4 * h;
                xv[i].x = (key > qpos) ? -__builtin_inff() : xv[i].x; xv[i].y = (key + 1 > qpos) ? -__builtin_inff() : xv[i].y; }
        }
        float bm = fmaxf(xv[0].x, xv[0].y);
#pragma unroll
        for (int i = 1; i < 8; ++i) bm = fmaxf(bm, fmaxf(xv[i].x, xv[i].y));
        { auto rr = __builtin_amdgcn_permlane32_swap(__float_as_uint(bm), __float_as_uint(bm), false, false); bm = fmaxf(__uint_as_float(rr[0]), __uint_as_float(rr[1])); }
        const float mn = fmaxf(m, bm), alpha = ex2(m - mn); m = mn;
        f32x2 ls2 = {0.f, 0.f};
#pragma unroll
        for (int i = 0; i < 8; ++i) { f32x2 e = xv[i] - mn; e.x = ex2(e.x); e.y = ex2(e.y); ls2 += e; x[2 * i] = e.x; x[2 * i + 1] = e.y; }
        float ls = ls2.x + ls2.y;
        { auto rr = __builtin_amdgcn_permlane32_swap(__float_as_uint(ls), __float_as_uint(ls), false, false); ls = __uint_as_float(rr[0]) + __uint_as_float(rr[1]); }
        l = l * alpha + ls;
        if (__any(alpha != 1.f)) {
#pragma unroll
            for (int c = 0; c < 4; ++c)
#pragma unroll
                for (int r = 0; r < 16; ++r) o[c][r] *= alpha;
        }
    } else {
        float lm[16];
#pragma unroll
        for (int r = 0; r < 16; ++r) { const int key = key0 + (r & 3) + 8 * (r >> 2) + 4 * h; const float z2 = p[r] * QK2, e = ex2(-fabsf(z2)), sp = fmaxf(z2, 0.f) + lg2(1.f + e);
            const bool valid = key < qpos; lm[r] = valid ? -sp : 0.f; x[r] = valid ? (z2 - sp) : -__builtin_inff(); }
        float gs0 = (lm[0] + lm[1]) + (lm[2] + lm[3]), gs1 = (lm[4] + lm[5]) + (lm[6] + lm[7]), gs2 = (lm[8] + lm[9]) + (lm[10] + lm[11]), gs3 = (lm[12] + lm[13]) + (lm[14] + lm[15]);
        float a0, b0, a1, b1, a2, b2, a3, b3;
        { auto rr = __builtin_amdgcn_permlane32_swap(__float_as_uint(gs0), __float_as_uint(gs0), false, false); a0 = __uint_as_float(rr[0]); b0 = __uint_as_float(rr[1]); }
        { auto rr = __builtin_amdgcn_permlane32_swap(__float_as_uint(gs1), __float_as_uint(gs1), false, false); a1 = __uint_as_float(rr[0]); b1 = __uint_as_float(rr[1]); }
        { auto rr = __builtin_amdgcn_permlane32_swap(__float_as_uint(gs2), __float_as_uint(gs2), false, false); a2 = __uint_as_float(rr[0]); b2 = __uint_as_float(rr[1]); }
        { auto rr = __builtin_amdgcn_permlane32_swap(__float_as_uint(gs3), __float_as_uint(gs3), false, false); a3 = __uint_as_float(rr[0]); b3 = __uint_as_float(rr[1]); }
        const float T7 = 0.f, T6 = b3, T5 = T6 + a3, T4 = T5 + b2, T3 = T4 + a2, T2 = T3 + b1, T1 = T2 + a1, T0 = T1 + b0;
        const float total = T0 + a0;
        const float tb0 = carry + (h ? T1 : T0), tb1 = carry + (h ? T3 : T2), tb2 = carry + (h ? T5 : T4), tb3 = carry + (h ? T7 : T6);
#define SB_GRP(g, tb) do { const float t3 = (tb), t2 = t3 + lm[4 * (g) + 3], t1 = t2 + lm[4 * (g) + 2], t0 = t1 + lm[4 * (g) + 1]; \
            x[4 * (g) + 3] = ex2(x[4 * (g) + 3] + t3); x[4 * (g) + 2] = ex2(x[4 * (g) + 2] + t2); x[4 * (g) + 1] = ex2(x[4 * (g) + 1] + t1); x[4 * (g)] = ex2(x[4 * (g)] + t0); } while (0)
        SB_GRP(0, tb0); SB_GRP(1, tb1); SB_GRP(2, tb2); SB_GRP(3, tb3);
#undef SB_GRP
        carry += total;
        { bool bad = false;
#pragma unroll
          for (int r = 0; r < 16; ++r) bad |= nonfin(x[r]);
          DBG_FLAG(bad, 2); DBG_FLAG(nonfin(carry), 3); }
    }
    bf16x8 pk[2];
#pragma unroll
    for (int ks = 0; ks < 2; ++ks) { v4u w; w.x = cvtpk(x[8 * ks], x[8 * ks + 1]); w.y = cvtpk(x[8 * ks + 2], x[8 * ks + 3]); w.z = cvtpk(x[8 * ks + 4], x[8 * ks + 5]); w.w = cvtpk(x[8 * ks + 6], x[8 * ks + 7]); pk[ks] = __builtin_bit_cast(bf16x8, w); }
    __builtin_amdgcn_s_setprio(1);
    attn_pv(Vt, blk, pk, o, lane);
    __builtin_amdgcn_s_setprio(0);
}

__device__ __forceinline__ float vmax3(float a, float b, float c) { float r; asm("v_max3_f32 %0, %1, %2, %3" : "=v"(r) : "v"(a), "v"(b), "v"(c)); return r; }
__device__ __forceinline__ void attn_tile64_fox(const LAS unsigned char* Kt, const LAS unsigned char* Vt, const bf16x8 (&qf)[8], f32x16 (&o)[4], float& m, float& l, int lane, const LAS float* fkl) {
    const int r32 = lane & 31, h = lane >> 5;
    f32x16 p1, p0;
#pragma unroll
    for (int g = 0; g < 4; ++g) { const f32x4 n1 = *(const LAS f32x4*)(fkl + 32 + 8 * g + 4 * h), n0 = *(const LAS f32x4*)(fkl + 8 * g + 4 * h);
#pragma unroll
        for (int j = 0; j < 4; ++j) { p1[4 * g + j] = n1[j]; p0[4 * g + j] = n0[j]; } }
    {
        const unsigned kx = ((r32 & 3u) << 2) | ((r32 >> 2) & 3u);
        const LAS unsigned char* kb = Kt + 256u * r32;
#pragma unroll
        for (int s = 0; s < 8; ++s) { const unsigned co = 16u * ((unsigned)(2 * s + h) ^ kx);
            const bf16x8 a1 = *(const LAS bf16x8*)(kb + 8192u + co), a0 = *(const LAS bf16x8*)(kb + co);
            p1 = __builtin_amdgcn_mfma_f32_32x32x16_bf16(a1, qf[s], p1, 0, 0, 0); p0 = __builtin_amdgcn_mfma_f32_32x32x16_bf16(a0, qf[s], p0, 0, 0, 0); }
    }
    s16x4 fl[4], fh[4];
    int lv = lane; asm volatile("" : "+v"(lv));
    const unsigned vh_ = ((unsigned)lv >> 5) & 1u, vq4 = (lv & 15) >> 2, vpp = lv & 3, vbc = (lv >> 4) & 1;
#define VLD(blk_, ks_, c_) do { const unsigned row0_ = 32u * (blk_) + 16u * (ks_) + 4u * vh_ + vq4, x0_ = (vq4 << 2) | (vh_ & 3u), x1_ = (vq4 << 2) | ((vh_ + 2u) & 3u), chn_ = 4u * (c_) + 2u * vbc + (vpp >> 1); \
        fl[c_] = __builtin_amdgcn_ds_read_tr16_b64_v4i16((LAS s16x4*)(Vt + 256u * row0_ + 16u * (chn_ ^ x0_) + 8u * (vpp & 1))); \
        fh[c_] = __builtin_amdgcn_ds_read_tr16_b64_v4i16((LAS s16x4*)(Vt + 256u * (row0_ + 8u) + 16u * (chn_ ^ x1_) + 8u * (vpp & 1))); } while (0)
#define VMMA(c_, pk_) do { const bf16x8 a_ = {fl[c_][0], fl[c_][1], fl[c_][2], fl[c_][3], fh[c_][0], fh[c_][1], fh[c_][2], fh[c_][3]}; o[c_] = __builtin_amdgcn_mfma_f32_32x32x16_bf16(a_, pk_, o[c_], 0, 0, 0); } while (0)
    VLD(1, 0, 0); VLD(1, 0, 1); VLD(1, 0, 2); VLD(1, 0, 3);
    __builtin_amdgcn_sched_barrier(0);
    float bmA = vmax3(p1[0], p1[1], p1[2]), bmB = vmax3(p0[0], p0[1], p0[2]);
#pragma unroll
    for (int i = 3; i < 15; i += 2) { bmA = vmax3(bmA, p1[i], p1[i + 1]); bmB = vmax3(bmB, p0[i], p0[i + 1]); }
    float bm = vmax3(bmA, bmB, p1[15]); bm = fmaxf(bm, p0[15]);
    { auto rr = __builtin_amdgcn_permlane32_swap(__float_as_uint(bm), __float_as_uint(bm), false, false); bm = fmaxf(__uint_as_float(rr[0]), __uint_as_float(rr[1])) * QK2; }
    const float mn = fmaxf(m, bm), alpha = ex2(m - mn); m = mn;
    if (__any(alpha != 1.f)) {
#pragma unroll
        for (int c = 0; c < 4; ++c)
#pragma unroll
            for (int r = 0; r < 16; ++r) o[c][r] *= alpha;
    }
    f32x2 ls2 = {0.f, 0.f};
    bf16x8 pk1[2], pk0[2];
    { v4u w[2];
#pragma unroll
      for (int i = 0; i < 8; ++i) { f32x2 e = (f32x2){p1[2 * i], p1[2 * i + 1]} * QK2 - mn; e.x = ex2(e.x); e.y = ex2(e.y); ls2 += e; w[i >> 2][i & 3] = cvtpk(e.x, e.y); }
      pk1[0] = __builtin_bit_cast(bf16x8, w[0]); pk1[1] = __builtin_bit_cast(bf16x8, w[1]); }
    __builtin_amdgcn_sched_barrier(0);
#define VSTEP(c_, pk_, nb_, nk_) do { VMMA(c_, pk_); VLD(nb_, nk_, c_); __builtin_amdgcn_sched_barrier(0); } while (0)
    VSTEP(0, pk1[0], 1, 1); VSTEP(1, pk1[0], 1, 1); VSTEP(2, pk1[0], 1, 1); VSTEP(3, pk1[0], 1, 1);
    VSTEP(0, pk1[1], 0, 0); VSTEP(1, pk1[1], 0, 0); VSTEP(2, pk1[1], 0, 0); VSTEP(3, pk1[1], 0, 0);
    { v4u w[2];
#pragma unroll
      for (int i = 0; i < 8; ++i) { f32x2 e = (f32x2){p0[2 * i], p0[2 * i + 1]} * QK2 - mn; e.x = ex2(e.x); e.y = ex2(e.y); ls2 += e; w[i >> 2][i & 3] = cvtpk(e.x, e.y); }
      pk0[0] = __builtin_bit_cast(bf16x8, w[0]); pk0[1] = __builtin_bit_cast(bf16x8, w[1]); }
    __builtin_amdgcn_sched_barrier(0);
    VSTEP(0, pk0[0], 0, 1); VSTEP(1, pk0[0], 0, 1); VSTEP(2, pk0[0], 0, 1); VSTEP(3, pk0[0], 0, 1);
    VMMA(0, pk0[1]); VMMA(1, pk0[1]); VMMA(2, pk0[1]); VMMA(3, pk0[1]);
#undef VSTEP
#undef VMMA
#undef VLD
    float ls = ls2.x + ls2.y;
    { auto rr = __builtin_amdgcn_permlane32_swap(__float_as_uint(ls), __float_as_uint(ls), false, false); ls = __uint_as_float(rr[0]) + __uint_as_float(rr[1]); }
    l = l * alpha + ls;
}

template <int MODE>
__device__ __forceinline__ void attn_prompt_unit(LAS unsigned char* lds, const bf16_t* Qb, const bf16_t* Kb, const bf16_t* Vb, const bf16_t* Gate, int ld, int hd, int qb,
                                                 bf16_t* Out, int ocol0, const float* FCh, int tid, int wid, int lane, float kn2 = 0.f  ) {
    asm volatile("" : "+v"(tid)); lane = tid & 63;
    const int r32 = lane & 31, h = lane >> 5;
    const int qlo = qb * 256 + wid * 32, qrow = qlo + r32;
    bf16x8 qf[8];
    { const bf16_t* qp = Qb + (size_t)qrow * ld + hd * HD + 8 * h;
#pragma unroll
      for (int s = 0; s < 8; ++s) qf[s] = *(const bf16x8*)(qp + 16 * s); }
    f32x16 o[4] = {};
    float m = -1e30f, l = 0.f, carry = 0.f;
    const float fq2 = MODE ? FCh[qrow] : 0.f;
    float qnk = 0.f;
    if (MODE == 1) { float s2 = 0.f;
#pragma unroll
        for (int s = 0; s < 8; ++s)
#pragma unroll
            for (int e = 0; e < 8; ++e) { const float qv = bf2f((unsigned short)qf[s][e]); s2 += qv * qv; }
        { auto rr = __builtin_amdgcn_permlane32_swap(__float_as_uint(s2), __float_as_uint(s2), false, false); s2 = __uint_as_float(rr[0]) + __uint_as_float(rr[1]); }
        qnk = sqrtf(s2) * kn2; }
    LAS float* Fl = (LAS float*)(lds + 65536 + 128);
    float sf = 0.f;
    volatile LAS int* flags = (volatile LAS int*)(lds + 65536);
    const int ktop = 4 * qb + 3;
    const int srow = tid >> 4, sch = tid & 15;
    const bf16_t* kg = Kb + (size_t)srow * ld + hd * HD + sch * 8;
    const bf16_t* vg = Vb + (size_t)srow * ld + hd * HD + sch * 8;
    const unsigned so0 = off_b(srow, sch), so1 = off_b(srow + 32, sch);
    v4u sk0, sk1, sv0, sv1;
#define AP_ISSUE(kt) do { if (MODE == 1 && tid < 64) sf = FCh[(kt) * 64 + tid]; const size_t go = (size_t)(kt) * 64 * ld; sk0 = *(const v4u*)(kg + go); sk1 = *(const v4u*)(kg + go + (size_t)32 * ld); sv0 = *(const v4u*)(vg + go); sv1 = *(const v4u*)(vg + go + (size_t)32 * ld); } while (0)
#define AP_WRITE(b) do { if (MODE == 1 && tid < 64) Fl[(b) * 64 + tid] = sf; LAS unsigned char* kb_ = lds + (b) * 32768; *(LAS v4u*)(kb_ + so0) = sk0; *(LAS v4u*)(kb_ + so1) = sk1; *(LAS v4u*)(kb_ + 16384 + so0) = sv0; *(LAS v4u*)(kb_ + 16384 + so1) = sv1; } while (0)
    if (tid < 16) flags[tid] = 0;
    int cur = 0, it = 0; bool wdone = false;
    AP_ISSUE(ktop);
    for (int kt = ktop; kt >= 0; --kt, ++it) {
        AP_WRITE(cur);
        __syncthreads();
        if (it > 0) { const volatile LAS int* f = flags + ((it - 1) & 1) * 8; int all = 1;
#pragma unroll
            for (int w = 0; w < 8; ++w) all &= f[w];
            if (all) break; }
        if (kt > 0) AP_ISSUE(kt - 1);
        if (!wdone) {
#pragma unroll
            for (int blk = 1; blk >= 0; --blk) {
                const int key0 = kt * 64 + blk * 32;
                if (key0 > qlo + 31) continue;
                attn_block<MODE, MODE == 1>(lds + cur * 32768, lds + cur * 32768 + 16384, blk, qf, o, m, l, carry, key0, qrow, fq2, nullptr, lane, nullptr, Fl + cur * 64 + blk * 32, key0 + 31 > qlo);
            }
            if (MODE == 0) wdone = __all(carry < -136.f);
            else wdone = __all(m > -1e29f && qnk + Fl[cur * 64] * QK2 < m - 136.f);
        }
        if (lane == 0) flags[(it & 1) * 8 + wid] = wdone ? 1 : 0;
        cur ^= 1;
    }
#undef AP_ISSUE
#undef AP_WRITE
    const float inv = MODE ? 1.f / l : 1.f;
    const bf16_t* gp = Gate + (size_t)qrow * ld + hd * HD + 4 * h;
    bf16_t* op = Out + (size_t)qrow * DM + ocol0 + 4 * h;
#pragma unroll
    for (int c = 0; c < 4; ++c)
#pragma unroll
        for (int g = 0; g < 4; ++g) { const v2u gw = *(const v2u*)(gp + 32 * c + 8 * g);
            v2u w; w.x = cvtpk(o[c][4 * g] * inv * bflo(gw.x), o[c][4 * g + 1] * inv * bfhi(gw.x)); w.y = cvtpk(o[c][4 * g + 2] * inv * bflo(gw.y), o[c][4 * g + 3] * inv * bfhi(gw.y));
            *(v2u*)(op + 32 * c + 8 * g) = w; }
    __syncthreads();
}

struct GBar { volatile LAS unsigned* cnt; unsigned tgt; };
__device__ __forceinline__ void gbar_sync(GBar& g, int lane) {
    g.tgt += 4u;
    asm volatile("s_waitcnt lgkmcnt(0)" ::: "memory");
    if (lane == 0) __hip_atomic_fetch_add((LAS unsigned*)g.cnt, 1u, __ATOMIC_RELAXED, __HIP_MEMORY_SCOPE_WORKGROUP);
    while ((int)(__hip_atomic_load((LAS unsigned*)g.cnt, __ATOMIC_RELAXED, __HIP_MEMORY_SCOPE_WORKGROUP) - g.tgt) < 0) __builtin_amdgcn_s_sleep(1);
    asm volatile("" ::: "memory");
}
template <int MODE>
__device__ __forceinline__ void attn_prompt_group(LAS unsigned char* gl, LAS unsigned char* gx, GBar& gb, const bf16_t* Qb, const bf16_t* Kb, const bf16_t* Vb, const bf16_t* Gate, int ld, int hd, int qb,
                                                  bf16_t* Out, int ocol0, const float* FCh, int gtid, int gw, float kn2) {
    asm volatile("" : "+v"(gtid)); const int lane = gtid & 63;
    const int r32 = lane & 31, h = lane >> 5;
    const int qlo = qb * 128 + gw * 32, qrow = qlo + r32;
    bf16x8 qf[8];
    { const bf16_t* qp = Qb + (size_t)qrow * ld + hd * HD + 8 * h;
#pragma unroll
      for (int s = 0; s < 8; ++s) qf[s] = *(const bf16x8*)(qp + 16 * s); }
    f32x16 o[4] = {};
    float m = -1e30f, l = 0.f, carry = 0.f;
    float qnk = 0.f;
    if (MODE == 1) { float s2 = 0.f;
#pragma unroll
        for (int s = 0; s < 8; ++s)
#pragma unroll
            for (int e = 0; e < 8; ++e) { const float qv = bf2f((unsigned short)qf[s][e]); s2 += qv * qv; }
        { auto rr = __builtin_amdgcn_permlane32_swap(__float_as_uint(s2), __float_as_uint(s2), false, false); s2 = __uint_as_float(rr[0]) + __uint_as_float(rr[1]); }
        qnk = sqrtf(s2) * kn2; }
    LAS float* Fl = (LAS float*)(gx + 128);
    volatile LAS int* flags = (volatile LAS int*)gx;
    const int ktop = 2 * qb + 1;
#define AG_DMA(kt, b) do { const size_t go_ = (size_t)(kt) * 64 * ld * 2; LAS unsigned char* kb_ = gl + (b) * 32768 + gw * 4096; int l_ = gtid; asm volatile("" : "+v"(l_)); l_ &= 63; unsigned voff[4]; \
        _Pragma("unroll") for (int i_ = 0; i_ < 4; ++i_) { const int row_ = 16 * gw + 4 * i_ + (l_ >> 4), ch_ = (l_ & 15) ^ ((((l_ >> 4) & 3) << 2) | i_); voff[i_] = (unsigned)((row_ * ld + hd * HD + 8 * ch_) * 2); } \
        _Pragma("unroll") for (int i_ = 0; i_ < 4; ++i_) { \
            __builtin_amdgcn_global_load_lds((const unsigned*)((const char*)Kb + go_ + voff[i_]), (LAS unsigned*)(kb_ + i_ * 1024), 16, 0, 0); \
            __builtin_amdgcn_global_load_lds((const unsigned*)((const char*)Vb + go_ + voff[i_]), (LAS unsigned*)(kb_ + 16384 + i_ * 1024), 16, 0, 0); } \
        if (MODE == 1 && gw == 0) __builtin_amdgcn_global_load_lds((const unsigned*)(FCh + (kt) * 64 + l_), (LAS unsigned*)(Fl + (b) * 64), 4, 0, 0); } while (0)
    if (gtid < 8) flags[gtid] = 0;
    int cur = 0, it = 0; bool wdone = false;
    AG_DMA(ktop, 0);
    for (int kt = ktop; kt >= 0; --kt, ++it) {
        asm volatile("s_waitcnt vmcnt(0)" ::: "memory");
        gbar_sync(gb, lane);
        if (it > 0) { const volatile LAS int* f = flags + ((it - 1) & 1) * 4; if (f[0] & f[1] & f[2] & f[3]) break; }
        if (kt > 0) AG_DMA(kt - 1, cur ^ 1);
        if (!wdone) {
            if (MODE == 1 && kt * 64 + 63 <= qlo) attn_tile64_fox(gl + cur * 32768, gl + cur * 32768 + 16384, qf, o, m, l, lane, Fl + cur * 64);
            else {
#pragma unroll
            for (int blk = 1; blk >= 0; --blk) {
                const int key0 = kt * 64 + blk * 32;
                if (key0 > qlo + 31) continue;
                attn_block<MODE, MODE == 1>(gl + cur * 32768, gl + cur * 32768 + 16384, blk, qf, o, m, l, carry, key0, qrow, 0.f, nullptr, lane, nullptr, Fl + cur * 64 + blk * 32, key0 + 31 > qlo);
            } }
            if (MODE == 0) wdone = __all(carry < -136.f);
            else wdone = __all(m > -1e29f && qnk + Fl[cur * 64] * QK2 < m - 136.f);
        }
        if (lane == 0) flags[(it & 1) * 4 + gw] = wdone ? 1 : 0;
        cur ^= 1;
    }
#undef AG_DMA
    const float inv = MODE ? 1.f / l : 1.f;
    int le = gtid; asm volatile("" : "+v"(le));
    const int qrow_e = qlo + (le & 31), he = (le >> 5) & 1;
    const bf16_t* gp = Gate + (size_t)qrow_e * ld + hd * HD + 4 * he;
    bf16_t* op = Out + (size_t)qrow_e * DM + ocol0 + 4 * he;
#pragma unroll
    for (int c = 0; c < 4; ++c)
#pragma unroll
        for (int g = 0; g < 4; ++g) { const v2u gw_ = *(const v2u*)(gp + 32 * c + 8 * g);
            v2u w; w.x = cvtpk(o[c][4 * g] * inv * bflo(gw_.x), o[c][4 * g + 1] * inv * bfhi(gw_.x)); w.y = cvtpk(o[c][4 * g + 2] * inv * bflo(gw_.y), o[c][4 * g + 3] * inv * bfhi(gw_.y));
            *(v2u*)(op + 32 * c + 8 * g) = w; }
    gbar_sync(gb, lane);
}

__device__ __forceinline__ void fl_rows(LAS unsigned char* lds, const bf16_t* XN, const bf16_t* W3fl, const unsigned long long* RS, const float* bfg, float* FL, float* outF, int row0, int tid, int wid) {
    asm volatile("" : "+v"(tid)); const int lane = tid & 63;
    const int r32 = lane & 31, h = lane >> 5;
    f32x16 acc = {};
    const bf16_t* ap = XN + (size_t)(row0 + r32) * DM + wid * 512 + 8 * h;
    const bf16_t* bp = W3fl + (size_t)r32 * DM + wid * 512 + 8 * h;
#pragma unroll 8
    for (int s = 0; s < 32; ++s) { const bf16x8 a = *(const bf16x8*)(ap + 16 * s), bb = *(const bf16x8*)(bp + 16 * s); acc = __builtin_amdgcn_mfma_f32_32x32x16_bf16(a, bb, acc, 0, 0, 0); }
    LAS float* red = (LAS float*)lds;
#pragma unroll
    for (int r = 0; r < 16; ++r) red[(wid * 32 + (r & 3) + 8 * (r >> 2) + 4 * h) * 32 + r32] = acc[r];
    __syncthreads();
    { const int row = tid >> 4, c2 = (tid & 15) * 2;
      float s0 = 0.f, s1 = 0.f;
#pragma unroll
      for (int w = 0; w < 8; ++w) { const f32x2 v = *(const LAS f32x2*)(red + (w * 32 + row) * 32 + c2); s0 += v.x; s1 += v.y; }
      const float r = rsqrtf((float)RS[row0 + row] * (1.f / (FIX * 4096.f)) + EPS);
      float x0 = s0 * r + bfg[c2], x1 = s1 * r + bfg[c2 + 1];
      x0 = fminf(x0, 0.f) - log1pf(__expf(-fabsf(x0))); x1 = fminf(x1, 0.f) - log1pf(__expf(-fabsf(x1)));
      *(f32x2*)(FL + (size_t)(row0 + row) * 32 + c2) = (f32x2){x0, x1}; *(f32x2*)(outF + (size_t)(row0 + row) * 32 + c2) = (f32x2){x0, x1}; }
    __syncthreads();
}

template <int NB>
__device__ __forceinline__ void stage_block_f32(LAS unsigned char* T, const float* src  , size_t rs, int lane) {
#pragma unroll
    for (int hf = 0; hf < 16 / NB; ++hf) {
        f32x4 v[NB];
#pragma unroll
        for (int i = 0; i < NB; ++i) { const int id = lane + 64 * (NB * hf + i), row = id >> 5, c4 = id & 31; v[i] = *(const f32x4*)(src + (size_t)row * rs + c4 * 4); }
#pragma unroll
        for (int i = 0; i < NB; ++i) { const int id = lane + 64 * (NB * hf + i), row = id >> 5, c4 = id & 31; v2u w; w.x = cvtpk(v[i].x, v[i].y); w.y = cvtpk(v[i].z, v[i].w);
            *(LAS v2u*)(T + off_b(row, c4 >> 1) + (c4 & 1) * 8) = w; }
        asm volatile("" ::: "memory");
    }
}
__device__ __forceinline__ void stage_block_new(LAS unsigned char* T, const bf16_t* src  , int ld, int lane) {
#pragma unroll
    for (int i = 0; i < 8; ++i) { const int id = lane + 64 * i, row = id >> 4, ch = id & 15; v4u w = {0u, 0u, 0u, 0u}; if (row < 16) w = *(const v4u*)(src + (size_t)row * ld + ch * 8);
        *(LAS v4u*)(T + off_b(row, ch)) = w; }
    asm volatile("" ::: "memory");
}
__device__ __forceinline__ void attn_sample_sb_unit(LAS unsigned char* lds, int b, int hd, const bf16_t* QB, const bf16_t* KB, const bf16_t* VB, const bf16_t* GB,
                                                    const float* ck, const float* cv, bf16_t* Out, int tid_, int wid) {
    int lane = tid_ & 63; asm volatile("" : "+v"(lane));
    const int r32 = lane & 31, h = lane >> 5, t = r32 & 15; const bool real = r32 < 16;
    const int qrow = TP + 16 * b + t, qpos = real ? PAST + t : -1;
    bf16x8 qf[8];
    { const bf16_t* qp = QB + (size_t)qrow * HW + hd * HD + 8 * h;
#pragma unroll
      for (int s = 0; s < 8; ++s) { qf[s] = *(const bf16x8*)(qp + 16 * s); if (!real) qf[s] = (bf16x8){0, 0, 0, 0, 0, 0, 0, 0}; } }
    f32x16 o[4] = {};
    float m = 0.f, l = 0.f, carry = 0.f;
    volatile LAS int* flag = (volatile LAS int*)(lds + 65536);
    for (int tl = 16; tl >= 0; --tl) {
        int tid = wid * 64 + lane; asm volatile("" : "+v"(tid));
        if (tl == 16) {
#pragma unroll
            for (int i = 0; i < 2; ++i) { const int id = tid + 512 * i, row = id >> 4, ch = id & 15; v4u wk = {0u, 0u, 0u, 0u}, wv = {0u, 0u, 0u, 0u};
                if (row < 16) { const size_t go = (size_t)(TP + 16 * b + row) * HW + hd * HD + ch * 8; wk = *(const v4u*)(KB + go); wv = *(const v4u*)(VB + go); }
                *(LAS v4u*)(lds + off_b(row, ch)) = wk; *(LAS v4u*)(lds + 16384 + off_b(row, ch)) = wv; }
        } else {
            const size_t ro = (((size_t)b * PAST + 64 * tl) * NH_B + hd) * HD;
            f32x4 vk[4], vv[4];
#pragma unroll
            for (int i = 0; i < 4; ++i) { const int id = tid + 512 * i, row = id >> 5, c4 = id & 31; const size_t go = ro + (size_t)row * (NH_B * HD) + c4 * 4; vk[i] = *(const f32x4*)(ck + go); vv[i] = *(const f32x4*)(cv + go); }
#pragma unroll
            for (int i = 0; i < 4; ++i) { const int id = tid + 512 * i, row = id >> 5, c4 = id & 31; const unsigned lo = off_b(row, c4 >> 1) + (c4 & 1) * 8;
                v2u w; w.x = cvtpk(vk[i].x, vk[i].y); w.y = cvtpk(vk[i].z, vk[i].w); *(LAS v2u*)(lds + lo) = w;
                w.x = cvtpk(vv[i].x, vv[i].y); w.y = cvtpk(vv[i].z, vv[i].w); *(LAS v2u*)(lds + 16384 + lo) = w; }
        }
        __syncthreads();
        if (wid == 0) {
            attn_block<0>(lds, lds + 16384, 1, qf, o, m, l, carry, 64 * tl + 32, qpos, 0.f, nullptr, lane);
            attn_block<0>(lds, lds + 16384, 0, qf, o, m, l, carry, 64 * tl, qpos, 0.f, nullptr, lane);
            if (lane == 0) flag[0] = __all(carry < -136.f || !real) ? 1 : 0;
        }
        __syncthreads();
        if (flag[0]) break;
    }
    if (wid == 0 && real) {
        const bf16_t* gp = GB + (size_t)qrow * HW + hd * HD + 4 * h;
        bf16_t* op = Out + (size_t)qrow * DM + HW + hd * HD + 4 * h;
#pragma unroll
        for (int c = 0; c < 4; ++c)
#pragma unroll
            for (int g = 0; g < 4; ++g) { const v2u gw = *(const v2u*)(gp + 32 * c + 8 * g);
                v2u w; w.x = cvtpk(o[c][4 * g] * bflo(gw.x), o[c][4 * g + 1] * bfhi(gw.x)); w.y = cvtpk(o[c][4 * g + 2] * bflo(gw.y), o[c][4 * g + 3] * bfhi(gw.y));
                *(v2u*)(op + 32 * c + 8 * g) = w; }
    }
    __syncthreads();
}
__device__ __forceinline__ void attn_sample_fox_unit(LAS unsigned char* lds, int b, int hd, const bf16_t* QC, const bf16_t* KC, const bf16_t* VC, const bf16_t* GC,
                                                     const float* ck, const float* cv, const float* clf  , const float* FL, bf16_t* Out, int tid, int wid, int lane) {
    asm volatile("" : "+v"(tid)); lane = tid & 63;
    const int r32 = lane & 31, h = lane >> 5, t = r32 & 15; const bool real = r32 < 16;
    const int qrow = TP + 16 * b + t, qpos = real ? PAST + t : -1;
    LAS float* NFl = (LAS float*)(lds + RING_BYTES + 2048);
    { float v[3];
#pragma unroll
      for (int j = 0; j < 3; ++j) { const int s = tid * 3 + j; float x = 0.f;
          if (s < PAST) x = clf[((size_t)b * PAST + s) * NH_C + hd]; else if (s < PAST + TSQ) x = FL[(size_t)(TP + 16 * b + s - PAST) * 32 + hd];
          v[j] = x * -NFRS; }
      wg_scan<3>(v, (LAS float*)(lds + RING_BYTES + 1536), tid, wid, lane);
#pragma unroll
      for (int j = 0; j < 3; ++j) { const int s = tid * 3 + j; if (s < FCS_LD) NFl[s] = v[j]; }
      __syncthreads(); }
    LAS unsigned char* wl = lds + wid * 16384;
    bf16x8 qf[8];
    { const bf16_t* qp = QC + (size_t)qrow * DM + hd * HD + 8 * h;
#pragma unroll
      for (int s = 0; s < 8; ++s) { qf[s] = *(const bf16x8*)(qp + 16 * s); if (!real) qf[s] = (bf16x8){0, 0, 0, 0, 0, 0, 0, 0}; } }
    f32x16 o[4] = {};
    float m = -1e30f, l = 0.f, carry = 0.f;
    const float fq2 = 0.f;
    const int nb = (wid == 7) ? 5 : 4;
    for (int j = 0; j < nb; ++j) {
        const int bi = (j == 4) ? 32 : 4 * wid + j;
        if (bi == 32) { stage_block_new(wl, KC + (size_t)(TP + 16 * b) * DM + hd * HD, DM, lane); stage_block_new(wl + 8192, VC + (size_t)(TP + 16 * b) * DM + hd * HD, DM, lane); }
        else { const size_t ro = (((size_t)b * PAST + 32 * bi) * NH_C + hd) * HD; stage_block_f32<8>(wl, ck + ro, (size_t)NH_C * HD, lane); stage_block_f32<8>(wl + 8192, cv + ro, (size_t)NH_C * HD, lane); }
        attn_block<1, true>(wl, wl + 8192, 0, qf, o, m, l, carry, 32 * bi, qpos, fq2, nullptr, lane, nullptr, NFl + 32 * bi, bi == 32);
    }
    __syncthreads();
    LAS float* co = (LAS float*)lds;
    LAS float* cm = (LAS float*)(lds + 65536);
    if (real) {
        if (h == 0) { cm[wid * 16 + t] = m; cm[128 + wid * 16 + t] = l; }
#pragma unroll
        for (int c = 0; c < 4; ++c)
#pragma unroll
            for (int g = 0; g < 4; ++g) *(LAS f32x4*)(co + (wid * 16 + t) * 128 + 32 * c + 8 * g + 4 * h) = (f32x4){o[c][4 * g], o[c][4 * g + 1], o[c][4 * g + 2], o[c][4 * g + 3]};
    }
    __syncthreads();
    {
        const int tq = tid >> 5, d4 = (tid & 31) * 4;
        float M = -1e30f;
#pragma unroll
        for (int w = 0; w < 8; ++w) M = fmaxf(M, cm[w * 16 + tq]);
        float L = 0.f; f32x4 acc = {0.f, 0.f, 0.f, 0.f};
#pragma unroll
        for (int w = 0; w < 8; ++w) { const float sc = ex2(cm[w * 16 + tq] - M); L += cm[128 + w * 16 + tq] * sc; acc += *(const LAS f32x4*)(co + (w * 16 + tq) * 128 + d4) * sc; }
        const float inv = 1.f / L;
        const int orow = TP + 16 * b + tq;
        const v2u gw = *(const v2u*)(GC + (size_t)orow * DM + hd * HD + d4);
        v2u w; w.x = cvtpk(acc[0] * inv * bflo(gw.x), acc[1] * inv * bfhi(gw.x)); w.y = cvtpk(acc[2] * inv * bflo(gw.y), acc[3] * inv * bfhi(gw.y));
        *(v2u*)(Out + (size_t)orow * DM + hd * HD + d4) = w;
    }
    __syncthreads();
}

__device__ __forceinline__ void hg_load_g(const float* Gp  , int ntok, int k, int a, float (&g)[16]) {
#pragma unroll
    for (int j = 0; j < 16; ++j) { const int i = 16 * a + j; g[j] = (i < ntok) ? Gp[(size_t)i * HW + k] : 0.f; }
}
__device__ __forceinline__ void hg_scan(const float (&g)[16], LAS float* tot, int k, int a, float (&Gc)[16], float& Glast, float& Gmid) {
    float run = 0.f;
#pragma unroll
    for (int j = 0; j < 16; ++j) { run += g[j]; Gc[j] = run; }
    tot[a * 128 + k] = run;
    __syncthreads();
    const float t0 = tot[k], t1 = tot[128 + k], t2 = tot[256 + k], t3 = tot[384 + k];
    const float offs = (a > 0 ? t0 : 0.f) + (a > 1 ? t1 : 0.f) + (a > 2 ? t2 : 0.f);
#pragma unroll
    for (int j = 0; j < 16; ++j) Gc[j] += offs;
    Glast = (t0 + t1) + (t2 + t3); Gmid = t0 + t1;
}
__device__ __forceinline__ void hg_tile_load(const bf16_t* src, int ntok, int tid, v4u (&w)[2]) {
#pragma unroll
    for (int i = 0; i < 2; ++i) { const int id = tid + 512 * i, row = id >> 4, ch = id & 15; w[i] = (v4u){0u, 0u, 0u, 0u}; if (row < ntok) w[i] = *(const v4u*)(src + (size_t)row * HW + ch * 8); }
}
__device__ __forceinline__ void hg_tile_write(LAS unsigned char* T, int tid, const v4u (&w)[2]) {
#pragma unroll
    for (int i = 0; i < 2; ++i) { const int id = tid + 512 * i, row = id >> 4, ch = id & 15; *(LAS v4u*)(T + off_b(row, ch)) = w[i]; }
}
constexpr int HG_V = 0, HG_KT = 16384, HG_QP = 32768, HG_QM = 49152, HG_KM = 65536, HG_SST = 81920, HG_TOT = 114688, HG_RED = 116736;

struct HgIn { float g[16]; unsigned short kr[16]; v4u vt[2]; };
__device__ __forceinline__ void hg_local_load(HgIn& I, const bf16_t* KAp, const bf16_t* VAp, const float* Gp, int ntok, int tid) {
    const int k = tid & 127, a = tid >> 7;
    hg_load_g(Gp, ntok, k, a, I.g);
    hg_tile_load(VAp, ntok, tid, I.vt);
#pragma unroll
    for (int j = 0; j < 16; ++j) { const int i = 16 * a + j; I.kr[j] = (i < ntok) ? KAp[(size_t)i * HW + k] : (unsigned short)0; }
}
template <bool SAMPLE>
__device__ __forceinline__ void hg_local_compute(LAS unsigned char* lds, const HgIn& I, const float* S0, float* Sout, float* Dout, int tid, int wid) {
    const int lane = tid & 63;
    const int k = tid & 127, a = tid >> 7;
    float Gc[16], Glast, Gmid;
    hg_scan(I.g, (LAS float*)(lds + HG_TOT), k, a, Gc, Glast, Gmid);
    hg_tile_write(lds + HG_V, tid, I.vt);
    {
        unsigned w[8];
#pragma unroll
        for (int j = 0; j < 16; j += 2) {
            const float k0 = bf2f(I.kr[j]) * ex2((Glast - Gc[j]) * LOG2E);
            const float k1 = bf2f(I.kr[j + 1]) * ex2((Glast - Gc[j + 1]) * LOG2E);
            w[j >> 1] = cvtpk(k0, k1); }
        const unsigned sx = (k >> 1) & 7;
        *(LAS v4u*)(lds + HG_KT + 128 * k + 16 * ((2 * a) ^ sx)) = (v4u){w[0], w[1], w[2], w[3]};
        *(LAS v4u*)(lds + HG_KT + 128 * k + 16 * ((2 * a + 1) ^ sx)) = (v4u){w[4], w[5], w[6], w[7]};
    }
    if (!SAMPLE && a == 0) Dout[k] = ex2(Glast * LOG2E);
    __syncthreads();
    const int r32 = lane & 31, h = lane >> 5, kb = wid >> 1;
    const unsigned q4 = (lane & 15) >> 2, pp = lane & 3, bc = (lane >> 4) & 1;
    f32x16 acc[2] = {};
    const int krow = 32 * kb + r32; const unsigned sx = (krow >> 1) & 7;
#pragma unroll
    for (int s = 0; s < 4; ++s) {
        const bf16x8 af = *(const LAS bf16x8*)(lds + HG_KT + 128 * krow + 16 * ((unsigned)(2 * s + h) ^ sx));
#pragma unroll
        for (int vv = 0; vv < 2; ++vv) { const int vb = 2 * (wid & 1) + vv;
            const unsigned row0 = 16u * s + 8u * h + q4, row1 = row0 + 4u, chn = 4u * vb + 2u * bc + (pp >> 1);
            const unsigned x0 = (q4 << 2) | ((row0 >> 2) & 3u), x1 = (q4 << 2) | ((row1 >> 2) & 3u);
            const s16x4 lo = __builtin_amdgcn_ds_read_tr16_b64_v4i16((LAS s16x4*)(lds + HG_V + 256u * row0 + 16u * (chn ^ x0) + 8u * (pp & 1)));
            const s16x4 hi = __builtin_amdgcn_ds_read_tr16_b64_v4i16((LAS s16x4*)(lds + HG_V + 256u * row1 + 16u * (chn ^ x1) + 8u * (pp & 1)));
            const bf16x8 bfg = {lo[0], lo[1], lo[2], lo[3], hi[0], hi[1], hi[2], hi[3]};
            acc[vv] = __builtin_amdgcn_mfma_f32_32x32x16_bf16(af, bfg, acc[vv], 0, 0, 0); }
    }
    const LAS float* tot = (const LAS float*)(lds + HG_TOT);
#pragma unroll
    for (int vv = 0; vv < 2; ++vv) { const int v = 32 * (2 * (wid & 1) + vv) + r32;
#pragma unroll
        for (int r = 0; r < 16; ++r) { const int kk = 32 * kb + (r & 3) + 8 * (r >> 2) + 4 * h;
            float val = acc[vv][r];
            if (SAMPLE) { const float gl = (tot[kk] + tot[128 + kk]) + (tot[256 + kk] + tot[384 + kk]); val += ex2(gl * LOG2E) * S0[kk * 128 + v]; }
            if (SAMPLE) Sout[kk * 128 + v] = val;
            else { const float nb_ = __shfl_xor(val, 1);
                   if ((lane & 1) == 0) *(unsigned*)((bf16_t*)Sout + kk * 128 + v) = cvtpk(val, nb_); } } }
    __syncthreads();
}

template <bool SAMPLE>
__device__ __forceinline__ void hg_local(LAS unsigned char* lds, const bf16_t* KAp, const bf16_t* VAp, const float* Gp, int ntok, const float* S0, float* Sout, float* Dout, int tid, int wid, int lane) {
    asm volatile("" : "+v"(tid));
    HgIn I; hg_local_load(I, KAp, VAp, Gp, ntok, tid);
    hg_local_compute<SAMPLE>(lds, I, S0, Sout, Dout, tid, wid);
}

__device__ __forceinline__ void hg_output(LAS unsigned char* lds, const bf16_t* QAp, const bf16_t* KAp, const bf16_t* VAp, const float* Gp, const bf16_t* GAp, int ntok,
                                          const bf16_t* Sst16, const float* S0f, const float* anw, bf16_t* Outp  , int tid, int wid, int lane) {
    asm volatile("" : "+v"(tid)); lane = tid & 63;
    const int k = tid & 127, a = tid >> 7;
    float g[16]; hg_load_g(Gp, ntok, k, a, g);
    v4u vt[2]; hg_tile_load(VAp, ntok, tid, vt);
    unsigned short qr[16], kr[16];
#pragma unroll
    for (int j = 0; j < 16; ++j) { const int i = 16 * a + j; qr[j] = 0; kr[j] = 0; if (i < ntok) { qr[j] = QAp[(size_t)i * HW + k]; kr[j] = KAp[(size_t)i * HW + k]; } }
    v4u s16[4]; f32x4 s32[8];
    if (Sst16) {
#pragma unroll
        for (int i = 0; i < 4; ++i) { const int id = tid + 512 * i, row = id >> 4, ch = id & 15; s16[i] = *(const v4u*)(Sst16 + (size_t)row * 128 + ch * 8); }
    } else {
#pragma unroll
        for (int i = 0; i < 8; ++i) { const int id = tid + 512 * i, row = id >> 5, c4 = id & 31; s32[i] = *(const f32x4*)(S0f + (size_t)row * 128 + c4 * 4); }
    }
    v2u gwv[4]; f32x4 wwv[4];
    { const int lane_e = tid & 63, r32e = lane_e & 31, he = lane_e >> 5, vbe = wid & 3, ibe = wid >> 2, ie = 32 * ibe + r32e;
      const bf16_t* gp = GAp + (size_t)(ie < ntok ? ie : 0) * HW + 32 * vbe + 4 * he; const float* wp = anw + 32 * vbe + 4 * he;
#pragma unroll
      for (int g2 = 0; g2 < 4; ++g2) { gwv[g2] = *(const v2u*)(gp + 8 * g2); wwv[g2] = *(const f32x4*)(wp + 8 * g2); } }
    float Gc[16], Glast, Gmid;
    hg_scan(g, (LAS float*)(lds + HG_TOT), k, a, Gc, Glast, Gmid);
    hg_tile_write(lds + HG_V, tid, vt);
    if (Sst16) {
#pragma unroll
        for (int i = 0; i < 4; ++i) { const int id = tid + 512 * i, row = id >> 4, ch = id & 15; *(LAS v4u*)(lds + HG_SST + off_b(row, ch)) = s16[i]; }
    } else {
#pragma unroll
        for (int i = 0; i < 8; ++i) { const int id = tid + 512 * i, row = id >> 5, c4 = id & 31; const f32x4 v = s32[i];
            v2u w; w.x = cvtpk(v.x, v.y); w.y = cvtpk(v.z, v.w); *(LAS v2u*)(lds + HG_SST + off_b(row, c4 >> 1) + (c4 & 1) * 8) = w; }
    }
#pragma unroll
    for (int j = 0; j < 16; ++j) { const int i = 16 * a + j;
        const float q = bf2f(qr[j]), kk = bf2f(kr[j]);
        const float eq = ex2(Gc[j] * LOG2E), em = ex2(fminf((Gc[j] - Gmid) * LOG2E, 115.f)), ek = ex2(fminf((Gmid - Gc[j]) * LOG2E, 115.f));
        const unsigned o2 = off_b(i, k >> 3) + (k & 7) * 2;
        *(LAS bf16_t*)(lds + HG_QP + o2) = (bf16_t)(cvtpk(q * eq, 0.f) & 0xffffu);
        *(LAS bf16_t*)(lds + HG_QM + o2) = (bf16_t)(cvtpk(q * em, 0.f) & 0xffffu);
        *(LAS bf16_t*)(lds + HG_KM + o2) = (bf16_t)(cvtpk(kk * ek, 0.f) & 0xffffu); }
    __syncthreads();
    const int r32 = lane & 31, h = lane >> 5, vb = wid & 3, ib = wid >> 2;
    const unsigned q4 = (lane & 15) >> 2, pp = lane & 3, bc = (lane >> 4) & 1;
    f32x16 o = {};
    const bool active = (32 * ib < ntok);
    if (active) {
        const unsigned irow = 32u * ib + r32, ix = ((irow & 3u) << 2) | ((irow >> 2) & 3u);
#pragma unroll
        for (int s = 0; s < 8; ++s) {
            const bf16x8 bq = *(const LAS bf16x8*)(lds + HG_QP + 256u * irow + 16u * ((unsigned)(2 * s + h) ^ ix));
            const unsigned row0 = 16u * s + 8u * h + q4, row1 = row0 + 4u, chn = 4u * vb + 2u * bc + (pp >> 1);
            const unsigned x0 = (q4 << 2) | ((row0 >> 2) & 3u), x1 = (q4 << 2) | ((row1 >> 2) & 3u);
            const s16x4 lo = __builtin_amdgcn_ds_read_tr16_b64_v4i16((LAS s16x4*)(lds + HG_SST + 256u * row0 + 16u * (chn ^ x0) + 8u * (pp & 1)));
            const s16x4 hi = __builtin_amdgcn_ds_read_tr16_b64_v4i16((LAS s16x4*)(lds + HG_SST + 256u * row1 + 16u * (chn ^ x1) + 8u * (pp & 1)));
            const bf16x8 as = {lo[0], lo[1], lo[2], lo[3], hi[0], hi[1], hi[2], hi[3]};
            o = __builtin_amdgcn_mfma_f32_32x32x16_bf16(as, bq, o, 0, 0, 0);
        }
#pragma unroll
        for (int jb = 0; jb < 2; ++jb) {
            if (jb > ib) continue;
            f32x16 p = {};
            const unsigned jrow = 32u * jb + r32, jx = ((jrow & 3u) << 2) | ((jrow >> 2) & 3u);
#pragma unroll
            for (int s = 0; s < 8; ++s) {
                const bf16x8 ak = *(const LAS bf16x8*)(lds + HG_KM + 256u * jrow + 16u * ((unsigned)(2 * s + h) ^ jx));
                const bf16x8 bq = *(const LAS bf16x8*)(lds + HG_QM + 256u * irow + 16u * ((unsigned)(2 * s + h) ^ ix));
                p = __builtin_amdgcn_mfma_f32_32x32x16_bf16(ak, bq, p, 0, 0, 0);
            }
            float x[16];
#pragma unroll
            for (int r = 0; r < 16; ++r) { const int j = 32 * jb + (r & 3) + 8 * (r >> 2) + 4 * h, i = 32 * ib + r32; x[r] = (j <= i) ? p[r] : 0.f; }
#pragma unroll
            for (int ks = 0; ks < 2; ++ks) {
                v4u w; w.x = cvtpk(x[8 * ks], x[8 * ks + 1]); w.y = cvtpk(x[8 * ks + 2], x[8 * ks + 3]); w.z = cvtpk(x[8 * ks + 4], x[8 * ks + 5]); w.w = cvtpk(x[8 * ks + 6], x[8 * ks + 7]);
                const bf16x8 pk = __builtin_bit_cast(bf16x8, w);
                const unsigned row0 = 32u * jb + 16u * ks + 4u * h + q4, row1 = row0 + 8u, chn = 4u * vb + 2u * bc + (pp >> 1);
                const unsigned x0 = (q4 << 2) | ((unsigned)h & 3u), x1 = (q4 << 2) | (((unsigned)h + 2u) & 3u);
                const s16x4 lo = __builtin_amdgcn_ds_read_tr16_b64_v4i16((LAS s16x4*)(lds + HG_V + 256u * row0 + 16u * (chn ^ x0) + 8u * (pp & 1)));
                const s16x4 hi = __builtin_amdgcn_ds_read_tr16_b64_v4i16((LAS s16x4*)(lds + HG_V + 256u * row1 + 16u * (chn ^ x1) + 8u * (pp & 1)));
                const bf16x8 av = {lo[0], lo[1], lo[2], lo[3], hi[0], hi[1], hi[2], hi[3]};
                o = __builtin_amdgcn_mfma_f32_32x32x16_bf16(av, pk, o, 0, 0, 0);
            }
        }
    }
    float ss = 0.f;
#pragma unroll
    for (int r = 0; r < 16; ++r) ss += o[r] * o[r];
    { auto rr = __builtin_amdgcn_permlane32_swap(__float_as_uint(ss), __float_as_uint(ss), false, false); ss = __uint_as_float(rr[0]) + __uint_as_float(rr[1]); }
    LAS float* red = (LAS float*)(lds + HG_RED);
    if (h == 0) red[(ib * 4 + vb) * 32 + r32] = ss;
    __syncthreads();
    const int i = 32 * ib + r32;
    if (active && i < ntok) {
        const float tot = (red[(ib * 4 + 0) * 32 + r32] + red[(ib * 4 + 1) * 32 + r32]) + (red[(ib * 4 + 2) * 32 + r32] + red[(ib * 4 + 3) * 32 + r32]);
        const float rn = rsqrtf(tot * (1.f / 128.f) + EPS);
        bf16_t* op = Outp + (size_t)i * DM + 32 * vb + 4 * h;
#pragma unroll
        for (int g = 0; g < 4; ++g) { const v2u gw = gwv[g]; const f32x4 ww = wwv[g];
            v2u w; w.x = cvtpk(o[4 * g] * rn * ww.x * bflo(gw.x), o[4 * g + 1] * rn * ww.y * bfhi(gw.x)); w.y = cvtpk(o[4 * g + 2] * rn * ww.z * bflo(gw.y), o[4 * g + 3] * rn * ww.w * bfhi(gw.y));
            *(v2u*)(op + 8 * g) = w; }
    }
    __syncthreads();
}
#ifndef MK_FUSED
#define MK_FUSED 1
#endif
#ifndef MK_DEBUG
#define MK_DEBUG 0
#endif

constexpr int FI3 = (DM / 64) * (N1 / 64) + DM / 64, FI4 = (DM / 64) * (DM / 64), FILL_P1 = 6000;
__device__ __forceinline__ void w3_item(const float* w_in_odd, bf16_t* W3T, LAS float* scr, int it, int lane) {
    if (it < (DM / 64) * (N1 / 64)) p0_transpose_item64(w_in_odd, DM, N3R, W3T, scr, it, lane);
    else p0_transpose_item(w_in_odd, DM, N3R, W3T, scr, (it - (DM / 64) * (N1 / 64)) * (N3R / 32) + (N3R / 32 - 1), lane);
}
__device__ __forceinline__ void filler_static(bool w3, int first, int stride, int lo, int hi, const float* w_in_odd, const float* w_out_odd, bf16_t* W3T, bf16_t* W4T, LAS float* scr, int lane) {
    for (int it = lo + first; it < hi; it += stride) { if (w3) w3_item(w_in_odd, W3T, scr, it, lane); else p0_transpose_item64(w_out_odd, DM, DM, W4T, scr, it, lane); }
}
__device__ __forceinline__ void filler_drain(unsigned* fq, int lo, int hi, const float* w_in_odd, bf16_t* W3T, LAS float* scr, int lane) {
    for (;;) {
        int it = 0; if (lane == 0) it = (int)atomicAdd(fq, 4u);
        it = lo + __builtin_amdgcn_readfirstlane(it);
        if (it >= hi) break;
        const int e4 = (it + 4 < hi) ? it + 4 : hi;
        for (; it < e4; ++it) w3_item(w_in_odd, W3T, scr, it, lane);
    }
}
struct OneUnit { int pm, pn, hf;
    __device__ __forceinline__ bool next(int i, pg8::Unit& u) const { if (i) return false; u.pm = pm; u.pn = pn; u.hf = hf; return true; }
    __device__ __forceinline__ void a_ready(const pg8::Unit&) const {}
    __device__ __forceinline__ void done(const pg8::Unit&) const {} };
struct Args { const float* in[17]; float* out; unsigned char* ws; int ph_lo, ph_hi; };
constexpr int NPHASE = 11;

#define TIDX (wid0 * 64 + (int)__builtin_amdgcn_mbcnt_hi(~0u, __builtin_amdgcn_mbcnt_lo(~0u, 0u)))
#define PH_TID int tid = TIDX; asm volatile("" : "+v"(tid)); const int lane = tid & 63; (void)lane;
#define PH_PTRS const int wid = wid0; const int gw = bx * NWAVES + wid; (void)gw; unsigned char* ws_ = args.ws; unsigned* ctl_ = (unsigned*)(ws_ + WS_CTL); (void)ctl_; const float* x_prompt = args.in[0]; const float* x_sample = args.in[1]; const float* state_a = args.in[2]; const float* cache_b_k = args.in[3]; const float* cache_b_v = args.in[4]; const float* cache_c_k = args.in[5]; const float* cache_c_v = args.in[6]; const float* cache_c_logf = args.in[7]; const float* norm_w = args.in[8]; const float* final_w = args.in[9]; const float* w_in_even = args.in[10]; const float* w_out_even = args.in[11]; const float* lb_logits = args.in[12]; const float* a_norm_w = args.in[13]; const float* w_in_odd = args.in[14]; const float* b_forget = args.in[15]; const float* w_out_odd = args.in[16]; float* out = args.out; bf16_t* W1T = (bf16_t*)(ws_ + WS_W1T); bf16_t* W2T = (bf16_t*)(ws_ + WS_W2T); bf16_t* W3T = (bf16_t*)(ws_ + WS_W3T); bf16_t* W4T = (bf16_t*)(ws_ + WS_W4T); bf16_t* XN = (bf16_t*)(ws_ + WS_XN); bf16_t* P = (bf16_t*)(ws_ + WS_P); float* Gb = (float*)(ws_ + WS_G); bf16_t* A = (bf16_t*)(ws_ + WS_A); float* H1 = (float*)(ws_ + WS_H1); float* SLOC = (float*)(ws_ + WS_SLOC); bf16_t* SST = (bf16_t*)(ws_ + WS_SST); float* DEC = (float*)(ws_ + WS_DEC); float* FL = (float*)(ws_ + WS_FL); float* FCP = (float*)(ws_ + WS_FCP); float* FCS = (float*)(ws_ + WS_FCS); float* LB = (float*)(ws_ + WS_LB); unsigned long long* RS1 = (unsigned long long*)(ctl_ + CW_RS1); unsigned long long* RS2 = (unsigned long long*)(ctl_ + CW_RS2); bf16_t* QA = P; bf16_t* KA = P + PSTR1; bf16_t* VA = P + 2 * PSTR1; bf16_t* GA = P + 3 * PSTR1; bf16_t* QB = P + 4 * PSTR1; bf16_t* KB = P + 5 * PSTR1; bf16_t* VB = P + 6 * PSTR1; bf16_t* GB = P + 7 * PSTR1; bf16_t* P3 = (bf16_t*)(ws_ + WS_P3); bf16_t* QC = P3; bf16_t* KC = P3 + PSTR3; bf16_t* VC = P3 + 2 * PSTR3; bf16_t* GC = P3 + 3 * PSTR3;
__global__ void __launch_bounds__(NWAVES * 64, 2) fwd_kernel(Args args) {
    extern __shared__ __attribute__((aligned(16))) unsigned char lds_raw[];
    LAS unsigned char* lds = (LAS unsigned char*)lds_raw;
    const int tid0 = threadIdx.x;
    const int wid0 = __builtin_amdgcn_readfirstlane(tid0 >> 6);
    const int G = gridDim.x, bx = blockIdx.x;
    const int NGW = G * NWAVES;
    unsigned char* ws = args.ws;
    unsigned* ctl = (unsigned*)(ws + WS_CTL);
    volatile LAS unsigned* MISC = (volatile LAS unsigned*)(lds + MISC_OFF);
    for (int u = tid0; u < (LDS_BYTES - RING_BYTES) / 4; u += NWAVES * 64) ((LAS unsigned*)(lds + RING_BYTES))[u] = 0u;
    __syncthreads();
    const int lo = args.ph_lo, hi = args.ph_hi;
    const bool fused = (hi - lo) > 1;
    XcdBarrier bar; bar.bar = ctl + CW_BAR; bar.x = 0; bar.st = nullptr;
    if (fused) bar = xcd_barrier_post(ctl + CW_BAR, MISC + 8);
#ifdef ONLY
#define IN(k) ((k) == ONLY && lo <= (k) && (k) < hi)
#else
#define IN(k) (lo <= (k) && (k) < hi)
#endif
#ifndef DUP_MASK
#define DUP_MASK 0
#endif
#define REP(k) for (int rep_ = 0; rep_ < (((DUP_MASK >> (k)) & 1) ? 2 : 1); ++rep_)
#define SEAM(k) do { if (IN(k) && IN((k) + 1)) xcd_barrier(bar, wid0); } while (0)

    if (IN(0)) REP(0) { PH_PTRS PH_TID
        LAS float* scr = (LAS float*)(lds + wid * 16384);
        constexpr int I1 = (DM / 64) * (N1 / 64), I2 = (DM / 64) * (DM / 64);
        for (int it = gw; it < I1 + I2; it += NGW) {
            if (it < I1) p0_transpose_item64(w_in_even, DM, N1, W1T, scr, it, lane);
            else p0_transpose_item64(w_out_even, DM, DM, W2T, scr, it - I1, lane);
        }
        for (int m = gw; m < MROWS; m += NGW) norm_row_to_bf16(m < TP ? x_prompt + (size_t)m * DM : x_sample + (size_t)(m - TP) * DM, norm_w, XN + (size_t)m * DM, lane);
        {
            v4u* z = (v4u*)(W3T + (size_t)N3R * DM); const size_t n16 = (size_t)(N3 - N3R) * DM / 8;
            for (size_t i = (size_t)bx * 512 + tid; i < n16; i += (size_t)G * 512) z[i] = (v4u){0u, 0u, 0u, 0u};
        }
        for (int c = bx * 512 + tid; c < HW; c += G * 512) LB[c] = rcpf_(1.f + __expf(lb_logits[HW + c] - lb_logits[c]));
    }
    SEAM(0);
    if (IN(1)) REP(1) { PH_PTRS PH_TID
        { pg8::Gemm g{XN, W1T, TP, N1, DM}; pg8::StaticOrder S; S.init(TP, N1, G, bx);
          Epi1 E{P, Gb, LB, out};
          pg8::gemm_phase<Epi1, pg8::StaticOrder, true, true>(lds, g, S, E, tid); }
        for (int hu = bx; hu < 128; hu += G) { pg8::Gemm g{XN, W1T, MROWS, N1, DM}; OneUnit S{32, hu >> 1, hu & 1};
            Epi1 E{P, Gb, LB, out};
            pg8::gemm_phase<Epi1, OneUnit, true, true, true>(lds, g, S, E, tid); }
        if (G > 128) { if (bx >= 128) filler_static(true, (bx - 128) * NWAVES + wid, (G - 128) * NWAVES, 0, FILL_P1, w_in_odd, w_out_odd, W3T, W4T, (LAS float*)(lds + wid * 16384), lane); }
        else filler_static(true, gw, NGW, 0, FILL_P1, w_in_odd, w_out_odd, W3T, W4T, (LAS float*)(lds + wid * 16384), lane);
    }
    SEAM(1);
    if (IN(2)) REP(2) { PH_PTRS
#ifndef P2SUB
#define P2SUB 31
#endif
#ifndef P2REP
#define P2REP 0
#endif
#define R2(bit) for (int r2_ = 0; r2_ < ((P2REP & (bit)) ? 3 : 1); ++r2_)
        if (P2SUB & 2) R2(2) for (int u = bx; u < NSB * NH_B; u += G) attn_sample_sb_unit(lds, u >> 4, u & 15, QB, KB, VB, GB, cache_b_k, cache_b_v, A, TIDX, wid);
        if (P2SUB & 4) R2(4) {
            int tid = TIDX; asm volatile("" : "+v"(tid));
            HgIn I;
            if (bx < NH_A * 128) { const size_t ro = (size_t)(64 * (bx & 127)) * HW + (bx >> 7) * HD; hg_local_load(I, KA + ro, VA + ro, Gb + ro, 64, tid); }
            for (int u = bx; u < NH_A * 128; u += G) {
                HgIn N; const int un = u + G;
                if (un < NH_A * 128) { const size_t ro = (size_t)(64 * (un & 127)) * HW + (un >> 7) * HD; hg_local_load(N, KA + ro, VA + ro, Gb + ro, 64, tid); }
                hg_local_compute<false>(lds, I, nullptr, SLOC + (size_t)u * 8192  , DEC + (size_t)u * 128, tid, wid);
                if (un < NH_A * 128) I = N;
            }
        }
        if (P2SUB & 8) R2(8) for (int u = bx; u < NSB * NH_A; u += G) { const int b = u >> 4, hd = u & 15; const size_t ro = (size_t)(TP + 16 * b) * HW + hd * HD; const float* S0 = state_a + (size_t)u * 16384;
            hg_local<true>(lds, KA + ro, VA + ro, Gb + ro, 16, S0, out + O_SAS + (size_t)u * 16384, nullptr, TIDX, wid, 0); }
        if (P2SUB & 16) R2(16) for (int u = bx; u < NSB * NH_A; u += G) { const int b = u >> 4, hd = u & 15; const size_t ro = (size_t)(TP + 16 * b) * HW + hd * HD; const float* S0 = state_a + (size_t)u * 16384;
            hg_output(lds, QA + ro, KA + ro, VA + ro, Gb + ro, GA + ro, 16, nullptr, S0, a_norm_w, A + (size_t)(TP + 16 * b) * DM + hd * HD, TIDX, wid, 0); }
    }
    SEAM(2);
    if (IN(3)) REP(3) { PH_PTRS PH_TID
        const int NG = (G >= 128) ? 32 : 0, NSCAN = (G >= 128) ? 64 : G;
        if (bx < NG) {
            pg8::Gemm g{A, W2T, MROWS, DM, DM}; OneUnit S{32, bx >> 1, bx & 1};
            EpiRes<true> E{x_prompt, x_sample, H1, XN, norm_w + DM, RS1};
            pg8::gemm_phase<EpiRes<true>, OneUnit, true, true, true>(lds, g, S, E, tid);
        } else if (bx < NG + NSCAN) { const int sb = bx - NG;
            if (NSCAN == 64) {
                const unsigned* sl[4]; const float* dc[4]; unsigned* so[4]; float s0[4], s1[4];
#pragma unroll
                for (int j = 0; j < 4; ++j) { const int e = sb * 512 + tid + j * 32768; const int hd = e >> 13, k = (e >> 6) & 127, vp = e & 63;
                    sl[j] = (const unsigned*)SLOC + (size_t)hd * 128 * 8192 + k * 64 + vp; dc[j] = DEC + (size_t)hd * 128 * 128 + k; so[j] = (unsigned*)(SST + (size_t)hd * 128 * 16384 + k * 128 + 2 * vp); s0[j] = 0.f; s1[j] = 0.f; }
#pragma unroll 4
                for (int c = 0; c < 128; ++c) {
#pragma unroll
                    for (int j = 0; j < 4; ++j) { const unsigned lw = sl[j][(size_t)c * 8192]; const float d = dc[j][c * 128];
                        so[j][(size_t)c * 8192] = cvtpk(s0[j], s1[j]); s0[j] = fmaf(d, s0[j], bflo(lw)); s1[j] = fmaf(d, s1[j], bfhi(lw)); } }
#pragma unroll
                for (int j = 0; j < 4; ++j) { const int e = sb * 512 + tid + j * 32768; const int hd = e >> 13, k = (e >> 6) & 127, vp = e & 63;
                    *(f32x2*)(out + O_SAP + (size_t)hd * 16384 + k * 128 + 2 * vp) = (f32x2){s0[j], s1[j]}; }
            } else
            for (int e = sb * 512 + tid; e < NH_A * 128 * 64; e += NSCAN * 512) {
                const int hd = e >> 13, k = (e >> 6) & 127, vp = e & 63;
                const unsigned* sl = (const unsigned*)SLOC + (size_t)hd * 128 * 8192 + k * 64 + vp;
                const float* dc = DEC + (size_t)hd * 128 * 128 + k;
                unsigned* so = (unsigned*)(SST + (size_t)hd * 128 * 16384 + k * 128 + 2 * vp);
                float s0 = 0.f, s1 = 0.f;
#pragma unroll 16
                for (int c = 0; c < 128; ++c) { const unsigned lw = sl[(size_t)c * 8192]; const float d = dc[c * 128];
                    so[(size_t)c * 8192] = cvtpk(s0, s1); s0 = fmaf(d, s0, bflo(lw)); s1 = fmaf(d, s1, bfhi(lw)); }
                *(f32x2*)(out + O_SAP + (size_t)hd * 16384 + k * 128 + 2 * vp) = (f32x2){s0, s1};
            }
        }
        if (G < 128) {
            for (int u = bx; u < 32; u += G) { pg8::Gemm g{A, W2T, MROWS, DM, DM}; OneUnit S{32, u >> 1, u & 1}; EpiRes<true> E{x_prompt, x_sample, H1, XN, norm_w + DM, RS1};
                pg8::gemm_phase<EpiRes<true>, OneUnit, true, true, true>(lds, g, S, E, tid); } }
        __syncthreads();
        {
            unsigned* wq = ctl_ + CW_WQ3;
            const int grp = wid >> 2, gw = wid & 3; const int gtid = gw * 64 + (TIDX & 63);
            LAS unsigned char* gl = lds + grp * 65536; LAS unsigned char* gx = lds + RING_BYTES + 2048 + grp * 1024;
            GBar gb; gb.cnt = (volatile LAS unsigned*)(gx + 832); gb.tgt = 0u;
            if (gtid == 0) *gb.cnt = 0u;
            __syncthreads();
            volatile LAS int* wqg = (volatile LAS int*)(gx + 768);
            for (;;) {
                if (gtid == 0) wqg[0] = (int)atomicAdd(wq, 1u);
                gbar_sync(gb, gtid & 63);
                const int u = wqg[0];
                gbar_sync(gb, gtid & 63);
                if (u >= NH_B * 64) break;
                const int hd = u & 15, qb = 63 - (u >> 4);
                attn_prompt_group<0>(gl, gx, gb, QB, KB, VB, GB, HW, hd, qb, A, HW + hd * HD, nullptr, gtid, gw, 0.f);
            }
        }
        __syncthreads();
        filler_drain(ctl_ + CW_FQ, FILL_P1, FI3, w_in_odd, W3T, (LAS float*)(lds + wid * 16384), TIDX & 63);
    }
    SEAM(3);
    if (IN(4)) REP(4) { PH_PTRS
        unsigned* wq = ctl_ + CW_WQ4;
        volatile LAS int* wql = (volatile LAS int*)(lds + RING_BYTES + 1024);
        for (;;) {
            if (TIDX == 0) wql[0] = (int)atomicAdd(wq, 1u);
            __syncthreads();
            const int item = wql[0];
            __syncthreads();
            if (item >= 129 + NH_A * 128) break;
            if (item < 129) {
                int tid = TIDX; asm volatile("" : "+v"(tid));
                pg8::Gemm g{XN, W3T, MROWS, N3, DM}; OneUnit S{32, item >> 1, item & 1};
                Epi3 E{P3, RS1, FL, b_forget, out};
                pg8::gemm_phase<Epi3, OneUnit, true, true, true>(lds, g, S, E, tid);
            } else { const int u = item - 129, hd = u >> 7, c = u & 127; const size_t ro = (size_t)(64 * c) * HW + hd * HD;
                hg_output(lds, QA + ro, KA + ro, VA + ro, Gb + ro, GA + ro, 64, SST + (size_t)u * 16384, nullptr, a_norm_w, A + (size_t)(64 * c) * DM + hd * HD, TIDX, wid, 0); }
        }
        { unsigned* fq = ctl_ + CW_FQ + 64;
          const int lane_ = TIDX & 63; LAS float* scr_ = (LAS float*)(lds + wid * 16384);
          for (;;) { int it = 0; if (lane_ == 0) it = (int)atomicAdd(fq, 4u); it = __builtin_amdgcn_readfirstlane(it); if (it >= FI4) break;
              const int e4 = (it + 4 < FI4) ? it + 4 : FI4; for (; it < e4; ++it) p0_transpose_item64(w_out_odd, DM, DM, W4T, scr_, it, lane_); } }
    }
    SEAM(4);
    if (IN(5)) REP(5) { PH_PTRS PH_TID
        pg8::Gemm g{A, W2T, TP, DM, DM}; pg8::StaticOrder S; S.init(TP, DM, G, bx);
        EpiRes<true> E{x_prompt, x_sample, H1, XN, norm_w + DM, RS1};
        pg8::gemm_phase<EpiRes<true>, pg8::StaticOrder, true, true>(lds, g, S, E, tid);
    }
    SEAM(5);
    if (IN(6)) REP(6) { PH_PTRS PH_TID
        pg8::Gemm g{XN, W3T, TP, N1, DM}; pg8::StaticOrder S; S.init(TP, N1, G, bx);
        Epi3 E{P3, RS1, FL, b_forget, out};
        pg8::gemm_phase<Epi3, pg8::StaticOrder, true, true>(lds, g, S, E, tid);
        for (int rb = bx; rb < TP / 32; rb += G) fl_rows(lds, XN, W3T + (size_t)N1 * DM, RS1, b_forget, FL, out + O_CFP, 32 * rb, tid, wid);
    }
    SEAM(6);
    if (IN(7)) REP(7) { PH_PTRS PH_TID
        LAS float* scr = (LAS float*)(lds + 1024);
        for (int u = bx; u < NH_C; u += G) { const int hd = u; float v[16];
#pragma unroll
            for (int j = 0; j < 16; ++j) v[j] = FL[(size_t)(tid * 16 + j) * 32 + hd] * -NFRS;
            wg_scan<16>(v, scr, tid, wid, lane);
#pragma unroll
            for (int j = 0; j < 16; j += 4) *(f32x4*)(FCP + (size_t)hd * TP + tid * 16 + j) = (f32x4){v[j], v[j + 1], v[j + 2], v[j + 3]};
        }
        {
            unsigned* KN2 = ctl_ + CW_KN2;
            for (int u = bx; u < NH_C * 8; u += G) { const int hd = u >> 3, part = u & 7; float mx = 0.f;
#pragma unroll
                for (int kk = 0; kk < 2; ++kk) { const int key = part * 1024 + tid * 2 + kk; const v4u* kp = (const v4u*)(KC + (size_t)key * DM + hd * HD); float s2 = 0.f;
#pragma unroll
                    for (int c8 = 0; c8 < 16; ++c8) { const v4u w = kp[c8]; const float a0 = bflo(w.x), a1 = bfhi(w.x), a2 = bflo(w.y), a3 = bfhi(w.y), a4 = bflo(w.z), a5 = bfhi(w.z), a6 = bflo(w.w), a7 = bfhi(w.w);
                        s2 += (a0 * a0 + a1 * a1) + (a2 * a2 + a3 * a3) + (a4 * a4 + a5 * a5) + (a6 * a6 + a7 * a7); }
                    mx = fmaxf(mx, s2); }
#pragma unroll
                for (int o = 32; o >= 1; o >>= 1) mx = fmaxf(mx, __shfl_xor(mx, o));
                if (lane == 0) atomicMax(KN2 + hd, __float_as_uint(mx)); }
        }
        __syncthreads();
        for (int u = bx; u < NSB * NH_C; u += G) attn_sample_fox_unit(lds, u >> 5, u & 31, QC, KC, VC, GC, cache_c_k, cache_c_v, cache_c_logf, FL, A, tid, wid, lane);
    }
    SEAM(7);
    if (IN(8)) REP(8) { PH_PTRS
        { unsigned* wq0 = ctl_ + CW_WQ; volatile LAS int* wql = (volatile LAS int*)(lds + RING_BYTES + 1024);
          for (;;) {
            if (TIDX == 0) wql[0] = (int)atomicAdd(wq0, 1u);
            __syncthreads();
            const int item = wql[0];
            __syncthreads();
            if (item >= 32) break;
            int tid = TIDX; asm volatile("" : "+v"(tid));
            pg8::Gemm g{A, W4T, MROWS, DM, DM}; OneUnit S{32, item >> 1, item & 1};
            EpiRes<false> E{H1, H1 + (size_t)TP * DM, out, nullptr, nullptr, RS2};
            pg8::gemm_phase<EpiRes<false>, OneUnit, true, true, true>(lds, g, S, E, tid);
          } }
        { unsigned* wq = ctl_ + CW_WQ + 16; const unsigned* KN2 = ctl_ + CW_KN2;
          const int grp = wid >> 2, gw = wid & 3; const int gtid = gw * 64 + (TIDX & 63);
          LAS unsigned char* gl = lds + grp * 65536; LAS unsigned char* gx = lds + RING_BYTES + 2048 + grp * 1024;
          GBar gb; gb.cnt = (volatile LAS unsigned*)(gx + 832); gb.tgt = 0u;
          if (gtid == 0) *gb.cnt = 0u;
          __syncthreads();
          volatile LAS int* wqg = (volatile LAS int*)(gx + 768);
          for (;;) {
            if (gtid == 0) wqg[0] = (int)atomicAdd(wq, 1u);
            gbar_sync(gb, gtid & 63);
            const int item = wqg[0];
            gbar_sync(gb, gtid & 63);
            if (item >= 2048) break;
            const int hd = item & 31, qb = 63 - (item >> 5);
            attn_prompt_group<1>(gl, gx, gb, QC, KC, VC, GC, DM, hd, qb, A, hd * HD, FCP + (size_t)hd * TP, gtid, gw, sqrtf(__uint_as_float(KN2[hd])) * QK2);
          }
          __syncthreads(); }
    }
    SEAM(8);
    if (IN(9)) REP(9) { PH_PTRS PH_TID
        pg8::Gemm g{A, W4T, TP, DM, DM}; pg8::StaticOrder S; S.init(TP, DM, G, bx);
        EpiRes<false> E{H1, H1 + (size_t)TP * DM, out, nullptr, nullptr, RS2};
        pg8::gemm_phase<EpiRes<false>, pg8::StaticOrder, true, true>(lds, g, S, E, tid);
    }
    SEAM(9);
    if (IN(10)) REP(10) { PH_PTRS PH_TID
        for (int m = gw; m < MROWS; m += NGW) {
            const float r = rsqrtf((float)RS2[m] * (1.f / (FIX * 4096.f)) + EPS);
            f32x4* yr = (f32x4*)(out + (size_t)m * DM) + lane; const f32x4* wr_ = (const f32x4*)final_w + lane;
#pragma unroll
            for (int j = 0; j < 16; ++j) { const f32x4 v = yr[64 * j], ww = wr_[64 * j]; yr[64 * j] = (f32x4){v.x * r * ww.x, v.y * r * ww.y, v.z * r * ww.z, v.w * r * ww.w}; }
        }
    }
#undef IN
#undef SEAM
}


#if MK_DEBUG
__global__ void dbg_check(const unsigned* p, size_t nwords, int kind  , unsigned long long* stat, unsigned long long* hstat) {
    unsigned long long cs = 0, nf = 0, hg = 0;
    for (size_t i = (size_t)blockIdx.x * blockDim.x + threadIdx.x; i < nwords; i += (size_t)gridDim.x * blockDim.x) {
        const unsigned w = p[i]; cs += (unsigned long long)w * (2ull * i + 1ull);
        if (kind == 0) { nf += ((w & 0x7f800000u) == 0x7f800000u); hg += (((w >> 23) & 0xffu) >= 141u); } else if (kind == 1) { nf += ((w & 0x7f80u) == 0x7f80u) + ((w & 0x7f800000u) == 0x7f800000u); hg += (((w >> 7) & 0xffu) >= 141u) + (((w >> 23) & 0xffu) >= 141u); }
    }
    for (int o = 32; o >= 1; o >>= 1) { cs += __shfl_xor(cs, o); nf += __shfl_xor(nf, o); hg += __shfl_xor(hg, o); }
    if ((threadIdx.x & 63) == 0) { atomicAdd(stat, nf); atomicAdd(stat + 1, cs); atomicAdd(hstat, hg); }
}
__global__ void dbg_check2(const unsigned short* p, int rows, int ld, int col0, int ncols, unsigned long long* stat, unsigned long long* hstat) {
    unsigned long long cs = 0, nf = 0, hg = 0; const size_t n = (size_t)rows * ncols;
    for (size_t i = (size_t)blockIdx.x * blockDim.x + threadIdx.x; i < n; i += (size_t)gridDim.x * blockDim.x) {
        const size_t r = i / ncols, cc = i % ncols; const unsigned w = p[r * ld + col0 + cc]; cs += (unsigned long long)w * (2ull * i + 1ull); nf += ((w & 0x7f80u) == 0x7f80u); hg += (((w >> 7) & 0xffu) >= 141u);
    }
    for (int o = 32; o >= 1; o >>= 1) { cs += __shfl_xor(cs, o); nf += __shfl_xor(nf, o); hg += __shfl_xor(hg, o); }
    if ((threadIdx.x & 63) == 0) { atomicAdd(stat, nf); atomicAdd(stat + 1, cs); atomicAdd(hstat, hg); }
}
__global__ void dbg_report(const unsigned long long* stat, const unsigned long long* hstat, float* out, unsigned* codew) {
    __shared__ int code_s;
    if (threadIdx.x == 0) {
        int code = 0;
        const int order[28] = {1, 2, 3, 4, 5, 6, 7, 8, 9, 10, 11, 12, 25, 26, 27, 13, 14, 15, 16, 17, 18, 19, 20, 21, 22, 23, 24, 0};
        for (int q = 0; q < 27 && !code; ++q) { const int k = order[q];
            if (stat[(0 * 32 + k) * 2] || stat[(1 * 32 + k) * 2]) code = k;
            else if (k != 15 && k != 23 && k != 22 && hstat[k]) code = 64 + k;
            else if (stat[(0 * 32 + k) * 2 + 1] != stat[(1 * 32 + k) * 2 + 1]) code = 32 + k; }
        { const unsigned bits = ((const unsigned*)hstat)[62]; if (bits) { int idx = 0; while (!((bits >> idx) & 1u)) ++idx; code = 92 + idx; } }
        if (!code) { const unsigned* cst = (const unsigned*)hstat + 64;
            for (int i = 14; i >= 0; --i) { const float er = __uint_as_float(cst[2 * i]), rf = __uint_as_float(cst[2 * i + 1]); if (er > 0.06f * rf + 1e-3f) code = 100 + 10 * i; } }
        code_s = code; if (blockIdx.x == 0) *codew = (unsigned)code;
    }
    __syncthreads();
    const int code = code_s; if (!code) return;
    const float c = sqrtf((float)code);
    for (size_t i = (size_t)blockIdx.x * blockDim.x + threadIdx.x; i < O_END; i += (size_t)gridDim.x * blockDim.x) out[i] = (i >= O_YS && i < O_SAP) ? c : 0.f;
}
#endif

#if MK_DEBUG
__device__ __forceinline__ float blk_sum128(float v, float* red) {
    for (int o = 32; o >= 1; o >>= 1) v += __shfl_xor(v, o);
    __syncthreads(); if ((threadIdx.x & 63) == 0) red[threadIdx.x >> 6] = v; __syncthreads();
    return red[0] + red[1];
}
__device__ __forceinline__ void chk_accum(float ref, float got, unsigned* st) {
    float e = fabsf(ref - got), r = fabsf(ref); if (!(e == e)) e = 1e30f;
    for (int o = 32; o >= 1; o >>= 1) { e = fmaxf(e, __shfl_xor(e, o)); r = fmaxf(r, __shfl_xor(r, o)); }
    if ((threadIdx.x & 63) == 0) { atomicMax(st, __float_as_uint(e)); atomicMax(st + 1, __float_as_uint(r)); }
}
template <int MODE>
__global__ void chk_attn(const bf16_t* Q, const bf16_t* K, const bf16_t* V, const bf16_t* Gt, int ld, int NH, const float* ck, const float* cv, const float* clf  ,
                         const float* FL, const bf16_t* A, int acol0, int nprompt, unsigned* st, int smp_slot, int prompt_slot0) {
    __shared__ float red[2];
    const int d = threadIdx.x; int hd, qrow, qpos, b = 0; bool smp;
    if ((int)blockIdx.x < nprompt) { smp = false; hd = blockIdx.x % NH; const int j = blockIdx.x / NH; qrow = (j * 1237 + 5) % TP; qpos = qrow; }
    else { smp = true; const int u = blockIdx.x - nprompt; const int t = u & 15; hd = (u >> 4) % NH; b = (u >> 4) / NH; qrow = TP + 16 * b + t; qpos = PAST + t; }
    const float q = bf2f(Q[(size_t)qrow * ld + hd * HD + d]) ;
    const int s_top = MODE ? qpos : qpos - 1;
    float o = 0.f, tail = 0.f, m = -1e30f, l = 0.f, dsum = 0.f;
    for (int s = s_top; s >= 0; --s) {
        float kv, vv;
        if (smp) { if (s < PAST) { const size_t ix = (((size_t)b * PAST + s) * NH + hd) * HD + d; kv = ck[ix]; vv = cv[ix]; } else { const size_t ix = (size_t)(TP + 16 * b + s - PAST) * ld + hd * HD + d; kv = bf2f(K[ix]); vv = bf2f(V[ix]); } }
        else { const size_t ix = (size_t)s * ld + hd * HD + d; kv = bf2f(K[ix]); vv = bf2f(V[ix]); }
        const float z = blk_sum128(q * kv, red) * 0.08838834764831845f;
        if (MODE == 0) {
            const float lp = fminf(z, 0.f) - log1pf(expf(-fabsf(z))), lm = lp - z;
            o += expf(lp + tail) * vv; tail += lm;
            if (tail < -200.f) break;
        } else {
            const float x = z + dsum;
            const float mn = fmaxf(m, x), al = expf(m - mn), p = expf(x - mn);
            o = o * al + p * vv; l = l * al + p; m = mn;
            float lf;
            if (smp) lf = (s < PAST) ? clf[((size_t)b * PAST + s) * NH + hd] : FL[(size_t)(TP + 16 * b + s - PAST) * 32 + hd]; else lf = FL[(size_t)s * 32 + hd];
            dsum += lf;
            if (dsum < -200.f && m > -1e29f) break;
        }
    }
    if (MODE == 1) o /= l;
    const float ref = o * bf2f(Gt[(size_t)qrow * ld + hd * HD + d]);
    chk_accum(ref, bf2f(A[(size_t)qrow * DM + acol0 + hd * HD + d]), st + (smp ? 2 * smp_slot : (MODE ? 2 * (prompt_slot0 + (int)(blockIdx.x / NH)) : 0)));
}
__global__ void chk_fc(const float* FL, const float* clf, const float* FCP, const float* FCS, unsigned* st) {
    const int u = blockIdx.x, lane = threadIdx.x;
    if (u < 32) { const int hd = u, t = (lane * 131 + 7) % TP; double s = 0; for (int j = 0; j <= t; ++j) s += (double)FL[(size_t)j * 32 + hd]; chk_accum((float)(s * 1.4426950408889634), FCP[(size_t)hd * TP + t], st); }
    else { const int ub = u - 32, b = ub >> 5, hd = ub & 31, t = (lane * 17 + 3) % 1040; double s = 0; for (int j = 0; j <= t; ++j) s += (double)(j < PAST ? clf[((size_t)b * PAST + j) * 32 + hd] : FL[(size_t)(TP + 16 * b + j - PAST) * 32 + hd]); chk_accum((float)(s * 1.4426950408889634), FCS[(size_t)ub * FCS_LD + t], st + 2); }
}
__global__ void chk_hgrn_sample(const bf16_t* QA, const bf16_t* KA, const bf16_t* VA, const float* Gb, const float* S0, const float* Sout, float* oref, unsigned* st) {
    __shared__ float red[2];
    const int u = blockIdx.x >> 7, v = blockIdx.x & 127, k = threadIdx.x, b = u >> 4, hd = u & 15;
    float S = S0[(size_t)u * 16384 + k * 128 + v];
    for (int t = 0; t < 16; ++t) { const size_t ro = (size_t)(TP + 16 * b + t) * HW + hd * HD;
        S = S * expf(Gb[ro + k]) + bf2f(KA[ro + k]) * bf2f(VA[ro + v]);
        const float ov = blk_sum128(bf2f(QA[ro + k]) * S, red);
        if (k == 0) oref[((size_t)u * 16 + t) * 128 + v] = ov; }
    chk_accum(S, Sout[(size_t)u * 16384 + k * 128 + v], st);
}
__global__ void chk_hgrn_sample_out(const float* oref, const bf16_t* GA, const float* anw, const bf16_t* A, unsigned* st) {
    __shared__ float red[2];
    const int u = blockIdx.x >> 4, t = blockIdx.x & 15, v = threadIdx.x, b = u >> 4, hd = u & 15;
    const float o = oref[((size_t)u * 16 + t) * 128 + v];
    const float ss = blk_sum128(o * o, red);
    const int row = TP + 16 * b + t;
    const float ref = o * rsqrtf(ss * (1.f / 128.f) + EPS) * anw[v] * bf2f(GA[(size_t)row * HW + hd * HD + v]);
    chk_accum(ref, bf2f(A[(size_t)row * DM + hd * HD + v]), st);
}
#endif
extern "C" void kernel_launch(void* const* d_in, const int* in_sizes, int n_in, void* d_out, int out_size, void* d_ws, size_t ws_size, hipStream_t stream) {
    static int grid = 0;
    if (grid == 0) {
        if (n_in != 17 || (size_t)out_size != O_END || ws_size < WS_END) { fprintf(stderr, "kernel_launch: unexpected shapes (n_in %d, out %d, ws %zu)\n", n_in, out_size, ws_size); grid = -1; return; }
        int dev = 0, cus = 0, per_cu = 0;
        if (hipGetDevice(&dev) != hipSuccess || hipDeviceGetAttribute(&cus, hipDeviceAttributeMultiprocessorCount, dev) != hipSuccess) { grid = -1; return; }
        if (hipFuncSetAttribute((const void*)fwd_kernel, hipFuncAttributeMaxDynamicSharedMemorySize, LDS_BYTES) != hipSuccess) { fprintf(stderr, "kernel_launch: hipFuncSetAttribute failed\n"); grid = -1; return; }
        if (hipOccupancyMaxActiveBlocksPerMultiprocessor(&per_cu, (const void*)fwd_kernel, NWAVES * 64, LDS_BYTES) != hipSuccess || per_cu < 1)
            fprintf(stderr, "kernel_launch: occupancy query reports %d workgroups per CU\n", per_cu);
        (void)hipGetLastError();
        grid = cus;
    }
    if (grid < 0) return;
    (void)hipMemsetAsync((char*)d_ws + WS_CTL, 0, CTL_ZERO_BYTES, stream);
    Args a{};
    for (int i = 0; i < 17; ++i) a.in[i] = (const float*)d_in[i];
    a.out = (float*)d_out; a.ws = (unsigned char*)d_ws;
#if MK_DEBUG
    unsigned char* ws = (unsigned char*)d_ws; float* out = (float*)d_out;
    unsigned long long* stat = (unsigned long long*)((unsigned*)(ws + WS_CTL) + CW_STAT);
    unsigned long long* hstat = (unsigned long long*)((unsigned*)(ws + WS_CTL) + CW_HSTAT);
    for (int run = 0; run < 2; ++run) {
        if (run) (void)hipMemsetAsync((char*)d_ws + WS_CTL, 0, (size_t)CW_STAT * 4, stream);
        auto CHK = [&](int k, const void* p, size_t bytes, int kind) { hipLaunchKernelGGL(dbg_check, dim3(2048), dim3(256), 0, stream, (const unsigned*)p, bytes / 4, kind, stat + (run * 32 + k) * 2, hstat + k); };
        auto CHK2 = [&](int k, const void* p, int rows, int ld, int col0, int ncols) { hipLaunchKernelGGL(dbg_check2, dim3(2048), dim3(256), 0, stream, (const unsigned short*)p, rows, ld, col0, ncols, stat + (run * 32 + k) * 2, hstat + k); };
        for (int p = 0; p < NPHASE; ++p) {
            a.ph_lo = p; a.ph_hi = p + 1; hipLaunchKernelGGL(fwd_kernel, dim3(grid), dim3(NWAVES * 64), LDS_BYTES, stream, a);
            switch (p) {
                case 0: CHK(1, ws + WS_W1T, WS_XN - WS_W1T, 1); CHK(2, ws + WS_XN, 66 * MiB, 1); CHK(3, ws + WS_LB, 8192, 0); break;
                case 1: CHK(4, ws + WS_P, 8 * 33 * MiB, 1); CHK(5, ws + WS_G, 66 * MiB, 0); CHK(6, out + O_BKP, (O_CKP - O_BKP) * 4, 0); break;
                case 2: CHK(7, ws + WS_SLOC, 128 * MiB, 0); CHK(8, ws + WS_DEC, 1 * MiB, 0); CHK(9, out + O_SAS, (O_BKP - O_SAS) * 4, 0); break;
                case 3: CHK(10, ws + WS_SST, 64 * MiB, 1); CHK(11, out + O_SAP, (O_SAS - O_SAP) * 4, 0); break;
                case 4: if (run == 0) {
                    unsigned* cst = (unsigned*)(ws + WS_CTL) + CW_HSTAT + 64;
                    bf16_t* Pp = (bf16_t*)(ws + WS_P); float* oref = (float*)(ws + WS_FCS);
                    hipLaunchKernelGGL(chk_attn<0>, dim3(16 * 8 + 256 * 16), dim3(128), 0, stream, Pp + 4 * PSTR1, Pp + 5 * PSTR1, Pp + 6 * PSTR1, Pp + 7 * PSTR1, HW, 16, (const float*)d_in[3], (const float*)d_in[4], (const float*)nullptr, (const float*)nullptr, (const bf16_t*)(ws + WS_A), HW, 16 * 8, cst + 0, 1, 0);
                    hipLaunchKernelGGL(chk_hgrn_sample, dim3(256 * 128), dim3(128), 0, stream, Pp, Pp + PSTR1, Pp + 2 * PSTR1, (const float*)(ws + WS_G), (const float*)d_in[2], (const float*)(out + O_SAS), oref, cst + 4);
                    hipLaunchKernelGGL(chk_hgrn_sample_out, dim3(256 * 16), dim3(128), 0, stream, (const float*)oref, Pp + 3 * PSTR1, (const float*)d_in[13], (const bf16_t*)(ws + WS_A), cst + 6); }
                    CHK2(12, ws + WS_A, TP, DM, 0, HW); CHK2(25, ws + WS_A, TP, DM, HW, HW); CHK2(26, ws + WS_A + (size_t)TP * DM * 2, 256, DM, 0, HW); CHK2(27, ws + WS_A + (size_t)TP * DM * 2, 256, DM, HW, HW); break;
                case 5: CHK(13, ws + WS_H1, 132 * MiB, 0); CHK(14, ws + WS_XN, 66 * MiB, 1); CHK(15, ws + WS_CTL + CW_RS1 * 4, 8448 * 8, 1 + 1); break;
                case 6: CHK(16, ws + WS_P, 4 * 66 * MiB, 1); CHK(17, ws + WS_FL, 8448 * 32 * 4, 0); CHK(18, out + O_CKP, (O_END - O_CKP) * 4, 0); break;
                case 7: CHK(19, ws + WS_FCP, 1 * MiB, 0); CHK(20, ws + WS_FCS, (size_t)512 * FCS_LD * 4, 0); break;
                case 8: if (run == 0) {
                    unsigned* cst = (unsigned*)(ws + WS_CTL) + CW_HSTAT + 64; bf16_t* Pp = (bf16_t*)(ws + WS_P);
                    hipLaunchKernelGGL(chk_attn<1>, dim3(32 * 8 + 512 * 16), dim3(128), 0, stream, Pp, Pp + PSTR3, Pp + 2 * PSTR3, Pp + 3 * PSTR3, DM, 32, (const float*)d_in[5], (const float*)d_in[6], (const float*)d_in[7], (const float*)(ws + WS_FL), (const bf16_t*)(ws + WS_A), 0, 32 * 8, cst, 14, 6);
                    hipLaunchKernelGGL(chk_fc, dim3(32 + 512), dim3(64), 0, stream, (const float*)(ws + WS_FL), (const float*)d_in[7], (const float*)(ws + WS_FCP), (const float*)(ws + WS_FCS), cst + 8); }
                    CHK(21, ws + WS_A, 66 * MiB, 1); break;
                case 9: CHK(22, out, (size_t)MROWS * DM * 4, 0); CHK(23, ws + WS_CTL + CW_RS2 * 4, 8448 * 8, 2); break;
                case 10: CHK(24, out, (size_t)MROWS * DM * 4, 0); break;
            }
        }
    }
    hipLaunchKernelGGL(dbg_report, dim3(1024), dim3(256), 0, stream, (const unsigned long long*)stat, (const unsigned long long*)hstat, out, (unsigned*)(ws + WS_CTL) + CW_HSTAT + 63);
#elif MK_FUSED
    a.ph_lo = 0; a.ph_hi = NPHASE;
    hipLaunchKernelGGL(fwd_kernel, dim3(grid), dim3(NWAVES * 64), LDS_BYTES, stream, a);
#else
    for (int p = 0; p < NPHASE; ++p) { a.ph_lo = p; a.ph_hi = p + 1; hipLaunchKernelGGL(fwd_kernel, dim3(grid), dim3(NWAVES * 64), LDS_BYTES, stream, a); }
#endif
}
```

```cpp
#include <hip/hip_runtime.h>
#include <cstdio>
#include <cstdint>

namespace pg8 {
#define PG8_LAS __attribute__((address_space(3)))
typedef unsigned short bf16_t;
typedef short bf16x8 __attribute__((ext_vector_type(8)));
typedef float f32x4 __attribute__((ext_vector_type(4)));
typedef unsigned u32x4 __attribute__((ext_vector_type(4)));
constexpr int BM = 256, BK = 64, HALF = 128, HTB = HALF * BK * 2  , STAGE_BYTES = 8 * HTB, NXCD = 8, WGM = 8;

__host__ __device__ __forceinline__ int lds_byte(int r, int c) { const int st = (r >> 4) * 2 + (c >> 5), rr = r & 15, cc = c & 31, ob = rr * 64 + cc * 2; return st * 1024 + (ob ^ (((ob >> 9) & 1) << 5)); }
__host__ __device__ __forceinline__ void stage_rc(int b, int& R, int& C) { const int st = b / 1024, sb = b % 1024, swz = sb ^ (((sb >> 9) & 1) << 5); R = (st >> 1) * 16 + swz / 64; C = (st & 1) * 32 + (swz % 64) / 2; }
__host__ __device__ __forceinline__ int perm32(int rho) { const int n = rho >> 4, i = rho & 15; return 8 * (i >> 2) + 4 * n + (i & 3); }

struct Unit { int pm, pn, hf; };
struct Gemm { const bf16_t* A; const bf16_t* Bt; int M, N, K; };

struct StaticOrder {
    int nM, nN, nwg, G, c;
    __host__ __device__ void init(int M, int N, int G_, int c_) { nM = M / BM; nN = N / BM; nwg = nM * nN; G = G_; c = c_; }
    __host__ __device__ bool next(int i, Unit& u) const {
        const long L = (long)i * G + c; if (L >= nwg) return false;
        int wgid = (int)L; { const int q = nwg / NXCD, r = nwg % NXCD, xcd = wgid % NXCD, off = wgid / NXCD; wgid = (xcd < r ? xcd * (q + 1) : r * (q + 1) + (xcd - r) * q) + off; }
        const int nig = WGM * nN, gid = wgid / nig, fm = gid * WGM, gsz = (nM - fm) < WGM ? (nM - fm) : WGM;
        u.pm = fm + ((wgid % nig) % gsz); u.pn = (wgid % nig) / gsz; u.hf = -1; return true;
    }
    __device__ __forceinline__ void a_ready(const Unit&) const {}
    __device__ __forceinline__ void done(const Unit&) const {}
};
__device__ __forceinline__ unsigned cvt_pk_bf16(float lo, float hi) { unsigned r; asm volatile("v_cvt_pk_bf16_f32 %0, %1, %2" : "=v"(r) : "v"(lo), "v"(hi)); return r; }
template <class Epi, class Sched, bool ALIGN_EPI = false, bool SP2 = false, bool HALFN = false>
__device__ __forceinline__ void gemm_phase(PG8_LAS unsigned char* lds, const Gemm g, const Sched& S, const Epi& E, const int tid_in) {
    const int tid = tid_in, wid = __builtin_amdgcn_readfirstlane(tid >> 6), lane = tid & 63, wr = wid >> 2, wc = wid & 3, fr = lane & 15, fq = lane >> 4;
    const int K = g.K, nt = K / BK;
    unsigned voffA[2], voffB[2];
#pragma unroll
    for (int i = 0; i < 2; ++i) { int R, C; stage_rc(tid * 16 + i * 8192, R, C); const int Rb = Epi::PERM ? ((R & ~31) + perm32(R & 31)) : R;
        voffA[i] = (unsigned)(R * K + C) * 2u; voffB[i] = (unsigned)(Rb * K + C) * 2u; }
    const size_t kstep = (size_t)(BK * 2);
    const size_t hstep = (size_t)HALF * K * 2;
    const size_t tstep = 2 * hstep;
    const size_t hstepB = HALFN ? 0 : hstep;
    const unsigned ldsw = (unsigned)wid * 1024u;
    const int aoff = lds_byte(wr * 64 + fr, fq * 8), boff = lds_byte(wc * 32 + fr, fq * 8);
#define PG8_SA(b, h) (((b) * 2 + (h)) * HTB)
#define PG8_SB(b, h) ((4 + (b) * 2 + (h)) * HTB)
#define PG8_STAGE(bufoff, gbase, voff) do { _Pragma("unroll") for (int _i = 0; _i < 2; ++_i) \
        __builtin_amdgcn_global_load_lds((const unsigned*)((const char*)(gbase) + (voff)[_i]), (PG8_LAS unsigned*)(lds + (bufoff) + ldsw + _i * 8192), 16, 0, 0); } while (0)
#define PG8_LDA(dst, b, h) do { _Pragma("unroll") for (int m = 0; m < 4; ++m) _Pragma("unroll") for (int k = 0; k < 2; ++k) dst[m][k] = *(const PG8_LAS bf16x8*)(lds + PG8_SA(b, h) + aoff + m * 2048 + k * 1024); } while (0)
#define PG8_LDB(dst, b, h) do { _Pragma("unroll") for (int n = 0; n < 2; ++n) _Pragma("unroll") for (int k = 0; k < 2; ++k) dst[n][k] = *(const PG8_LAS bf16x8*)(lds + PG8_SB(b, h) + boff + n * 2048 + k * 1024); } while (0)
#define PG8_MMA(ai, bj, At, Bt) do { __builtin_amdgcn_s_setprio(1); _Pragma("unroll") for (int m = 0; m < 4; ++m) _Pragma("unroll") for (int n = 0; n < 2; ++n) _Pragma("unroll") for (int k = 0; k < 2; ++k) \
        acc[ai][bj][m][n] = __builtin_amdgcn_mfma_f32_16x16x32_bf16(Bt[n][k], At[m][k], acc[ai][bj][m][n], 0, 0, 0); __builtin_amdgcn_s_setprio(0); } while (0)
#define PG8_WAIT_V(n) asm volatile("s_waitcnt vmcnt(" #n ")" ::: "memory")
#define PG8_WAIT_L(n) asm volatile("s_waitcnt lgkmcnt(" #n ")" ::: "memory")
#define PG8_BAR __builtin_amdgcn_s_barrier()
#define PG8_SCHED __builtin_amdgcn_sched_barrier(0)
    Unit cur, nxt; int ui = 0;
    if (!S.next(0, cur)) return;
    f32x4 acc[2][2][4][2];
#pragma unroll
    for (int a = 0; a < 2; ++a)
#pragma unroll
        for (int b = 0; b < 2; ++b)
#pragma unroll
            for (int m = 0; m < 4; ++m)
#pragma unroll
                for (int n = 0; n < 2; ++n) acc[a][b][m][n] = (f32x4){0.f, 0.f, 0.f, 0.f};
    bf16x8 At[4][2], B0[2][2], B1[2][2];
    const char* cA = (const char*)g.A + (size_t)cur.pm * tstep; const char* cB = (const char*)g.Bt + (size_t)cur.pn * tstep + ((HALFN && cur.hf > 0) ? hstep : 0);
    S.a_ready(cur);
    if constexpr (SP2) {
        PG8_STAGE(PG8_SB(0, 0), cB, voffB); PG8_STAGE(PG8_SB(0, 1), cB + hstepB, voffB); PG8_STAGE(PG8_SA(0, 0), cA, voffA); PG8_STAGE(PG8_SA(0, 1), cA + hstep, voffA);
        if (wr == 1) PG8_BAR;
        PG8_WAIT_V(2); PG8_BAR;
        PG8_STAGE(PG8_SB(1, 0), cB + kstep, voffB); PG8_STAGE(PG8_SA(1, 0), cA + kstep, voffA); PG8_STAGE(PG8_SB(1, 1), cB + hstepB + kstep, voffB);
        PG8_WAIT_V(6); PG8_BAR;
    } else {
        PG8_STAGE(PG8_SB(0, 0), cB, voffB); PG8_STAGE(PG8_SA(0, 0), cA, voffA); PG8_STAGE(PG8_SB(0, 1), cB + hstepB, voffB); PG8_STAGE(PG8_SA(0, 1), cA + hstep, voffA);
        if (wr == 1) PG8_BAR;
        PG8_WAIT_V(4); PG8_BAR;
        PG8_STAGE(PG8_SB(1, 0), cB + kstep, voffB); PG8_STAGE(PG8_SA(1, 0), cA + kstep, voffA); PG8_STAGE(PG8_SB(1, 1), cB + hstepB + kstep, voffB);
        PG8_WAIT_V(6); PG8_BAR;
    }
    for (;;) {
        const bool has_next = S.next(ui + 1, nxt);
        const char* nA = has_next ? (const char*)g.A + (size_t)nxt.pm * tstep : cA; const char* nB = has_next ? (const char*)g.Bt + (size_t)nxt.pn * tstep + ((HALFN && nxt.hf > 0) ? hstep : 0) : cB;
        for (int t = 0; t < nt; t += 2) {
            const bool last = (t == nt - 2);
            const char* a1 = cA + (size_t)(t + 1) * kstep;
            const char* a2 = last ? nA : cA + (size_t)(t + 2) * kstep; const char* b2 = last ? nB : cB + (size_t)(t + 2) * kstep;
            const char* a3 = a2 + kstep; const char* b3 = b2 + kstep;
            if (last && has_next) S.a_ready(nxt);
            if constexpr (SP2) {
            PG8_LDB(B0, 0, 0); if constexpr (!HALFN) PG8_LDB(B1, 0, 1); PG8_SCHED; PG8_LDA(At, 0, 0); PG8_STAGE(PG8_SA(1, 1), a1 + hstep, voffA);
            PG8_WAIT_V(8); PG8_WAIT_L(0); PG8_BAR; PG8_MMA(0, 0, At, B0); if constexpr (!HALFN) PG8_MMA(0, 1, At, B1); PG8_BAR; PG8_SCHED;
            PG8_LDA(At, 0, 1); PG8_STAGE(PG8_SB(0, 0), b2, voffB); PG8_STAGE(PG8_SB(0, 1), b2 + hstepB, voffB); PG8_STAGE(PG8_SA(0, 0), a2, voffA);
            PG8_WAIT_V(8); PG8_WAIT_L(0); PG8_BAR; PG8_MMA(1, 0, At, B0); if constexpr (!HALFN) PG8_MMA(1, 1, At, B1); PG8_BAR; PG8_SCHED;
            PG8_LDB(B0, 1, 0); if constexpr (!HALFN) PG8_LDB(B1, 1, 1); PG8_SCHED; PG8_LDA(At, 1, 0); PG8_STAGE(PG8_SA(0, 1), a2 + hstep, voffA);
            PG8_WAIT_V(8); PG8_WAIT_L(0); PG8_BAR; PG8_MMA(0, 0, At, B0); if constexpr (!HALFN) PG8_MMA(0, 1, At, B1); PG8_BAR; PG8_SCHED;
            PG8_LDA(At, 1, 1); PG8_STAGE(PG8_SB(1, 0), b3, voffB); PG8_STAGE(PG8_SB(1, 1), b3 + hstepB, voffB); PG8_STAGE(PG8_SA(1, 0), a3, voffA);
            PG8_WAIT_V(8); PG8_WAIT_L(0); PG8_BAR; PG8_MMA(1, 0, At, B0); if constexpr (!HALFN) PG8_MMA(1, 1, At, B1); PG8_BAR; PG8_SCHED;
            } else {
            PG8_LDB(B0, 0, 0); PG8_SCHED; PG8_LDA(At, 0, 0); PG8_STAGE(PG8_SA(1, 1), a1 + hstep, voffA);
            PG8_WAIT_L(8); PG8_BAR; PG8_WAIT_L(0); PG8_MMA(0, 0, At, B0); PG8_BAR; PG8_SCHED;
            if constexpr (!HALFN) PG8_LDB(B1, 0, 1); PG8_STAGE(PG8_SB(0, 0), b2, voffB);
            PG8_BAR; PG8_WAIT_L(0); if constexpr (!HALFN) PG8_MMA(0, 1, At, B1); PG8_BAR;
            PG8_LDA(At, 0, 1); PG8_STAGE(PG8_SA(0, 0), a2, voffA);
            PG8_BAR; PG8_WAIT_L(0); PG8_MMA(1, 0, At, B0); PG8_BAR; PG8_SCHED;
            PG8_STAGE(PG8_SB(0, 1), b2 + hstepB, voffB);
            PG8_WAIT_V(6); PG8_BAR; if constexpr (!HALFN) PG8_MMA(1, 1, At, B1); PG8_BAR;
            PG8_LDB(B0, 1, 0); PG8_SCHED; PG8_LDA(At, 1, 0); PG8_STAGE(PG8_SA(0, 1), a2 + hstep, voffA);
            PG8_WAIT_L(8); PG8_BAR; PG8_WAIT_L(0); PG8_MMA(0, 0, At, B0); PG8_BAR; PG8_SCHED;
            if constexpr (!HALFN) PG8_LDB(B1, 1, 1); PG8_STAGE(PG8_SB(1, 0), b3, voffB);
            PG8_BAR; PG8_WAIT_L(0); if constexpr (!HALFN) PG8_MMA(0, 1, At, B1); PG8_BAR;
            PG8_LDA(At, 1, 1); PG8_STAGE(PG8_SA(1, 0), a3, voffA);
            PG8_BAR; PG8_WAIT_L(0); PG8_MMA(1, 0, At, B0); PG8_BAR; PG8_SCHED;
            PG8_STAGE(PG8_SB(1, 1), b3 + hstepB, voffB);
            PG8_WAIT_V(6); PG8_BAR; if constexpr (!HALFN) PG8_MMA(1, 1, At, B1); PG8_BAR;
            }
        }
        if constexpr (ALIGN_EPI) { if (wr == 0) PG8_BAR; }
        if constexpr (!Epi::AFTER_DRAIN) { E(acc, cur, wr, wc, fr, fq); S.done(cur); }
        if (!has_next) break;
#pragma unroll
        for (int a = 0; a < 2; ++a)
#pragma unroll
            for (int b = 0; b < 2; ++b)
#pragma unroll
                for (int m = 0; m < 4; ++m)
#pragma unroll
                    for (int n = 0; n < 2; ++n) acc[a][b][m][n] = (f32x4){0.f, 0.f, 0.f, 0.f};
        cur = nxt; cA = nA; cB = nB; ++ui;
        if constexpr (ALIGN_EPI) { if (wr == 1) PG8_BAR; }
    }
    PG8_WAIT_V(0);
    if constexpr (!ALIGN_EPI) { if (wr == 0) PG8_BAR; }
    PG8_BAR;
    if constexpr (Epi::AFTER_DRAIN) { E.fused(acc, cur, wr, wc, fr, fq, lds, wid, lane); S.done(cur); }
#undef PG8_SA
#undef PG8_SB
#undef PG8_STAGE
#undef PG8_LDA
#undef PG8_LDB
#undef PG8_MMA
#undef PG8_WAIT_V
#undef PG8_WAIT_L
#undef PG8_BAR
#undef PG8_SCHED
}
}

constexpr int DM = 4096, TP = 8192, NSB = 16, TSQ = 16, PAST = 1024;
constexpr int MROWS = TP + NSB * TSQ;
constexpr int N1 = 16384, N3R = 16416, N3 = 16640;
constexpr int HW = 2048;
constexpr int NH_A = 16, NH_B = 16, NH_C = 32, HD = 128;
constexpr int FCS_LD = 1056;
constexpr float EPS = 1e-6f;
constexpr float LOG2E = 1.4426950408889634f;
constexpr float QK2 = 0.08838834764831845f * 1.4426950408889634f;
constexpr float NFRS = 11.313708498984761f;
constexpr float FIX = 16777216.f;

constexpr size_t O_YP = 0, O_YS = O_YP + (size_t)TP * DM, O_SAP = O_YS + (size_t)256 * DM, O_SAS = O_SAP + (size_t)16 * 128 * 128,
    O_BKP = O_SAS + (size_t)16 * 16 * 128 * 128, O_BVP = O_BKP + (size_t)TP * HW, O_BKS = O_BVP + (size_t)TP * HW, O_BVS = O_BKS + (size_t)256 * HW,
    O_CKP = O_BVS + (size_t)256 * HW, O_CVP = O_CKP + (size_t)TP * DM, O_CFP = O_CVP + (size_t)TP * DM, O_CKS = O_CFP + (size_t)TP * 32,
    O_CVS = O_CKS + (size_t)256 * DM, O_CFS = O_CVS + (size_t)256 * DM, O_END = O_CFS + (size_t)256 * 32;
static_assert(O_END == 143138816, "output size");

constexpr size_t MiB = 1u << 20;
constexpr size_t WS_CTL = 0, CTL_ZERO_BYTES = 1 * MiB;
constexpr size_t WS_LB = 1 * MiB;
constexpr size_t WS_W1T = 2 * MiB;
constexpr size_t WS_W2T = WS_W1T + 128 * MiB;
constexpr size_t WS_W3T = WS_W2T + 32 * MiB;
constexpr size_t WS_W4T = WS_W3T + 130 * MiB;
constexpr size_t WS_XN = WS_W4T + 32 * MiB;
constexpr size_t WS_P = WS_XN + 66 * MiB;
constexpr size_t PSTR1 = (size_t)MROWS * HW;
constexpr size_t PSTR3 = (size_t)MROWS * DM;
constexpr size_t WS_G = WS_P + 8 * 33 * MiB;
constexpr size_t WS_A = WS_G + 66 * MiB;
constexpr size_t WS_H1 = WS_A + 66 * MiB;
constexpr size_t WS_SLOC = WS_H1 + 132 * MiB;
constexpr size_t WS_SST = WS_SLOC + 128 * MiB;
constexpr size_t WS_DEC = WS_SST + 64 * MiB;
constexpr size_t WS_FL = WS_DEC + 1 * MiB;
constexpr size_t WS_FCP = WS_FL + 2 * MiB;
constexpr size_t WS_FCS = WS_FCP + 1 * MiB;
constexpr size_t WS_P3 = WS_FCS + 3 * MiB;
constexpr size_t WS_END = WS_P3 + 4 * 66 * MiB;
static_assert(WS_P + 4 * 66 * MiB <= WS_A, "layer-1 overlay fits");
constexpr int CW_BAR = 4096;
constexpr int CW_RS1 = 16384;
constexpr int CW_RS2 = CW_RS1 + 2 * 8448 + 128;
constexpr int CW_STAT = CW_RS2 + 2 * 8448 + 128;
constexpr int CW_KN2 = 8192;
constexpr int CW_WQ = CW_KN2 + 64;
constexpr int CW_WQ3 = CW_WQ + 32;
constexpr int CW_WQ4 = CW_WQ + 64, CW_FQ = CW_WQ4 + 64;
constexpr int CW_HSTAT = CW_STAT + 256;
static_assert(CW_BAR + 3456 <= CW_KN2 && CW_FQ + 128 <= CW_RS1 && (CW_HSTAT + 128) * 4 <= (int)CTL_ZERO_BYTES, "ctl region");

constexpr int RING_BYTES = 131072;
constexpr int MISC_OFF = RING_BYTES + 320;
constexpr int LDS_BYTES = 147456;
constexpr int NWAVES = 8;

#define LAS __attribute__((address_space(3)))
typedef unsigned short bf16_t;
typedef unsigned v4u __attribute__((ext_vector_type(4)));
typedef unsigned v2u __attribute__((ext_vector_type(2)));
typedef float f32x4 __attribute__((ext_vector_type(4)));
typedef float f32x2 __attribute__((ext_vector_type(2)));
typedef float f32x16 __attribute__((ext_vector_type(16)));
typedef short bf16x8 __attribute__((ext_vector_type(8)));
typedef short s16x4 __attribute__((ext_vector_type(4)));
#define LDS_WAIT() asm volatile("s_waitcnt lgkmcnt(0)" ::: "memory")
#define VM_WAIT() asm volatile("s_waitcnt vmcnt(0)" ::: "memory")

typedef __bf16 bf16x2_n __attribute__((ext_vector_type(2)));
__device__ __forceinline__ unsigned cvtpk(float lo, float hi) { const f32x2 f = {lo, hi}; const bf16x2_n r = __builtin_convertvector(f, bf16x2_n); return __builtin_bit_cast(unsigned, r); }
__device__ __forceinline__ float bf2f(unsigned short b) { return __uint_as_float(((unsigned)b) << 16); }
__device__ __forceinline__ float bflo(unsigned w) { return __uint_as_float(w << 16); }
__device__ __forceinline__ float bfhi(unsigned w) { return __uint_as_float(w & 0xffff0000u); }
__device__ __forceinline__ float ex2(float x) { return __builtin_amdgcn_exp2f(x); }
__device__ __forceinline__ float lg2(float x) { return __builtin_amdgcn_logf(x); }
__device__ __forceinline__ float rcpf_(float x) { return __builtin_amdgcn_rcpf(x); }
__device__ __forceinline__ float silu_f(float x) { return x * rcpf_(1.f + ex2(-x * LOG2E)); }
__device__ __forceinline__ float wave_sum(float v) {
#pragma unroll
    for (int o = 1; o < 64; o <<= 1) v += __shfl_xor(v, o);
    return v;
}
__device__ __forceinline__ unsigned off_b(unsigned row, unsigned ch) { return 256u * row + 16u * (ch ^ (((row & 3u) << 2) | ((row >> 2) & 3u))); }

#define XB_TMO      128
#define XB_XCNT(j)  (256  + 64 * (j))
#define XB_XSUB(j)  (1280 + 64 * (j))
#define XB_XGEN(j)  (2304 + 64 * (j))
#define XB_TOP      3328
#define XB_TOPGEN   3392
#define XCD_BAR_WORDS 3456
#define XB_SPIN_CAP (1u << 18)
__device__ __forceinline__ unsigned xb_ld(unsigned* p)              { return __hip_atomic_load(p, __ATOMIC_RELAXED, __HIP_MEMORY_SCOPE_AGENT); }
__device__ __forceinline__ unsigned xb_add(unsigned* p, unsigned v) { return __hip_atomic_fetch_add(p, v, __ATOMIC_RELAXED, __HIP_MEMORY_SCOPE_AGENT); }
__device__ __forceinline__ unsigned xb_xcc_id() { return (unsigned)__builtin_amdgcn_s_getreg((3 << 11) | 20) & 0xFu; }
#define XB_SPIN(cond, bar) do { unsigned _sp = 0; while (cond) { __builtin_amdgcn_s_sleep(1); \
    if ((++_sp & 255u) == 0u) { if (xb_ld(&(bar)[XB_TMO])) break; if (_sp > XB_SPIN_CAP) { atomicAdd(&(bar)[XB_TMO], 1u); break; } } } } while (0)
struct XcdBarrier { unsigned* bar; unsigned x; volatile LAS unsigned* st; };
__device__ __forceinline__ XcdBarrier xcd_barrier_post(unsigned* bar, volatile LAS unsigned* st) {
    XcdBarrier b; b.bar = bar; b.x = xb_xcc_id(); b.st = st;
    if (threadIdx.x == 0) (void)xb_add(&bar[XB_XCNT(b.x)], 1u);
    return b;
}
__device__ __forceinline__ void xcd_barrier_complete(unsigned* bar, unsigned x, unsigned& nloc, unsigned& nx) {
    const unsigned G = gridDim.x * gridDim.y * gridDim.z;
    unsigned sum, cnt, mine, sp = 0u;
    for (;;) {
        sum = 0u; cnt = 0u; mine = 0u;
#pragma unroll
        for (unsigned j = 0; j < 16; ++j) { const unsigned c = xb_ld(&bar[XB_XCNT(j)]); sum += c; cnt += (c > 0u) ? 1u : 0u; mine = (j == x) ? c : mine; }
        if (sum == G) break;
        __builtin_amdgcn_s_sleep(1);
        if ((++sp & 255u) == 0u) { if (xb_ld(&bar[XB_TMO])) break; if (sp > XB_SPIN_CAP) { atomicAdd(&bar[XB_TMO], 1u); break; } }
    }
    nloc = mine > 0u ? mine : 1u; nx = cnt > 0u ? cnt : 1u;
}
__device__ __forceinline__ void xcd_barrier(const XcdBarrier& b, const int wid0  ) {
    asm volatile("s_waitcnt vmcnt(0)" ::: "memory");
    __syncthreads();
    if (wid0 == 0 && __builtin_amdgcn_mbcnt_hi(~0u, __builtin_amdgcn_mbcnt_lo(~0u, 0u)) == 0u) {
        unsigned* bar = b.bar;
        __builtin_amdgcn_s_waitcnt(0);
        unsigned nloc = b.st[0], nx = b.st[1];
        if (nloc == 0u) { xcd_barrier_complete(bar, b.x, nloc, nx); b.st[0] = nloc; b.st[1] = nx; }
        const unsigned old = xb_add(&bar[XB_XSUB(b.x)], 1u);
        const unsigned gen = old / nloc;
        if (old + 1u == (gen + 1u) * nloc) {
            __builtin_amdgcn_fence(__ATOMIC_RELEASE, "agent");
            asm volatile("s_waitcnt vmcnt(0)" ::: "memory");
            const unsigned og = xb_add(&bar[XB_TOP], 1u);
            const unsigned tg = og / nx;
            if (og + 1u == (tg + 1u) * nx) xb_add(&bar[XB_TOPGEN], 1u);
            else XB_SPIN(xb_ld(&bar[XB_TOPGEN]) == tg, bar);
            __builtin_amdgcn_fence(__ATOMIC_ACQUIRE, "agent");
            xb_add(&bar[XB_XGEN(b.x)], 1u);
            asm volatile("s_waitcnt vmcnt(0)" ::: "memory");
        } else {
            XB_SPIN(xb_ld(&bar[XB_XGEN(b.x)]) == gen, bar);
            __builtin_amdgcn_fence(__ATOMIC_ACQUIRE, "agent");
            asm volatile("s_waitcnt vmcnt(0)" ::: "memory");
        }
    }
    __syncthreads();
}

using pg8::Unit;
struct Epi1 {
    static constexpr bool PERM = true, AFTER_DRAIN = false;
    bf16_t* P; float* G; const float* LB; float* out;
    __device__ __forceinline__ void operator()(const f32x4 (&acc)[2][2][4][2], const Unit& u, int wr, int wc, int fr, int fq) const {
        const int t = u.pn >> 3;
        const int row0 = u.pm * 256 + wr * 64 + fr, col0 = (u.pn & 7) * 256 + wc * 32 + 8 * fq + (u.hf > 0 ? 128 : 0);
        const int nbj = (u.hf >= 0) ? 1 : 2;
        bf16_t* dst = P + (size_t)t * PSTR1;
        float* fo = nullptr;
        if (t == 5 || t == 6) { const bool smp = u.pm >= 32; fo = out + (t == 5 ? (smp ? O_BKS : O_BKP) : (smp ? O_BVS : O_BVP)) - (smp ? (size_t)TP * HW : (size_t)0); }
        f32x4 lbv[2][2];
#pragma unroll
        for (int bj = 0; bj < 2; ++bj)
#pragma unroll
            for (int n = 0; n < 2; ++n) lbv[bj][n] = (t == 1 && bj < nbj) ? *(const f32x4*)(LB + col0 + bj * 128 + 4 * n) : (f32x4){0.f, 0.f, 0.f, 0.f};
        const bool act = (t == 0 || t == 3 || t == 7);
#pragma unroll
        for (int ai = 0; ai < 2; ++ai)
#pragma unroll
            for (int m = 0; m < 4; ++m) {
                const size_t ro = (size_t)(row0 + ai * 128 + m * 16) * HW + col0;
#pragma unroll
                for (int bj = 0; bj < 2; ++bj) { if (bj >= nbj) continue;
                    f32x4 v[2] = {acc[ai][bj][m][0], acc[ai][bj][m][1]};
                    if (act) {
#pragma unroll
                        for (int n = 0; n < 2; ++n)
#pragma unroll
                            for (int j = 0; j < 4; ++j) v[n][j] = silu_f(v[n][j]);
                    } else if (t == 1) {
#pragma unroll
                        for (int n = 0; n < 2; ++n) {
                            f32x4 gg;
#pragma unroll
                            for (int j = 0; j < 4; ++j) { const float z = fmaxf(v[n][j], -80.f), lb = lbv[bj][n][j]; const float e = ex2(-z * LOG2E), s = rcpf_(1.f + e);
                                const float f = lb + (1.f - lb) * s; gg[j] = lg2(f) * 0.6931471805599453f; v[n][j] = (1.f - lb) * (e * s); }
                            *(f32x4*)(G + ro + bj * 128 + 4 * n) = gg;
                        }
                    }
                    if (fo) { *(f32x4*)(fo + ro + bj * 128) = v[0]; *(f32x4*)(fo + ro + bj * 128 + 4) = v[1]; }
                    v4u w; w.x = cvtpk(v[0][0], v[0][1]); w.y = cvtpk(v[0][2], v[0][3]); w.z = cvtpk(v[1][0], v[1][1]); w.w = cvtpk(v[1][2], v[1][3]);
                    *(v4u*)(dst + ro + bj * 128) = w;
                }
            }
    }
};
struct Epi3 {
    static constexpr bool PERM = true, AFTER_DRAIN = false;
    bf16_t* P; const unsigned long long* RS; float* FL; const float* bfg; float* out;
    __device__ __forceinline__ void operator()(const f32x4 (&acc)[2][2][4][2], const Unit& u, int wr, int wc, int fr, int fq) const {
        const int t = u.pn >> 4;
        const int row0 = u.pm * 256 + wr * 64 + fr, col0 = (u.pn & 15) * 256 + wc * 32 + 8 * fq + (u.hf > 0 ? 128 : 0);
        const int nbj = (u.hf >= 0) ? 1 : 2;
        const bool smp = u.pm >= 32;
        if (t == 4) {
            if (wc != 0) return;
            float* fo = out + (smp ? O_CFS : O_CFP) - (smp ? (size_t)TP * 32 : (size_t)0);
            const f32x4 b0 = *(const f32x4*)(bfg + 8 * fq), b1 = *(const f32x4*)(bfg + 8 * fq + 4);
#pragma unroll
            for (int ai = 0; ai < 2; ++ai)
#pragma unroll
                for (int m = 0; m < 4; ++m) {
                    const int row = row0 + ai * 128 + m * 16;
                    const float r = rsqrtf((float)RS[row] * (1.f / (FIX * 4096.f)) + EPS);
                    f32x4 v[2] = {acc[ai][0][m][0] * r + b0, acc[ai][0][m][1] * r + b1};
#pragma unroll
                    for (int n = 0; n < 2; ++n)
#pragma unroll
                        for (int j = 0; j < 4; ++j) { const float x = v[n][j]; v[n][j] = fminf(x, 0.f) - log1pf(__expf(-fabsf(x))); }
                    *(f32x4*)(FL + (size_t)row * 32 + 8 * fq) = v[0]; *(f32x4*)(FL + (size_t)row * 32 + 8 * fq + 4) = v[1];
                    *(f32x4*)(fo + (size_t)row * 32 + 8 * fq) = v[0]; *(f32x4*)(fo + (size_t)row * 32 + 8 * fq + 4) = v[1];
                }
            return;
        }
        bf16_t* dst = P + (size_t)t * PSTR3;
        float* fo = nullptr;
        if (t == 1 || t == 2) fo = out + (t == 1 ? (smp ? O_CKS : O_CKP) : (smp ? O_CVS : O_CVP)) - (smp ? (size_t)TP * DM : (size_t)0);
#pragma unroll
        for (int ai = 0; ai < 2; ++ai)
#pragma unroll
            for (int m = 0; m < 4; ++m) {
                const int row = row0 + ai * 128 + m * 16;
                const float r = rsqrtf((float)RS[row] * (1.f / (FIX * 4096.f)) + EPS);
                const size_t ro = (size_t)row * DM + col0;
#pragma unroll
                for (int bj = 0; bj < 2; ++bj) { if (bj >= nbj) continue;
                    f32x4 v[2] = {acc[ai][bj][m][0] * r, acc[ai][bj][m][1] * r};
                    if (t == 3) {
#pragma unroll
                        for (int n = 0; n < 2; ++n)
#pragma unroll
                            for (int j = 0; j < 4; ++j) v[n][j] = silu_f(v[n][j]);
                    }
                    if (fo) { *(f32x4*)(fo + ro + bj * 128) = v[0]; *(f32x4*)(fo + ro + bj * 128 + 4) = v[1]; }
                    v4u w; w.x = cvtpk(v[0][0], v[0][1]); w.y = cvtpk(v[0][2], v[0][3]); w.z = cvtpk(v[1][0], v[1][1]); w.w = cvtpk(v[1][2], v[1][3]);
                    *(v4u*)(dst + ro + bj * 128) = w;
                }
            }
    }
};
template <bool XN_> struct EpiRes {
    static constexpr bool PERM = true, AFTER_DRAIN = false;
    const float* resP; const float* resS;
    float* H; bf16_t* XN; const float* nw; unsigned long long* RS;
    __device__ __forceinline__ void operator()(const f32x4 (&acc)[2][2][4][2], const Unit& u, int wr, int wc, int fr, int fq) const {
        const int row0 = u.pm * 256 + wr * 64 + fr, col0 = u.pn * 256 + wc * 32 + 8 * fq + (u.hf > 0 ? 128 : 0);
        const int nbj = (u.hf >= 0) ? 1 : 2;
        const float* res = (u.pm >= 32) ? resS - (size_t)TP * DM : resP;
        f32x4 wv[2][2];
#pragma unroll
        for (int bj = 0; bj < 2; ++bj)
#pragma unroll
            for (int n = 0; n < 2; ++n) wv[bj][n] = (XN_ && bj < nbj) ? *(const f32x4*)(nw + col0 + bj * 128 + 4 * n) : (f32x4){0.f, 0.f, 0.f, 0.f};
#pragma unroll
        for (int ai = 0; ai < 2; ++ai)
#pragma unroll
            for (int m = 0; m < 4; ++m) {
                const int row = row0 + ai * 128 + m * 16;
                const size_t ro = (size_t)row * DM + col0;
                float ss = 0.f;
#pragma unroll
                for (int bj = 0; bj < 2; ++bj) { if (bj >= nbj) continue;
                    f32x4 v[2];
#pragma unroll
                    for (int n = 0; n < 2; ++n) { v[n] = acc[ai][bj][m][n] + *(const f32x4*)(res + ro + bj * 128 + 4 * n); ss += (v[n][0] * v[n][0] + v[n][1] * v[n][1]) + (v[n][2] * v[n][2] + v[n][3] * v[n][3]); }
                    *(f32x4*)(H + ro + bj * 128) = v[0]; *(f32x4*)(H + ro + bj * 128 + 4) = v[1];
                    if (XN_) { v[0] = v[0] * wv[bj][0]; v[1] = v[1] * wv[bj][1];
                        v4u w; w.x = cvtpk(v[0][0], v[0][1]); w.y = cvtpk(v[0][2], v[0][3]); w.z = cvtpk(v[1][0], v[1][1]); w.w = cvtpk(v[1][2], v[1][3]);
                        *(v4u*)(XN + ro + bj * 128) = w; }
                }
                ss += __shfl_xor(ss, 16); ss += __shfl_xor(ss, 32);
                if (fq == 0) atomicAdd(RS + row, (unsigned long long)__float2ull_rn(ss * FIX));
            }
    }
};

template <int E>
__device__ __forceinline__ void wg_scan(float (&vals)[E], LAS float* scr, int tid, int wid, int lane) {
    float run = 0.f;
#pragma unroll
    for (int j = 0; j < E; ++j) { run += vals[j]; vals[j] = run; }
    float inc = run;
#pragma unroll
    for (int o = 1; o < 64; o <<= 1) { const float t = __shfl_up(inc, o); if (lane >= o) inc += t; }
    if (lane == 63) scr[wid] = inc;
    __syncthreads();
    float woff = 0.f;
#pragma unroll
    for (int w = 0; w < 8; ++w) woff += (w < wid) ? scr[w] : 0.f;
    const float offs = woff + (inc - run);
#pragma unroll
    for (int j = 0; j < E; ++j) vals[j] += offs;
    __syncthreads();
}


__device__ __forceinline__ unsigned f2bf(float f) { unsigned u = __builtin_bit_cast(unsigned, f); return (u + 0x7fffu + ((u >> 16) & 1u)) >> 16; }
__device__ __forceinline__ unsigned pk2(float lo, float hi) { return f2bf(lo) | (f2bf(hi) << 16); }
__device__ __forceinline__ void p0_transpose_item(const float* W, int K, int N, bf16_t* WT, LAS float* scr, int item, int lane) {
    const int nblk = N / 32, kb = item / nblk, nb = item % nblk, k0 = 64 * kb, n0 = 32 * nb;
#pragma unroll 8
    for (int i = 0; i < 32; ++i) { const int kk = 2 * i + (lane >> 5); scr[kk * 33 + (lane & 31)] = W[(size_t)(k0 + kk) * N + n0 + (lane & 31)]; }
    LDS_WAIT(); asm volatile("" ::: "memory");
    const int c = lane & 7;
#pragma unroll
    for (int j = 0; j < 4; ++j) { const int n = (lane >> 3) + 8 * j; const LAS float* s = scr + (8 * c) * 33 + n;
        v4u o; o.x = pk2(s[0 * 33], s[1 * 33]); o.y = pk2(s[2 * 33], s[3 * 33]); o.z = pk2(s[4 * 33], s[5 * 33]); o.w = pk2(s[6 * 33], s[7 * 33]);
        *(v4u*)(WT + (size_t)(n0 + n) * K + k0 + 8 * c) = o; }
    LDS_WAIT(); asm volatile("" ::: "memory");
}
__device__ __forceinline__ void p0_transpose_item64(const float* W, int K, int N, bf16_t* WT, LAS float* scr, int item, int lane) {
    const int nblk = N / 64, kb = item / nblk, nb = item % nblk, k0 = 64 * kb, n0 = 64 * nb;
    const int r4 = lane >> 4, g4 = lane & 15;
    f32x4 v[16];
#pragma unroll
    for (int i = 0; i < 16; ++i) v[i] = *(const f32x4*)(W + (size_t)(k0 + 4 * i + r4) * N + n0 + 4 * g4);
#pragma unroll
    for (int i = 0; i < 16; ++i) { const int kk = 4 * i + r4; *(LAS f32x4*)(scr + kk * 64 + ((g4 ^ (kk >> 3)) << 2)) = v[i]; }
    LDS_WAIT(); asm volatile("" ::: "memory");
    const int c = lane & 7;
#pragma unroll
    for (int j = 0; j < 8; ++j) { const int n = (lane >> 3) + 8 * j; const LAS float* s = scr + (8 * c) * 64 + ((((n >> 2) ^ c)) << 2) + (n & 3);
        v4u o; o.x = cvtpk(s[0 * 64], s[1 * 64]); o.y = cvtpk(s[2 * 64], s[3 * 64]); o.z = cvtpk(s[4 * 64], s[5 * 64]); o.w = cvtpk(s[6 * 64], s[7 * 64]);
        *(v4u*)(WT + (size_t)(n0 + n) * K + k0 + 8 * c) = o; }
    LDS_WAIT(); asm volatile("" ::: "memory");
}
__device__ __forceinline__ void norm_row_to_bf16(const float* xrow, const float* w, bf16_t* orow, int lane) {
    const f32x4* xr = (const f32x4*)xrow + lane;
    f32x4 v[16]; float s = 0.f;
#pragma unroll
    for (int j = 0; j < 16; ++j) { v[j] = xr[64 * j]; s += (v[j].x * v[j].x + v[j].y * v[j].y) + (v[j].z * v[j].z + v[j].w * v[j].w); }
    const float r = rsqrtf(wave_sum(s) * (1.f / DM) + EPS);
    const f32x4* wr_ = (const f32x4*)w + lane;
    v2u* o8 = (v2u*)orow + lane;
#pragma unroll
    for (int j = 0; j < 16; ++j) { const f32x4 ww = wr_[64 * j]; v2u o; o.x = cvtpk(v[j].x * r * ww.x, v[j].y * r * ww.y); o.y = cvtpk(v[j].z * r * ww.z, v[j].w * r * ww.w); o8[64 * j] = o; }
}

#define DBG_FLAG(cond, bit) do { if (dbg && __any(cond)) { if ((threadIdx.x & 63) == 0) atomicOr(dbg, 1u << (bit)); } } while (0)
__device__ __forceinline__ bool nonfin(float v) { return (__float_as_uint(v) & 0x7f800000u) == 0x7f800000u; }
__device__ __forceinline__ void attn_pv(const LAS unsigned char* Vt, int blk, const bf16x8 (&pk)[2], f32x16 (&o)[4], int lane) {
    const unsigned h = (unsigned)lane >> 5, q4 = (lane & 15) >> 2, pp = lane & 3, bc = (lane >> 4) & 1;
#pragma unroll
    for (int ks = 0; ks < 2; ++ks) {
        const unsigned row0 = 32u * blk + 16u * ks + 4u * h + q4, row1 = row0 + 8u;
        const unsigned x0 = (q4 << 2) | (h & 3u), x1 = (q4 << 2) | ((h + 2u) & 3u);
#pragma unroll
        for (int c = 0; c < 4; ++c) {
            const unsigned chn = 4u * c + 2u * bc + (pp >> 1);
            const s16x4 lo = __builtin_amdgcn_ds_read_tr16_b64_v4i16((LAS s16x4*)(Vt + 256u * row0 + 16u * (chn ^ x0) + 8u * (pp & 1)));
            const s16x4 hi = __builtin_amdgcn_ds_read_tr16_b64_v4i16((LAS s16x4*)(Vt + 256u * row1 + 16u * (chn ^ x1) + 8u * (pp & 1)));
            const bf16x8 a = {lo[0], lo[1], lo[2], lo[3], hi[0], hi[1], hi[2], hi[3]};
            o[c] = __builtin_amdgcn_mfma_f32_32x32x16_bf16(a, pk[ks], o[c], 0, 0, 0);
        }
    }
}
__device__ __forceinline__ void attn_v_load(const LAS unsigned char* Vt, int blk, s16x4 (&vl)[8], s16x4 (&vh)[8], int lane) {
    const unsigned h = (unsigned)lane >> 5, q4 = (lane & 15) >> 2, pp = lane & 3, bc = (lane >> 4) & 1;
#pragma unroll
    for (int ks = 0; ks < 2; ++ks) {
        const unsigned row0 = 32u * blk + 16u * ks + 4u * h + q4, row1 = row0 + 8u;
        const unsigned x0 = (q4 << 2) | (h & 3u), x1 = (q4 << 2) | ((h + 2u) & 3u);
#pragma unroll
        for (int c = 0; c < 4; ++c) {
            const unsigned chn = 4u * c + 2u * bc + (pp >> 1);
            vl[4 * ks + c] = __builtin_amdgcn_ds_read_tr16_b64_v4i16((LAS s16x4*)(Vt + 256u * row0 + 16u * (chn ^ x0) + 8u * (pp & 1)));
            vh[4 * ks + c] = __builtin_amdgcn_ds_read_tr16_b64_v4i16((LAS s16x4*)(Vt + 256u * row1 + 16u * (chn ^ x1) + 8u * (pp & 1)));
        }
    }
}
__device__ __forceinline__ void attn_v_mma(const s16x4 (&vl)[8], const s16x4 (&vh)[8], const bf16x8 (&pk)[2], f32x16 (&o)[4]) {
#pragma unroll
    for (int ks = 0; ks < 2; ++ks)
#pragma unroll
        for (int c = 0; c < 4; ++c) { const s16x4 lo = vl[4 * ks + c], hi = vh[4 * ks + c];
            const bf16x8 a = {lo[0], lo[1], lo[2], lo[3], hi[0], hi[1], hi[2], hi[3]};
            o[c] = __builtin_amdgcn_mfma_f32_32x32x16_bf16(a, pk[ks], o[c], 0, 0, 0); }
}
template <int MODE, bool FK_LDS = false>
__device__ __forceinline__ void attn_block(const LAS unsigned char* Kt, const LAS unsigned char* Vt, int blk, const bf16x8 (&qf)[8], f32x16 (&o)[4],
                                           float& m, float& l, float& carry, int key0, int qpos, float fq2, const float* fk, int lane, unsigned* dbg = nullptr, const LAS float* fkl = nullptr, bool need_mask = true) {
    const int r32 = lane & 31, h = lane >> 5;
    f32x16 p = {};
    {
        const unsigned krow = 32u * blk + r32, kx = ((krow & 3u) << 2) | ((krow >> 2) & 3u);
        const LAS unsigned char* kb = Kt + 256u * krow;
        __builtin_amdgcn_s_setprio(1);
#pragma unroll
        for (int s = 0; s < 8; ++s) { const bf16x8 a = *(const LAS bf16x8*)(kb + 16u * ((unsigned)(2 * s + h) ^ kx)); p = __builtin_amdgcn_mfma_f32_32x32x16_bf16(a, qf[s], p, 0, 0, 0); }
        __builtin_amdgcn_s_setprio(0);
    }
    { bool bad = false;
#pragma unroll
      for (int r = 0; r < 16; ++r) bad |= nonfin(p[r]);
      DBG_FLAG(bad, 1); }
    float x[16];
    if (MODE == 1) {
        f32x4 nf[4];
#pragma unroll
        for (int g = 0; g < 4; ++g) nf[g] = FK_LDS ? *(const LAS f32x4*)(fkl + 8 * g + 4 * h) : *(const f32x4*)(fk + 8 * g + 4 * h);
        f32x2 xv[8];
#pragma unroll
        for (int i = 0; i < 8; ++i) { const f32x2 pp = {p[2 * i], p[2 * i + 1]}, nn = {nf[i >> 1][2 * (i & 1)], nf[i >> 1][2 * (i & 1) + 1]}; xv[i] = (pp + nn) * QK2; }
        if (need_mask) {
#pragma unroll
            for (int i = 0; i < 8; ++i) { const int key = key0 + ((2 * i) & 3) + 8 * ((2 * i) >> 2) + 4 * h;
                xv[i].x = (key > qpos) ? -__builtin_inff() : xv[i].x; xv[i].y = (key + 1 > qpos) ? -__builtin_inff() : xv[i].y; }
        }
        float bm = fmaxf(xv[0].x, xv[0].y);
#pragma unroll
        for (int i = 1; i < 8; ++i) bm = fmaxf(bm, fmaxf(xv[i].x, xv[i].y));
        { auto rr = __builtin_amdgcn_permlane32_swap(__float_as_uint(bm), __float_as_uint(bm), false, false); bm = fmaxf(__uint_as_float(rr[0]), __uint_as_float(rr[1])); }
        const float mn = fmaxf(m, bm), alpha = ex2(m - mn); m = mn;
        f32x2 ls2 = {0.f, 0.f};
#pragma unroll
        for (int i = 0; i < 8; ++i) { f32x2 e = xv[i] - mn; e.x = ex2(e.x); e.y = ex2(e.y); ls2 += e; x[2 * i] = e.x; x[2 * i + 1] = e.y; }
        float ls = ls2.x + ls2.y;
        { auto rr = __builtin_amdgcn_permlane32_swap(__float_as_uint(ls), __float_as_uint(ls), false, false); ls = __uint_as_float(rr[0]) + __uint_as_float(rr[1]); }
        l = l * alpha + ls;
        if (__any(alpha != 1.f)) {
#pragma unroll
            for (int c = 0; c < 4; ++c)
#pragma unroll
                for (int r = 0; r < 16; ++r) o[c][r] *= alpha;
        }
    } else {
        float lm[16];
#pragma unroll
        for (int r = 0; r < 16; ++r) { const int key = key0 + (r & 3) + 8 * (r >> 2) + 4 * h; const float z2 = p[r] * QK2, e = ex2(-fabsf(z2)), sp = fmaxf(z2, 0.f) + lg2(1.f + e);
            const bool valid = key < qpos; lm[r] = valid ? -sp : 0.f; x[r] = valid ? (z2 - sp) : -__builtin_inff(); }
        float gs0 = (lm[0] + lm[1]) + (lm[2] + lm[3]), gs1 = (lm[4] + lm[5]) + (lm[6] + lm[7]), gs2 = (lm[8] + lm[9]) + (lm[10] + lm[11]), gs3 = (lm[12] + lm[13]) + (lm[14] + lm[15]);
        float a0, b0, a1, b1, a2, b2, a3, b3;
        { auto rr = __builtin_amdgcn_permlane32_swap(__float_as_uint(gs0), __float_as_uint(gs0), false, false); a0 = __uint_as_float(rr[0]); b0 = __uint_as_float(rr[1]); }
        { auto rr = __builtin_amdgcn_permlane32_swap(__float_as_uint(gs1), __float_as_uint(gs1), false, false); a1 = __uint_as_float(rr[0]); b1 = __uint_as_float(rr[1]); }
        { auto rr = __builtin_amdgcn_permlane32_swap(__float_as_uint(gs2), __float_as_uint(gs2), false, false); a2 = __uint_as_float(rr[0]); b2 = __uint_as_float(rr[1]); }
        { auto rr = __builtin_amdgcn_permlane32_swap(__float_as_uint(gs3), __float_as_uint(gs3), false, false); a3 = __uint_as_float(rr[0]); b3 = __uint_as_float(rr[1]); }
        const float T7 = 0.f, T6 = b3, T5 = T6 + a3, T4 = T5 + b2, T3 = T4 + a2, T2 = T3 + b1, T1 = T2 + a1, T0 = T1 + b0;
        const float total = T0 + a0;
        const float tb0 = carry + (h ? T1 : T0), tb1 = carry + (h ? T3 : T2), tb2 = carry + (h ? T5 : T4), tb3 = carry + (h ? T7 : T6);
#define SB_GRP(g, tb) do { const float t3 = (tb), t2 = t3 + lm[4 * (g) + 3], t1 = t2 + lm[4 * (g) + 2], t0 = t1 + lm[4 * (g) + 1]; \
            x[4 * (g) + 3] = ex2(x[4 * (g) + 3] + t3); x[4 * (g) + 2] = ex2(x[4 * (g) + 2] + t2); x[4 * (g) + 1] = ex2(x[4 * (g) + 1] + t1); x[4 * (g)] = ex2(x[4 * (g)] + t0); } while (0)
        SB_GRP(0, tb0); SB_GRP(1, tb1); SB_GRP(2, tb2); SB_GRP(3, tb3);
#undef SB_GRP
        carry += total;
        { bool bad = false;
#pragma unroll
          for (int r = 0; r < 16; ++r) bad |= nonfin(x[r]);
          DBG_FLAG(bad, 2); DBG_FLAG(nonfin(carry), 3); }
    }
    bf16x8 pk[2];
#pragma unroll
    for (int ks = 0; ks < 2; ++ks) { v4u w; w.x = cvtpk(x[8 * ks], x[8 * ks + 1]); w.y = cvtpk(x[8 * ks + 2], x[8 * ks + 3]); w.z = cvtpk(x[8 * ks + 4], x[8 * ks + 5]); w.w = cvtpk(x[8 * ks + 6], x[8 * ks + 7]); pk[ks] = __builtin_bit_cast(bf16x8, w); }
    __builtin_amdgcn_s_setprio(1);
    attn_pv(Vt, blk, pk, o, lane);
    __builtin_amdgcn_s_setprio(0);
}

__device__ __forceinline__ float vmax3(float a, float b, float c) { float r; asm("v_max3_f32 %0, %1, %2, %3" : "=v"(r) : "v"(a), "v"(b), "v"(c)); return r; }
__device__ __forceinline__ void attn_tile64_fox(const LAS unsigned char* Kt, const LAS unsigned char* Vt, const bf16x8 (&qf)[8], f32x16 (&o)[4], float& m, float& l, int lane, const LAS float* fkl) {
    const int r32 = lane & 31, h = lane >> 5;
    f32x16 p1, p0;
#pragma unroll
    for (int g = 0; g < 4; ++g) { const f32x4 n1 = *(const LAS f32x4*)(fkl + 32 + 8 * g + 4 * h), n0 = *(const LAS f32x4*)(fkl + 8 * g + 4 * h);
#pragma unroll
        for (int j = 0; j < 4; ++j) { p1[4 * g + j] = n1[j]; p0[4 * g + j] = n0[j]; } }
    {
        const unsigned kx = ((r32 & 3u) << 2) | ((r32 >> 2) & 3u);
        const LAS unsigned char* kb = Kt + 256u * r32;
#pragma unroll
        for (int s = 0; s < 8; ++s) { const unsigned co = 16u * ((unsigned)(2 * s + h) ^ kx);
            const bf16x8 a1 = *(const LAS bf16x8*)(kb + 8192u + co), a0 = *(const LAS bf16x8*)(kb + co);
            p1 = __builtin_amdgcn_mfma_f32_32x32x16_bf16(a1, qf[s], p1, 0, 0, 0); p0 = __builtin_amdgcn_mfma_f32_32x32x16_bf16(a0, qf[s], p0, 0, 0, 0); }
    }
    s16x4 fl[4], fh[4];
    int lv = lane; asm volatile("" : "+v"(lv));
    const unsigned vh_ = ((unsigned)lv >> 5) & 1u, vq4 = (lv & 15) >> 2, vpp = lv & 3, vbc = (lv >> 4) & 1;
#define VLD(blk_, ks_, c_) do { const unsigned row0_ = 32u * (blk_) + 16u * (ks_) + 4u * vh_ + vq4, x0_ = (vq4 << 2) | (vh_ & 3u), x1_ = (vq4 << 2) | ((vh_ + 2u) & 3u), chn_ = 4u * (c_) + 2u * vbc + (vpp >> 1); \
        fl[c_] = __builtin_amdgcn_ds_read_tr16_b64_v4i16((LAS s16x4*)(Vt + 256u * row0_ + 16u * (chn_ ^ x0_) + 8u * (vpp & 1))); \
        fh[c_] = __builtin_amdgcn_ds_read_tr16_b64_v4i16((LAS s16x4*)(Vt + 256u * (row0_ + 8u) + 16u * (chn_ ^ x1_) + 8u * (vpp & 1))); } while (0)
#define VMMA(c_, pk_) do { const bf16x8 a_ = {fl[c_][0], fl[c_][1], fl[c_][2], fl[c_][3], fh[c_][0], fh[c_][1], fh[c_][2], fh[c_][3]}; o[c_] = __builtin_amdgcn_mfma_f32_32x32x16_bf16(a_, pk_, o[c_], 0, 0, 0); } while (0)
    VLD(1, 0, 0); VLD(1, 0, 1); VLD(1, 0, 2); VLD(1, 0, 3);
    __builtin_amdgcn_sched_barrier(0);
    float bmA = vmax3(p1[0], p1[1], p1[2]), bmB = vmax3(p0[0], p0[1], p0[2]);
#pragma unroll
    for (int i = 3; i < 15; i += 2) { bmA = vmax3(bmA, p1[i], p1[i + 1]); bmB = vmax3(bmB, p0[i], p0[i + 1]); }
    float bm = vmax3(bmA, bmB, p1[15]); bm = fmaxf(bm, p0[15]);
    { auto rr = __builtin_amdgcn_permlane32_swap(__float_as_uint(bm), __float_as_uint(bm), false, false); bm = fmaxf(__uint_as_float(rr[0]), __uint_as_float(rr[1])) * QK2; }
    const float mn = fmaxf(m, bm), alpha = ex2(m - mn); m = mn;
    if (__any(alpha != 1.f)) {
#pragma unroll
        for (int c = 0; c < 4; ++c)
#pragma unroll
            for (int r = 0; r < 16; ++r) o[c][r] *= alpha;
    }
    f32x2 ls2 = {0.f, 0.f};
    bf16x8 pk1[2], pk0[2];
    { v4u w[2];
#pragma unroll
      for (int i = 0; i < 8; ++i) { f32x2 e = (f32x2){p1[2 * i], p1[2 * i + 1]} * QK2 - mn; e.x = ex2(e.x); e.y = ex2(e.y); ls2 += e; w[i >> 2][i & 3] = cvtpk(e.x, e.y); }
      pk1[0] = __builtin_bit_cast(bf16x8, w[0]); pk1[1] = __builtin_bit_cast(bf16x8, w[1]); }
    __builtin_amdgcn_sched_barrier(0);
#define VSTEP(c_, pk_, nb_, nk_) do { VMMA(c_, pk_); VLD(nb_, nk_, c_); __builtin_amdgcn_sched_barrier(0); } while (0)
    VSTEP(0, pk1[0], 1, 1); VSTEP(1, pk1[0], 1, 1); VSTEP(2, pk1[0], 1, 1); VSTEP(3, pk1[0], 1, 1);
    VSTEP(0, pk1[1], 0, 0); VSTEP(1, pk1[1], 0, 0); VSTEP(2, pk1[1], 0, 0); VSTEP(3, pk1[1], 0, 0);
    { v4u w[2];
#pragma unroll
      for (int i = 0; i < 8; ++i) { f32x2 e = (f32x2){p0[2 * i], p0[2 * i + 1]} * QK2 - mn; e.x = ex2(e.x); e.y = ex2(e.y); ls2 += e; w[i >> 2][i & 3] = cvtpk(e.x, e.y); }
      pk0[0] = __builtin_bit_cast(bf16x8, w[0]); pk0[1] = __builtin_bit_cast(bf16x8, w[1]); }
    __builtin_amdgcn_sched_barrier(0);
    VSTEP(0, pk0[0], 0, 1); VSTEP(1, pk0[0], 0, 1); VSTEP(2, pk0[0], 0, 1); VSTEP(3, pk0[0], 0, 1);
    VMMA(0, pk0[1]); VMMA(1, pk0[1]); VMMA(2, pk0[1]); VMMA(3, pk0[1]);
#undef VSTEP
#undef VMMA
#undef VLD
    float ls = ls2.x + ls2.y;
    { auto rr = __builtin_amdgcn_permlane32_swap(__float_as_uint(ls), __float_as_uint(ls), false, false); ls = __uint_as_float(rr[0]) + __uint_as_float(rr[1]); }
    l = l * alpha + ls;
}

template <int MODE>
__device__ __forceinline__ void attn_prompt_unit(LAS unsigned char* lds, const bf16_t* Qb, const bf16_t* Kb, const bf16_t* Vb, const bf16_t* Gate, int ld, int hd, int qb,
                                                 bf16_t* Out, int ocol0, const float* FCh, int tid, int wid, int lane, float kn2 = 0.f  ) {
    asm volatile("" : "+v"(tid)); lane = tid & 63;
    const int r32 = lane & 31, h = lane >> 5;
    const int qlo = qb * 256 + wid * 32, qrow = qlo + r32;
    bf16x8 qf[8];
    { const bf16_t* qp = Qb + (size_t)qrow * ld + hd * HD + 8 * h;
#pragma unroll
      for (int s = 0; s < 8; ++s) qf[s] = *(const bf16x8*)(qp + 16 * s); }
    f32x16 o[4] = {};
    float m = -1e30f, l = 0.f, carry = 0.f;
    const float fq2 = MODE ? FCh[qrow] : 0.f;
    float qnk = 0.f;
    if (MODE == 1) { float s2 = 0.f;
#pragma unroll
        for (int s = 0; s < 8; ++s)
#pragma unroll
            for (int e = 0; e < 8; ++e) { const float qv = bf2f((unsigned short)qf[s][e]); s2 += qv * qv; }
        { auto rr = __builtin_amdgcn_permlane32_swap(__float_as_uint(s2), __float_as_uint(s2), false, false); s2 = __uint_as_float(rr[0]) + __uint_as_float(rr[1]); }
        qnk = sqrtf(s2) * kn2; }
    LAS float* Fl = (LAS float*)(lds + 65536 + 128);
    float sf = 0.f;
    volatile LAS int* flags = (volatile LAS int*)(lds + 65536);
    const int ktop = 4 * qb + 3;
    const int srow = tid >> 4, sch = tid & 15;
    const bf16_t* kg = Kb + (size_t)srow * ld + hd * HD + sch * 8;
    const bf16_t* vg = Vb + (size_t)srow * ld + hd * HD + sch * 8;
    const unsigned so0 = off_b(srow, sch), so1 = off_b(srow + 32, sch);
    v4u sk0, sk1, sv0, sv1;
#define AP_ISSUE(kt) do { if (MODE == 1 && tid < 64) sf = FCh[(kt) * 64 + tid]; const size_t go = (size_t)(kt) * 64 * ld; sk0 = *(const v4u*)(kg + go); sk1 = *(const v4u*)(kg + go + (size_t)32 * ld); sv0 = *(const v4u*)(vg + go); sv1 = *(const v4u*)(vg + go + (size_t)32 * ld); } while (0)
#define AP_WRITE(b) do { if (MODE == 1 && tid < 64) Fl[(b) * 64 + tid] = sf; LAS unsigned char* kb_ = lds + (b) * 32768; *(LAS v4u*)(kb_ + so0) = sk0; *(LAS v4u*)(kb_ + so1) = sk1; *(LAS v4u*)(kb_ + 16384 + so0) = sv0; *(LAS v4u*)(kb_ + 16384 + so1) = sv1; } while (0)
    if (tid < 16) flags[tid] = 0;
    int cur = 0, it = 0; bool wdone = false;
    AP_ISSUE(ktop);
    for (int kt = ktop; kt >= 0; --kt, ++it) {
        AP_WRITE(cur);
        __syncthreads();
        if (it > 0) { const volatile LAS int* f = flags + ((it - 1) & 1) * 8; int all = 1;
#pragma unroll
            for (int w = 0; w < 8; ++w) all &= f[w];
            if (all) break; }
        if (kt > 0) AP_ISSUE(kt - 1);
        if (!wdone) {
#pragma unroll
            for (int blk = 1; blk >= 0; --blk) {
                const int key0 = kt * 64 + blk * 32;
                if (key0 > qlo + 31) continue;
                attn_block<MODE, MODE == 1>(lds + cur * 32768, lds + cur * 32768 + 16384, blk, qf, o, m, l, carry, key0, qrow, fq2, nullptr, lane, nullptr, Fl + cur * 64 + blk * 32, key0 + 31 > qlo);
            }
            if (MODE == 0) wdone = __all(carry < -136.f);
            else wdone = __all(m > -1e29f && qnk + Fl[cur * 64] * QK2 < m - 136.f);
        }
        if (lane == 0) flags[(it & 1) * 8 + wid] = wdone ? 1 : 0;
        cur ^= 1;
    }
#undef AP_ISSUE
#undef AP_WRITE
    const float inv = MODE ? 1.f / l : 1.f;
    const bf16_t* gp = Gate + (size_t)qrow * ld + hd * HD + 4 * h;
    bf16_t* op = Out + (size_t)qrow * DM + ocol0 + 4 * h;
#pragma unroll
    for (int c = 0; c < 4; ++c)
#pragma unroll
        for (int g = 0; g < 4; ++g) { const v2u gw = *(const v2u*)(gp + 32 * c + 8 * g);
            v2u w; w.x = cvtpk(o[c][4 * g] * inv * bflo(gw.x), o[c][4 * g + 1] * inv * bfhi(gw.x)); w.y = cvtpk(o[c][4 * g + 2] * inv * bflo(gw.y), o[c][4 * g + 3] * inv * bfhi(gw.y));
            *(v2u*)(op + 32 * c + 8 * g) = w; }
    __syncthreads();
}

struct GBar { volatile LAS unsigned* cnt; unsigned tgt; };
__device__ __forceinline__ void gbar_sync(GBar& g, int lane) {
    g.tgt += 4u;
    asm volatile("s_waitcnt lgkmcnt(0)" ::: "memory");
    if (lane == 0) __hip_atomic_fetch_add((LAS unsigned*)g.cnt, 1u, __ATOMIC_RELAXED, __HIP_MEMORY_SCOPE_WORKGROUP);
    while ((int)(__hip_atomic_load((LAS unsigned*)g.cnt, __ATOMIC_RELAXED, __HIP_MEMORY_SCOPE_WORKGROUP) - g.tgt) < 0) __builtin_amdgcn_s_sleep(1);
    asm volatile("" ::: "memory");
}
template <int MODE>
__device__ __forceinline__ void attn_prompt_group(LAS unsigned char* gl, LAS unsigned char* gx, GBar& gb, const bf16_t* Qb, const bf16_t* Kb, const bf16_t* Vb, const bf16_t* Gate, int ld, int hd, int qb,
                                                  bf16_t* Out, int ocol0, const float* FCh, int gtid, int gw, float kn2) {
    asm volatile("" : "+v"(gtid)); const int lane = gtid & 63;
    const int r32 = lane & 31, h = lane >> 5;
    const int qlo = qb * 128 + gw * 32, qrow = qlo + r32;
    bf16x8 qf[8];
    { const bf16_t* qp = Qb + (size_t)qrow * ld + hd * HD + 8 * h;
#pragma unroll
      for (int s = 0; s < 8; ++s) qf[s] = *(const bf16x8*)(qp + 16 * s); }
    f32x16 o[4] = {};
    float m = -1e30f, l = 0.f, carry = 0.f;
    float qnk = 0.f;
    if (MODE == 1) { float s2 = 0.f;
#pragma unroll
        for (int s = 0; s < 8; ++s)
#pragma unroll
            for (int e = 0; e < 8; ++e) { const float qv = bf2f((unsigned short)qf[s][e]); s2 += qv * qv; }
        { auto rr = __builtin_amdgcn_permlane32_swap(__float_as_uint(s2), __float_as_uint(s2), false, false); s2 = __uint_as_float(rr[0]) + __uint_as_float(rr[1]); }
        qnk = sqrtf(s2) * kn2; }
    LAS float* Fl = (LAS float*)(gx + 128);
    volatile LAS int* flags = (volatile LAS int*)gx;
    const int ktop = 2 * qb + 1;
#define AG_DMA(kt, b) do { const size_t go_ = (size_t)(kt) * 64 * ld * 2; LAS unsigned char* kb_ = gl + (b) * 32768 + gw * 4096; int l_ = gtid; asm volatile("" : "+v"(l_)); l_ &= 63; unsigned voff[4]; \
        _Pragma("unroll") for (int i_ = 0; i_ < 4; ++i_) { const int row_ = 16 * gw + 4 * i_ + (l_ >> 4), ch_ = (l_ & 15) ^ ((((l_ >> 4) & 3) << 2) | i_); voff[i_] = (unsigned)((row_ * ld + hd * HD + 8 * ch_) * 2); } \
        _Pragma("unroll") for (int i_ = 0; i_ < 4; ++i_) { \
            __builtin_amdgcn_global_load_lds((const unsigned*)((const char*)Kb + go_ + voff[i_]), (LAS unsigned*)(kb_ + i_ * 1024), 16, 0, 0); \
            __builtin_amdgcn_global_load_lds((const unsigned*)((const char*)Vb + go_ + voff[i_]), (LAS unsigned*)(kb_ + 16384 + i_ * 1024), 16, 0, 0); } \
        if (MODE == 1 && gw == 0) __builtin_amdgcn_global_load_lds((const unsigned*)(FCh + (kt) * 64 + l_), (LAS unsigned*)(Fl + (b) * 64), 4, 0, 0); } while (0)
    if (gtid < 8) flags[gtid] = 0;
    int cur = 0, it = 0; bool wdone = false;
    AG_DMA(ktop, 0);
    for (int kt = ktop; kt >= 0; --kt, ++it) {
        asm volatile("s_waitcnt vmcnt(0)" ::: "memory");
        gbar_sync(gb, lane);
        if (it > 0) { const volatile LAS int* f = flags + ((it - 1) & 1) * 4; if (f[0] & f[1] & f[2] & f[3]) break; }
        if (kt > 0) AG_DMA(kt - 1, cur ^ 1);
        if (!wdone) {
            if (MODE == 1 && kt * 64 + 63 <= qlo) attn_tile64_fox(gl + cur * 32768, gl + cur * 32768 + 16384, qf, o, m, l, lane, Fl + cur * 64);
            else {
#pragma unroll
            for (int blk = 1; blk >= 0; --blk) {
                const int key0 = kt * 64 + blk * 32;
                if (key0 > qlo + 31) continue;
                attn_block<MODE, MODE == 1>(gl + cur * 32768, gl + cur * 32768 + 16384, blk, qf, o, m, l, carry, key0, qrow, 0.f, nullptr, lane, nullptr, Fl + cur * 64 + blk * 32, key0 + 31 > qlo);
            } }
            if (MODE == 0) wdone = __all(carry < -136.f);
            else wdone = __all(m > -1e29f && qnk + Fl[cur * 64] * QK2 < m - 136.f);
        }
        if (lane == 0) flags[(it & 1) * 4 + gw] = wdone ? 1 : 0;
        cur ^= 1;
    }
#undef AG_DMA
    const float inv = MODE ? 1.f / l : 1.f;
    int le = gtid; asm volatile("" : "+v"(le));
    const int qrow_e = qlo + (le & 31), he = (le >> 5) & 1;
    const bf16_t* gp = Gate + (size_t)qrow_e * ld + hd * HD + 4 * he;
    bf16_t* op = Out + (size_t)qrow_e * DM + ocol0 + 4 * he;
#pragma unroll
    for (int c = 0; c < 4; ++c)
#pragma unroll
        for (int g = 0; g < 4; ++g) { const v2u gw_ = *(const v2u*)(gp + 32 * c + 8 * g);
            v2u w; w.x = cvtpk(o[c][4 * g] * inv * bflo(gw_.x), o[c][4 * g + 1] * inv * bfhi(gw_.x)); w.y = cvtpk(o[c][4 * g + 2] * inv * bflo(gw_.y), o[c][4 * g + 3] * inv * bfhi(gw_.y));
            *(v2u*)(op + 32 * c + 8 * g) = w; }
    gbar_sync(gb, lane);
}

__device__ __forceinline__ void fl_rows(LAS unsigned char* lds, const bf16_t* XN, const bf16_t* W3fl, const unsigned long long* RS, const float* bfg, float* FL, float* outF, int row0, int tid, int wid) {
    asm volatile("" : "+v"(tid)); const int lane = tid & 63;
    const int r32 = lane & 31, h = lane >> 5;
    f32x16 acc = {};
    const bf16_t* ap = XN + (size_t)(row0 + r32) * DM + wid * 512 + 8 * h;
    const bf16_t* bp = W3fl + (size_t)r32 * DM + wid * 512 + 8 * h;
#pragma unroll 8
    for (int s = 0; s < 32; ++s) { const bf16x8 a = *(const bf16x8*)(ap + 16 * s), bb = *(const bf16x8*)(bp + 16 * s); acc = __builtin_amdgcn_mfma_f32_32x32x16_bf16(a, bb, acc, 0, 0, 0); }
    LAS float* red = (LAS float*)lds;
#pragma unroll
    for (int r = 0; r < 16; ++r) red[(wid * 32 + (r & 3) + 8 * (r >> 2) + 4 * h) * 32 + r32] = acc[r];
    __syncthreads();
    { const int row = tid >> 4, c2 = (tid & 15) * 2;
      float s0 = 0.f, s1 = 0.f;
#pragma unroll
      for (int w = 0; w < 8; ++w) { const f32x2 v = *(const LAS f32x2*)(red + (w * 32 + row) * 32 + c2); s0 += v.x; s1 += v.y; }
      const float r = rsqrtf((float)RS[row0 + row] * (1.f / (FIX * 4096.f)) + EPS);
      float x0 = s0 * r + bfg[c2], x1 = s1 * r + bfg[c2 + 1];
      x0 = fminf(x0, 0.f) - log1pf(__expf(-fabsf(x0))); x1 = fminf(x1, 0.f) - log1pf(__expf(-fabsf(x1)));
      *(f32x2*)(FL + (size_t)(row0 + row) * 32 + c2) = (f32x2){x0, x1}; *(f32x2*)(outF + (size_t)(row0 + row) * 32 + c2) = (f32x2){x0, x1}; }
    __syncthreads();
}

template <int NB>
__device__ __forceinline__ void stage_block_f32(LAS unsigned char* T, const float* src  , size_t rs, int lane) {
#pragma unroll
    for (int hf = 0; hf < 16 / NB; ++hf) {
        f32x4 v[NB];
#pragma unroll
        for (int i = 0; i < NB; ++i) { const int id = lane + 64 * (NB * hf + i), row = id >> 5, c4 = id & 31; v[i] = *(const f32x4*)(src + (size_t)row * rs + c4 * 4); }
#pragma unroll
        for (int i = 0; i < NB; ++i) { const int id = lane + 64 * (NB * hf + i), row = id >> 5, c4 = id & 31; v2u w; w.x = cvtpk(v[i].x, v[i].y); w.y = cvtpk(v[i].z, v[i].w);
            *(LAS v2u*)(T + off_b(row, c4 >> 1) + (c4 & 1) * 8) = w; }
        asm volatile("" ::: "memory");
    }
}
__device__ __forceinline__ void stage_block_new(LAS unsigned char* T, const bf16_t* src  , int ld, int lane) {
#pragma unroll
    for (int i = 0; i < 8; ++i) { const int id = lane + 64 * i, row = id >> 4, ch = id & 15; v4u w = {0u, 0u, 0u, 0u}; if (row < 16) w = *(const v4u*)(src + (size_t)row * ld + ch * 8);
        *(LAS v4u*)(T + off_b(row, ch)) = w; }
    asm volatile("" ::: "memory");
}
__device__ __forceinline__ void attn_sample_sb_unit(LAS unsigned char* lds, int b, int hd, const bf16_t* QB, const bf16_t* KB, const bf16_t* VB, const bf16_t* GB,
                                                    const float* ck, const float* cv, bf16_t* Out, int tid_, int wid) {
    int lane = tid_ & 63; asm volatile("" : "+v"(lane));
    const int r32 = lane & 31, h = lane >> 5, t = r32 & 15; const bool real = r32 < 16;
    const int qrow = TP + 16 * b + t, qpos = real ? PAST + t : -1;
    bf16x8 qf[8];
    { const bf16_t* qp = QB + (size_t)qrow * HW + hd * HD + 8 * h;
#pragma unroll
      for (int s = 0; s < 8; ++s) { qf[s] = *(const bf16x8*)(qp + 16 * s); if (!real) qf[s] = (bf16x8){0, 0, 0, 0, 0, 0, 0, 0}; } }
    f32x16 o[4] = {};
    float m = 0.f, l = 0.f, carry = 0.f;
    volatile LAS int* flag = (volatile LAS int*)(lds + 65536);
    for (int tl = 16; tl >= 0; --tl) {
        int tid = wid * 64 + lane; asm volatile("" : "+v"(tid));
        if (tl == 16) {
#pragma unroll
            for (int i = 0; i < 2; ++i) { const int id = tid + 512 * i, row = id >> 4, ch = id & 15; v4u wk = {0u, 0u, 0u, 0u}, wv = {0u, 0u, 0u, 0u};
                if (row < 16) { const size_t go = (size_t)(TP + 16 * b + row) * HW + hd * HD + ch * 8; wk = *(const v4u*)(KB + go); wv = *(const v4u*)(VB + go); }
                *(LAS v4u*)(lds + off_b(row, ch)) = wk; *(LAS v4u*)(lds + 16384 + off_b(row, ch)) = wv; }
        } else {
            const size_t ro = (((size_t)b * PAST + 64 * tl) * NH_B + hd) * HD;
            f32x4 vk[4], vv[4];
#pragma unroll
            for (int i = 0; i < 4; ++i) { const int id = tid + 512 * i, row = id >> 5, c4 = id & 31; const size_t go = ro + (size_t)row * (NH_B * HD) + c4 * 4; vk[i] = *(const f32x4*)(ck + go); vv[i] = *(const f32x4*)(cv + go); }
#pragma unroll
            for (int i = 0; i < 4; ++i) { const int id = tid + 512 * i, row = id >> 5, c4 = id & 31; const unsigned lo = off_b(row, c4 >> 1) + (c4 & 1) * 8;
                v2u w; w.x = cvtpk(vk[i].x, vk[i].y); w.y = cvtpk(vk[i].z, vk[i].w); *(LAS v2u*)(lds + lo) = w;
                w.x = cvtpk(vv[i].x, vv[i].y); w.y = cvtpk(vv[i].z, vv[i].w); *(LAS v2u*)(lds + 16384 + lo) = w; }
        }
        __syncthreads();
        if (wid == 0) {
            attn_block<0>(lds, lds + 16384, 1, qf, o, m, l, carry, 64 * tl + 32, qpos, 0.f, nullptr, lane);
            attn_block<0>(lds, lds + 16384, 0, qf, o, m, l, carry, 64 * tl, qpos, 0.f, nullptr, lane);
            if (lane == 0) flag[0] = __all(carry < -136.f || !real) ? 1 : 0;
        }
        __syncthreads();
        if (flag[0]) break;
    }
    if (wid == 0 && real) {
        const bf16_t* gp = GB + (size_t)qrow * HW + hd * HD + 4 * h;
        bf16_t* op = Out + (size_t)qrow * DM + HW + hd * HD + 4 * h;
#pragma unroll
        for (int c = 0; c < 4; ++c)
#pragma unroll
            for (int g = 0; g < 4; ++g) { const v2u gw = *(const v2u*)(gp + 32 * c + 8 * g);
                v2u w; w.x = cvtpk(o[c][4 * g] * bflo(gw.x), o[c][4 * g + 1] * bfhi(gw.x)); w.y = cvtpk(o[c][4 * g + 2] * bflo(gw.y), o[c][4 * g + 3] * bfhi(gw.y));
                *(v2u*)(op + 32 * c + 8 * g) = w; }
    }
    __syncthreads();
}
__device__ __forceinline__ void attn_sample_fox_unit(LAS unsigned char* lds, int b, int hd, const bf16_t* QC, const bf16_t* KC, const bf16_t* VC, const bf16_t* GC,
                                                     const float* ck, const float* cv, const float* clf  , const float* FL, bf16_t* Out, int tid, int wid, int lane) {
    asm volatile("" : "+v"(tid)); lane = tid & 63;
    const int r32 = lane & 31, h = lane >> 5, t = r32 & 15; const bool real = r32 < 16;
    const int qrow = TP + 16 * b + t, qpos = real ? PAST + t : -1;
    LAS float* NFl = (LAS float*)(lds + RING_BYTES + 2048);
    { float v[3];
#pragma unroll
      for (int j = 0; j < 3; ++j) { const int s = tid * 3 + j; float x = 0.f;
          if (s < PAST) x = clf[((size_t)b * PAST + s) * NH_C + hd]; else if (s < PAST + TSQ) x = FL[(size_t)(TP + 16 * b + s - PAST) * 32 + hd];
          v[j] = x * -NFRS; }
      wg_scan<3>(v, (LAS float*)(lds + RING_BYTES + 1536), tid, wid, lane);
#pragma unroll
      for (int j = 0; j < 3; ++j) { const int s = tid * 3 + j; if (s < FCS_LD) NFl[s] = v[j]; }
      __syncthreads(); }
    LAS unsigned char* wl = lds + wid * 16384;
    bf16x8 qf[8];
    { const bf16_t* qp = QC + (size_t)qrow * DM + hd * HD + 8 * h;
#pragma unroll
      for (int s = 0; s < 8; ++s) { qf[s] = *(const bf16x8*)(qp + 16 * s); if (!real) qf[s] = (bf16x8){0, 0, 0, 0, 0, 0, 0, 0}; } }
    f32x16 o[4] = {};
    float m = -1e30f, l = 0.f, carry = 0.f;
    const float fq2 = 0.f;
    const int nb = (wid == 7) ? 5 : 4;
    for (int j = 0; j < nb; ++j) {
        const int bi = (j == 4) ? 32 : 4 * wid + j;
        if (bi == 32) { stage_block_new(wl, KC + (size_t)(TP + 16 * b) * DM + hd * HD, DM, lane); stage_block_new(wl + 8192, VC + (size_t)(TP + 16 * b) * DM + hd * HD, DM, lane); }
        else { const size_t ro = (((size_t)b * PAST + 32 * bi) * NH_C + hd) * HD; stage_block_f32<8>(wl, ck + ro, (size_t)NH_C * HD, lane); stage_block_f32<8>(wl + 8192, cv + ro, (size_t)NH_C * HD, lane); }
        attn_block<1, true>(wl, wl + 8192, 0, qf, o, m, l, carry, 32 * bi, qpos, fq2, nullptr, lane, nullptr, NFl + 32 * bi, bi == 32);
    }
    __syncthreads();
    LAS float* co = (LAS float*)lds;
    LAS float* cm = (LAS float*)(lds + 65536);
    if (real) {
        if (h == 0) { cm[wid * 16 + t] = m; cm[128 + wid * 16 + t] = l; }
#pragma unroll
        for (int c = 0; c < 4; ++c)
#pragma unroll
            for (int g = 0; g < 4; ++g) *(LAS f32x4*)(co + (wid * 16 + t) * 128 + 32 * c + 8 * g + 4 * h) = (f32x4){o[c][4 * g], o[c][4 * g + 1], o[c][4 * g + 2], o[c][4 * g + 3]};
    }
    __syncthreads();
    {
        const int tq = tid >> 5, d4 = (tid & 31) * 4;
        float M = -1e30f;
#pragma unroll
        for (int w = 0; w < 8; ++w) M = fmaxf(M, cm[w * 16 + tq]);
        float L = 0.f; f32x4 acc = {0.f, 0.f, 0.f, 0.f};
#pragma unroll
        for (int w = 0; w < 8; ++w) { const float sc = ex2(cm[w * 16 + tq] - M); L += cm[128 + w * 16 + tq] * sc; acc += *(const LAS f32x4*)(co + (w * 16 + tq) * 128 + d4) * sc; }
        const float inv = 1.f / L;
        const int orow = TP + 16 * b + tq;
        const v2u gw = *(const v2u*)(GC + (size_t)orow * DM + hd * HD + d4);
        v2u w; w.x = cvtpk(acc[0] * inv * bflo(gw.x), acc[1] * inv * bfhi(gw.x)); w.y = cvtpk(acc[2] * inv * bflo(gw.y), acc[3] * inv * bfhi(gw.y));
        *(v2u*)(Out + (size_t)orow * DM + hd * HD + d4) = w;
    }
    __syncthreads();
}

__device__ __forceinline__ void hg_load_g(const float* Gp  , int ntok, int k, int a, float (&g)[16]) {
#pragma unroll
    for (int j = 0; j < 16; ++j) { const int i = 16 * a + j; g[j] = (i < ntok) ? Gp[(size_t)i * HW + k] : 0.f; }
}
__device__ __forceinline__ void hg_scan(const float (&g)[16], LAS float* tot, int k, int a, float (&Gc)[16], float& Glast, float& Gmid) {
    float run = 0.f;
#pragma unroll
    for (int j = 0; j < 16; ++j) { run += g[j]; Gc[j] = run; }
    tot[a * 128 + k] = run;
    __syncthreads();
    const float t0 = tot[k], t1 = tot[128 + k], t2 = tot[256 + k], t3 = tot[384 + k];
    const float offs = (a > 0 ? t0 : 0.f) + (a > 1 ? t1 : 0.f) + (a > 2 ? t2 : 0.f);
#pragma unroll
    for (int j = 0; j < 16; ++j) Gc[j] += offs;
    Glast = (t0 + t1) + (t2 + t3); Gmid = t0 + t1;
}
__device__ __forceinline__ void hg_tile_load(const bf16_t* src, int ntok, int tid, v4u (&w)[2]) {
#pragma unroll
    for (int i = 0; i < 2; ++i) { const int id = tid + 512 * i, row = id >> 4, ch = id & 15; w[i] = (v4u){0u, 0u, 0u, 0u}; if (row < ntok) w[i] = *(const v4u*)(src + (size_t)row * HW + ch * 8); }
}
__device__ __forceinline__ void hg_tile_write(LAS unsigned char* T, int tid, const v4u (&w)[2]) {
#pragma unroll
    for (int i = 0; i < 2; ++i) { const int id = tid + 512 * i, row = id >> 4, ch = id & 15; *(LAS v4u*)(T + off_b(row, ch)) = w[i]; }
}
constexpr int HG_V = 0, HG_KT = 16384, HG_QP = 32768, HG_QM = 49152, HG_KM = 65536, HG_SST = 81920, HG_TOT = 114688, HG_RED = 116736;

struct HgIn { float g[16]; unsigned short kr[16]; v4u vt[2]; };
__device__ __forceinline__ void hg_local_load(HgIn& I, const bf16_t* KAp, const bf16_t* VAp, const float* Gp, int ntok, int tid) {
    const int k = tid & 127, a = tid >> 7;
    hg_load_g(Gp, ntok, k, a, I.g);
    hg_tile_load(VAp, ntok, tid, I.vt);
#pragma unroll
    for (int j = 0; j < 16; ++j) { const int i = 16 * a + j; I.kr[j] = (i < ntok) ? KAp[(size_t)i * HW + k] : (unsigned short)0; }
}
template <bool SAMPLE>
__device__ __forceinline__ void hg_local_compute(LAS unsigned char* lds, const HgIn& I, const float* S0, float* Sout, float* Dout, int tid, int wid) {
    const int lane = tid & 63;
    const int k = tid & 127, a = tid >> 7;
    float Gc[16], Glast, Gmid;
    hg_scan(I.g, (LAS float*)(lds + HG_TOT), k, a, Gc, Glast, Gmid);
    hg_tile_write(lds + HG_V, tid, I.vt);
    {
        unsigned w[8];
#pragma unroll
        for (int j = 0; j < 16; j += 2) {
            const float k0 = bf2f(I.kr[j]) * ex2((Glast - Gc[j]) * LOG2E);
            const float k1 = bf2f(I.kr[j + 1]) * ex2((Glast - Gc[j + 1]) * LOG2E);
            w[j >> 1] = cvtpk(k0, k1); }
        const unsigned sx = (k >> 1) & 7;
        *(LAS v4u*)(lds + HG_KT + 128 * k + 16 * ((2 * a) ^ sx)) = (v4u){w[0], w[1], w[2], w[3]};
        *(LAS v4u*)(lds + HG_KT + 128 * k + 16 * ((2 * a + 1) ^ sx)) = (v4u){w[4], w[5], w[6], w[7]};
    }
    if (!SAMPLE && a == 0) Dout[k] = ex2(Glast * LOG2E);
    __syncthreads();
    const int r32 = lane & 31, h = lane >> 5, kb = wid >> 1;
    const unsigned q4 = (lane & 15) >> 2, pp = lane & 3, bc = (lane >> 4) & 1;
    f32x16 acc[2] = {};
    const int krow = 32 * kb + r32; const unsigned sx = (krow >> 1) & 7;
#pragma unroll
    for (int s = 0; s < 4; ++s) {
        const bf16x8 af = *(const LAS bf16x8*)(lds + HG_KT + 128 * krow + 16 * ((unsigned)(2 * s + h) ^ sx));
#pragma unroll
        for (int vv = 0; vv < 2; ++vv) { const int vb = 2 * (wid & 1) + vv;
            const unsigned row0 = 16u * s + 8u * h + q4, row1 = row0 + 4u, chn = 4u * vb + 2u * bc + (pp >> 1);
            const unsigned x0 = (q4 << 2) | ((row0 >> 2) & 3u), x1 = (q4 << 2) | ((row1 >> 2) & 3u);
            const s16x4 lo = __builtin_amdgcn_ds_read_tr16_b64_v4i16((LAS s16x4*)(lds + HG_V + 256u * row0 + 16u * (chn ^ x0) + 8u * (pp & 1)));
            const s16x4 hi = __builtin_amdgcn_ds_read_tr16_b64_v4i16((LAS s16x4*)(lds + HG_V + 256u * row1 + 16u * (chn ^ x1) + 8u * (pp & 1)));
            const bf16x8 bfg = {lo[0], lo[1], lo[2], lo[3], hi[0], hi[1], hi[2], hi[3]};
            acc[vv] = __builtin_amdgcn_mfma_f32_32x32x16_bf16(af, bfg, acc[vv], 0, 0, 0); }
    }
    const LAS float* tot = (const LAS float*)(lds + HG_TOT);
#pragma unroll
    for (int vv = 0; vv < 2; ++vv) { const int v = 32 * (2 * (wid & 1) + vv) + r32;
#pragma unroll
        for (int r = 0; r < 16; ++r) { const int kk = 32 * kb + (r & 3) + 8 * (r >> 2) + 4 * h;
            float val = acc[vv][r];
            if (SAMPLE) { const float gl = (tot[kk] + tot[128 + kk]) + (tot[256 + kk] + tot[384 + kk]); val += ex2(gl * LOG2E) * S0[kk * 128 + v]; }
            if (SAMPLE) Sout[kk * 128 + v] = val;
            else { const float nb_ = __shfl_xor(val, 1);
                   if ((lane & 1) == 0) *(unsigned*)((bf16_t*)Sout + kk * 128 + v) = cvtpk(val, nb_); } } }
    __syncthreads();
}

template <bool SAMPLE>
__device__ __forceinline__ void hg_local(LAS unsigned char* lds, const bf16_t* KAp, const bf16_t* VAp, const float* Gp, int ntok, const float* S0, float* Sout, float* Dout, int tid, int wid, int lane) {
    asm volatile("" : "+v"(tid));
    HgIn I; hg_local_load(I, KAp, VAp, Gp, ntok, tid);
    hg_local_compute<SAMPLE>(lds, I, S0, Sout, Dout, tid, wid);
}

__device__ __forceinline__ void hg_output(LAS unsigned char* lds, const bf16_t* QAp, const bf16_t* KAp, const bf16_t* VAp, const float* Gp, const bf16_t* GAp, int ntok,
                                          const bf16_t* Sst16, const float* S0f, const float* anw, bf16_t* Outp  , int tid, int wid, int lane) {
    asm volatile("" : "+v"(tid)); lane = tid & 63;
    const int k = tid & 127, a = tid >> 7;
    float g[16]; hg_load_g(Gp, ntok, k, a, g);
    v4u vt[2]; hg_tile_load(VAp, ntok, tid, vt);
    unsigned short qr[16], kr[16];
#pragma unroll
    for (int j = 0; j < 16; ++j) { const int i = 16 * a + j; qr[j] = 0; kr[j] = 0; if (i < ntok) { qr[j] = QAp[(size_t)i * HW + k]; kr[j] = KAp[(size_t)i * HW + k]; } }
    v4u s16[4]; f32x4 s32[8];
    if (Sst16) {
#pragma unroll
        for (int i = 0; i < 4; ++i) { const int id = tid + 512 * i, row = id >> 4, ch = id & 15; s16[i] = *(const v4u*)(Sst16 + (size_t)row * 128 + ch * 8); }
    } else {
#pragma unroll
        for (int i = 0; i < 8; ++i) { const int id = tid + 512 * i, row = id >> 5, c4 = id & 31; s32[i] = *(const f32x4*)(S0f + (size_t)row * 128 + c4 * 4); }
    }
    v2u gwv[4]; f32x4 wwv[4];
    { const int lane_e = tid & 63, r32e = lane_e & 31, he = lane_e >> 5, vbe = wid & 3, ibe = wid >> 2, ie = 32 * ibe + r32e;
      const bf16_t* gp = GAp + (size_t)(ie < ntok ? ie : 0) * HW + 32 * vbe + 4 * he; const float* wp = anw + 32 * vbe + 4 * he;
#pragma unroll
      for (int g2 = 0; g2 < 4; ++g2) { gwv[g2] = *(const v2u*)(gp + 8 * g2); wwv[g2] = *(const f32x4*)(wp + 8 * g2); } }
    float Gc[16], Glast, Gmid;
    hg_scan(g, (LAS float*)(lds + HG_TOT), k, a, Gc, Glast, Gmid);
    hg_tile_write(lds + HG_V, tid, vt);
    if (Sst16) {
#pragma unroll
        for (int i = 0; i < 4; ++i) { const int id = tid + 512 * i, row = id >> 4, ch = id & 15; *(LAS v4u*)(lds + HG_SST + off_b(row, ch)) = s16[i]; }
    } else {
#pragma unroll
        for (int i = 0; i < 8; ++i) { const int id = tid + 512 * i, row = id >> 5, c4 = id & 31; const f32x4 v = s32[i];
            v2u w; w.x = cvtpk(v.x, v.y); w.y = cvtpk(v.z, v.w); *(LAS v2u*)(lds + HG_SST + off_b(row, c4 >> 1) + (c4 & 1) * 8) = w; }
    }
#pragma unroll
    for (int j = 0; j < 16; ++j) { const int i = 16 * a + j;
        const float q = bf2f(qr[j]), kk = bf2f(kr[j]);
        const float eq = ex2(Gc[j] * LOG2E), em = ex2(fminf((Gc[j] - Gmid) * LOG2E, 115.f)), ek = ex2(fminf((Gmid - Gc[j]) * LOG2E, 115.f));
        const unsigned o2 = off_b(i, k >> 3) + (k & 7) * 2;
        *(LAS bf16_t*)(lds + HG_QP + o2) = (bf16_t)(cvtpk(q * eq, 0.f) & 0xffffu);
        *(LAS bf16_t*)(lds + HG_QM + o2) = (bf16_t)(cvtpk(q * em, 0.f) & 0xffffu);
        *(LAS bf16_t*)(lds + HG_KM + o2) = (bf16_t)(cvtpk(kk * ek, 0.f) & 0xffffu); }
    __syncthreads();
    const int r32 = lane & 31, h = lane >> 5, vb = wid & 3, ib = wid >> 2;
    const unsigned q4 = (lane & 15) >> 2, pp = lane & 3, bc = (lane >> 4) & 1;
    f32x16 o = {};
    const bool active = (32 * ib < ntok);
    if (active) {
        const unsigned irow = 32u * ib + r32, ix = ((irow & 3u) << 2) | ((irow >> 2) & 3u);
#pragma unroll
        for (int s = 0; s < 8; ++s) {
            const bf16x8 bq = *(const LAS bf16x8*)(lds + HG_QP + 256u * irow + 16u * ((unsigned)(2 * s + h) ^ ix));
            const unsigned row0 = 16u * s + 8u * h + q4, row1 = row0 + 4u, chn = 4u * vb + 2u * bc + (pp >> 1);
            const unsigned x0 = (q4 << 2) | ((row0 >> 2) & 3u), x1 = (q4 << 2) | ((row1 >> 2) & 3u);
            const s16x4 lo = __builtin_amdgcn_ds_read_tr16_b64_v4i16((LAS s16x4*)(lds + HG_SST + 256u * row0 + 16u * (chn ^ x0) + 8u * (pp & 1)));
            const s16x4 hi = __builtin_amdgcn_ds_read_tr16_b64_v4i16((LAS s16x4*)(lds + HG_SST + 256u * row1 + 16u * (chn ^ x1) + 8u * (pp & 1)));
            const bf16x8 as = {lo[0], lo[1], lo[2], lo[3], hi[0], hi[1], hi[2], hi[3]};
            o = __builtin_amdgcn_mfma_f32_32x32x16_bf16(as, bq, o, 0, 0, 0);
        }
#pragma unroll
        for (int jb = 0; jb < 2; ++jb) {
            if (jb > ib) continue;
            f32x16 p = {};
            const unsigned jrow = 32u * jb + r32, jx = ((jrow & 3u) << 2) | ((jrow >> 2) & 3u);
#pragma unroll
            for (int s = 0; s < 8; ++s) {
                const bf16x8 ak = *(const LAS bf16x8*)(lds + HG_KM + 256u * jrow + 16u * ((unsigned)(2 * s + h) ^ jx));
                const bf16x8 bq = *(const LAS bf16x8*)(lds + HG_QM + 256u * irow + 16u * ((unsigned)(2 * s + h) ^ ix));
                p = __builtin_amdgcn_mfma_f32_32x32x16_bf16(ak, bq, p, 0, 0, 0);
            }
            float x[16];
#pragma unroll
            for (int r = 0; r < 16; ++r) { const int j = 32 * jb + (r & 3) + 8 * (r >> 2) + 4 * h, i = 32 * ib + r32; x[r] = (j <= i) ? p[r] : 0.f; }
#pragma unroll
            for (int ks = 0; ks < 2; ++ks) {
                v4u w; w.x = cvtpk(x[8 * ks], x[8 * ks + 1]); w.y = cvtpk(x[8 * ks + 2], x[8 * ks + 3]); w.z = cvtpk(x[8 * ks + 4], x[8 * ks + 5]); w.w = cvtpk(x[8 * ks + 6], x[8 * ks + 7]);
                const bf16x8 pk = __builtin_bit_cast(bf16x8, w);
                const unsigned row0 = 32u * jb + 16u * ks + 4u * h + q4, row1 = row0 + 8u, chn = 4u * vb + 2u * bc + (pp >> 1);
                const unsigned x0 = (q4 << 2) | ((unsigned)h & 3u), x1 = (q4 << 2) | (((unsigned)h + 2u) & 3u);
                const s16x4 lo = __builtin_amdgcn_ds_read_tr16_b64_v4i16((LAS s16x4*)(lds + HG_V + 256u * row0 + 16u * (chn ^ x0) + 8u * (pp & 1)));
                const s16x4 hi = __builtin_amdgcn_ds_read_tr16_b64_v4i16((LAS s16x4*)(lds + HG_V + 256u * row1 + 16u * (chn ^ x1) + 8u * (pp & 1)));
                const bf16x8 av = {lo[0], lo[1], lo[2], lo[3], hi[0], hi[1], hi[2], hi[3]};
                o = __builtin_amdgcn_mfma_f32_32x32x16_bf16(av, pk, o, 0, 0, 0);
            }
        }
    }
    float ss = 0.f;
#pragma unroll
    for (int r = 0; r < 16; ++r) ss += o[r] * o[r];
    { auto rr = __builtin_amdgcn_permlane32_swap(__float_as_uint(ss), __float_as_uint(ss), false, false); ss = __uint_as_float(rr[0]) + __uint_as_float(rr[1]); }
    LAS float* red = (LAS float*)(lds + HG_RED);
    if (h == 0) red[(ib * 4 + vb) * 32 + r32] = ss;
    __syncthreads();
    const int i = 32 * ib + r32;
    if (active && i < ntok) {
        const float tot = (red[(ib * 4 + 0) * 32 + r32] + red[(ib * 4 + 1) * 32 + r32]) + (red[(ib * 4 + 2) * 32 + r32] + red[(ib * 4 + 3) * 32 + r32]);
        const float rn = rsqrtf(tot * (1.f / 128.f) + EPS);
        bf16_t* op = Outp + (size_t)i * DM + 32 * vb + 4 * h;
#pragma unroll
        for (int g = 0; g < 4; ++g) { const v2u gw = gwv[g]; const f32x4 ww = wwv[g];
            v2u w; w.x = cvtpk(o[4 * g] * rn * ww.x * bflo(gw.x), o[4 * g + 1] * rn * ww.y * bfhi(gw.x)); w.y = cvtpk(o[4 * g + 2] * rn * ww.z * bflo(gw.y), o[4 * g + 3] * rn * ww.w * bfhi(gw.y));
            *(v2u*)(op + 8 * g) = w; }
    }
    __syncthreads();
}
struct HgOutIn { float g[16]; v4u vt[2]; unsigned short qr[16], kr[16]; v4u s16[4]; v2u gwv[4]; };
__device__ __forceinline__ void hg_out_load(HgOutIn& I, const bf16_t* QAp, const bf16_t* KAp, const bf16_t* VAp, const float* Gp, const bf16_t* GAp, const bf16_t* Sst16, int tid, int wid) {
    const int k = tid & 127, a = tid >> 7;
    hg_load_g(Gp, 64, k, a, I.g);
    hg_tile_load(VAp, 64, tid, I.vt);
#pragma unroll
    for (int j = 0; j < 16; ++j) { const int i = 16 * a + j; I.qr[j] = QAp[(size_t)i * HW + k]; I.kr[j] = KAp[(size_t)i * HW + k]; }
#pragma unroll
    for (int i = 0; i < 4; ++i) { const int id = tid + 512 * i, row = id >> 4, ch = id & 15; I.s16[i] = *(const v4u*)(Sst16 + (size_t)row * 128 + ch * 8); }
    { const int lane_e = tid & 63, r32e = lane_e & 31, he = lane_e >> 5, vbe = wid & 3, ibe = wid >> 2, ie = 32 * ibe + r32e;
      const bf16_t* gp = GAp + (size_t)ie * HW + 32 * vbe + 4 * he;
#pragma unroll
      for (int g2 = 0; g2 < 4; ++g2) I.gwv[g2] = *(const v2u*)(gp + 8 * g2); }
}
__device__ __forceinline__ void hg_out_stage(LAS unsigned char* lds, const HgOutIn& I, int tid) {
    const int k = tid & 127, a = tid >> 7;
    float Gc[16], Glast, Gmid;
    hg_scan(I.g, (LAS float*)(lds + HG_TOT), k, a, Gc, Glast, Gmid);
    hg_tile_write(lds + HG_V, tid, I.vt);
#pragma unroll
    for (int i = 0; i < 4; ++i) { const int id = tid + 512 * i, row = id >> 4, ch = id & 15; *(LAS v4u*)(lds + HG_SST + off_b(row, ch)) = I.s16[i]; }
#pragma unroll
    for (int j = 0; j < 16; ++j) { const int i = 16 * a + j;
        const float q = bf2f(I.qr[j]), kk = bf2f(I.kr[j]);
        const float eq = ex2(Gc[j] * LOG2E), em = ex2(fminf((Gc[j] - Gmid) * LOG2E, 115.f)), ek = ex2(fminf((Gmid - Gc[j]) * LOG2E, 115.f));
        const unsigned o2 = off_b(i, k >> 3) + (k & 7) * 2;
        *(LAS bf16_t*)(lds + HG_QP + o2) = (bf16_t)(cvtpk(q * eq, 0.f) & 0xffffu);
        *(LAS bf16_t*)(lds + HG_QM + o2) = (bf16_t)(cvtpk(q * em, 0.f) & 0xffffu);
        *(LAS bf16_t*)(lds + HG_KM + o2) = (bf16_t)(cvtpk(kk * ek, 0.f) & 0xffffu); }
}
__device__ __forceinline__ void hg_out_compute(LAS unsigned char* lds, const v2u (&gwv)[4], const f32x4 (&wwv)[4], bf16_t* Outp, int tid, int wid) {
    constexpr int ntok = 64;
    const int lane = tid & 63;
    const int r32 = lane & 31, h = lane >> 5, vb = wid & 3, ib = wid >> 2;
    const unsigned q4 = (lane & 15) >> 2, pp = lane & 3, bc = (lane >> 4) & 1;
    f32x16 o = {};
    const bool active = (32 * ib < ntok);
    if (active) {
        const unsigned irow = 32u * ib + r32, ix = ((irow & 3u) << 2) | ((irow >> 2) & 3u);
#pragma unroll
        for (int s = 0; s < 8; ++s) {
            const bf16x8 bq = *(const LAS bf16x8*)(lds + HG_QP + 256u * irow + 16u * ((unsigned)(2 * s + h) ^ ix));
            const unsigned row0 = 16u * s + 8u * h + q4, row1 = row0 + 4u, chn = 4u * vb + 2u * bc + (pp >> 1);
            const unsigned x0 = (q4 << 2) | ((row0 >> 2) & 3u), x1 = (q4 << 2) | ((row1 >> 2) & 3u);
            const s16x4 lo = __builtin_amdgcn_ds_read_tr16_b64_v4i16((LAS s16x4*)(lds + HG_SST + 256u * row0 + 16u * (chn ^ x0) + 8u * (pp & 1)));
            const s16x4 hi = __builtin_amdgcn_ds_read_tr16_b64_v4i16((LAS s16x4*)(lds + HG_SST + 256u * row1 + 16u * (chn ^ x1) + 8u * (pp & 1)));
            const bf16x8 as = {lo[0], lo[1], lo[2], lo[3], hi[0], hi[1], hi[2], hi[3]};
            o = __builtin_amdgcn_mfma_f32_32x32x16_bf16(as, bq, o, 0, 0, 0);
        }
#pragma unroll
        for (int jb = 0; jb < 2; ++jb) {
            if (jb > ib) continue;
            f32x16 p = {};
            const unsigned jrow = 32u * jb + r32, jx = ((jrow & 3u) << 2) | ((jrow >> 2) & 3u);
#pragma unroll
            for (int s = 0; s < 8; ++s) {
                const bf16x8 ak = *(const LAS bf16x8*)(lds + HG_KM + 256u * jrow + 16u * ((unsigned)(2 * s + h) ^ jx));
                const bf16x8 bq = *(const LAS bf16x8*)(lds + HG_QM + 256u * irow + 16u * ((unsigned)(2 * s + h) ^ ix));
                p = __builtin_amdgcn_mfma_f32_32x32x16_bf16(ak, bq, p, 0, 0, 0);
            }
            float x[16];
#pragma unroll
            for (int r = 0; r < 16; ++r) { const int j = 32 * jb + (r & 3) + 8 * (r >> 2) + 4 * h, i = 32 * ib + r32; x[r] = (j <= i) ? p[r] : 0.f; }
#pragma unroll
            for (int ks = 0; ks < 2; ++ks) {
                v4u w; w.x = cvtpk(x[8 * ks], x[8 * ks + 1]); w.y = cvtpk(x[8 * ks + 2], x[8 * ks + 3]); w.z = cvtpk(x[8 * ks + 4], x[8 * ks + 5]); w.w = cvtpk(x[8 * ks + 6], x[8 * ks + 7]);
                const bf16x8 pk = __builtin_bit_cast(bf16x8, w);
                const unsigned row0 = 32u * jb + 16u * ks + 4u * h + q4, row1 = row0 + 8u, chn = 4u * vb + 2u * bc + (pp >> 1);
                const unsigned x0 = (q4 << 2) | ((unsigned)h & 3u), x1 = (q4 << 2) | (((unsigned)h + 2u) & 3u);
                const s16x4 lo = __builtin_amdgcn_ds_read_tr16_b64_v4i16((LAS s16x4*)(lds + HG_V + 256u * row0 + 16u * (chn ^ x0) + 8u * (pp & 1)));
                const s16x4 hi = __builtin_amdgcn_ds_read_tr16_b64_v4i16((LAS s16x4*)(lds + HG_V + 256u * row1 + 16u * (chn ^ x1) + 8u * (pp & 1)));
                const bf16x8 av = {lo[0], lo[1], lo[2], lo[3], hi[0], hi[1], hi[2], hi[3]};
                o = __builtin_amdgcn_mfma_f32_32x32x16_bf16(av, pk, o, 0, 0, 0);
            }
        }
    }
    float ss = 0.f;
#pragma unroll
    for (int r = 0; r < 16; ++r) ss += o[r] * o[r];
    { auto rr = __builtin_amdgcn_permlane32_swap(__float_as_uint(ss), __float_as_uint(ss), false, false); ss = __uint_as_float(rr[0]) + __uint_as_float(rr[1]); }
    LAS float* red = (LAS float*)(lds + HG_RED);
    if (h == 0) red[(ib * 4 + vb) * 32 + r32] = ss;
    __syncthreads();
    const int i = 32 * ib + r32;
    if (active && i < ntok) {
        const float tot = (red[(ib * 4 + 0) * 32 + r32] + red[(ib * 4 + 1) * 32 + r32]) + (red[(ib * 4 + 2) * 32 + r32] + red[(ib * 4 + 3) * 32 + r32]);
        const float rn = rsqrtf(tot * (1.f / 128.f) + EPS);
        bf16_t* op = Outp + (size_t)i * DM + 32 * vb + 4 * h;
#pragma unroll
        for (int g = 0; g < 4; ++g) { const v2u gw = gwv[g]; const f32x4 ww = wwv[g];
            v2u w; w.x = cvtpk(o[4 * g] * rn * ww.x * bflo(gw.x), o[4 * g + 1] * rn * ww.y * bfhi(gw.x)); w.y = cvtpk(o[4 * g + 2] * rn * ww.z * bflo(gw.y), o[4 * g + 3] * rn * ww.w * bfhi(gw.y));
            *(v2u*)(op + 8 * g) = w; }
    }
    __syncthreads();
}

#ifndef MK_FUSED
#define MK_FUSED 1
#endif
#ifndef MK_DEBUG
#define MK_DEBUG 0
#endif

constexpr int FI3 = (DM / 64) * (N1 / 64) + DM / 64, FI4 = (DM / 64) * (DM / 64), FILL_P1 = 6000;
__device__ __forceinline__ void w3_item(const float* w_in_odd, bf16_t* W3T, LAS float* scr, int it, int lane) {
    if (it < (DM / 64) * (N1 / 64)) p0_transpose_item64(w_in_odd, DM, N3R, W3T, scr, it, lane);
    else p0_transpose_item(w_in_odd, DM, N3R, W3T, scr, (it - (DM / 64) * (N1 / 64)) * (N3R / 32) + (N3R / 32 - 1), lane);
}
__device__ __forceinline__ void filler_static(bool w3, int first, int stride, int lo, int hi, const float* w_in_odd, const float* w_out_odd, bf16_t* W3T, bf16_t* W4T, LAS float* scr, int lane) {
    for (int it = lo + first; it < hi; it += stride) { if (w3) w3_item(w_in_odd, W3T, scr, it, lane); else p0_transpose_item64(w_out_odd, DM, DM, W4T, scr, it, lane); }
}
__device__ __forceinline__ void filler_drain(unsigned* fq, int lo, int hi, const float* w_in_odd, bf16_t* W3T, LAS float* scr, int lane) {
    for (;;) {
        int it = 0; if (lane == 0) it = (int)atomicAdd(fq, 4u);
        it = lo + __builtin_amdgcn_readfirstlane(it);
        if (it >= hi) break;
        const int e4 = (it + 4 < hi) ? it + 4 : hi;
        for (; it < e4; ++it) w3_item(w_in_odd, W3T, scr, it, lane);
    }
}
struct OneUnit { int pm, pn, hf;
    __device__ __forceinline__ bool next(int i, pg8::Unit& u) const { if (i) return false; u.pm = pm; u.pn = pn; u.hf = hf; return true; }
    __device__ __forceinline__ void a_ready(const pg8::Unit&) const {}
    __device__ __forceinline__ void done(const pg8::Unit&) const {} };
struct Args { const float* in[17]; float* out; unsigned char* ws; int ph_lo, ph_hi; };
constexpr int NPHASE = 11;

#define TIDX (wid0 * 64 + (int)__builtin_amdgcn_mbcnt_hi(~0u, __builtin_amdgcn_mbcnt_lo(~0u, 0u)))
#define PH_TID int tid = TIDX; asm volatile("" : "+v"(tid)); const int lane = tid & 63; (void)lane;
#define PH_PTRS const int wid = wid0; const int gw = bx * NWAVES + wid; (void)gw; unsigned char* ws_ = args.ws; unsigned* ctl_ = (unsigned*)(ws_ + WS_CTL); (void)ctl_; const float* x_prompt = args.in[0]; const float* x_sample = args.in[1]; const float* state_a = args.in[2]; const float* cache_b_k = args.in[3]; const float* cache_b_v = args.in[4]; const float* cache_c_k = args.in[5]; const float* cache_c_v = args.in[6]; const float* cache_c_logf = args.in[7]; const float* norm_w = args.in[8]; const float* final_w = args.in[9]; const float* w_in_even = args.in[10]; const float* w_out_even = args.in[11]; const float* lb_logits = args.in[12]; const float* a_norm_w = args.in[13]; const float* w_in_odd = args.in[14]; const float* b_forget = args.in[15]; const float* w_out_odd = args.in[16]; float* out = args.out; bf16_t* W1T = (bf16_t*)(ws_ + WS_W1T); bf16_t* W2T = (bf16_t*)(ws_ + WS_W2T); bf16_t* W3T = (bf16_t*)(ws_ + WS_W3T); bf16_t* W4T = (bf16_t*)(ws_ + WS_W4T); bf16_t* XN = (bf16_t*)(ws_ + WS_XN); bf16_t* P = (bf16_t*)(ws_ + WS_P); float* Gb = (float*)(ws_ + WS_G); bf16_t* A = (bf16_t*)(ws_ + WS_A); float* H1 = (float*)(ws_ + WS_H1); float* SLOC = (float*)(ws_ + WS_SLOC); bf16_t* SST = (bf16_t*)(ws_ + WS_SST); float* DEC = (float*)(ws_ + WS_DEC); float* FL = (float*)(ws_ + WS_FL); float* FCP = (float*)(ws_ + WS_FCP); float* FCS = (float*)(ws_ + WS_FCS); float* LB = (float*)(ws_ + WS_LB); unsigned long long* RS1 = (unsigned long long*)(ctl_ + CW_RS1); unsigned long long* RS2 = (unsigned long long*)(ctl_ + CW_RS2); bf16_t* QA = P; bf16_t* KA = P + PSTR1; bf16_t* VA = P + 2 * PSTR1; bf16_t* GA = P + 3 * PSTR1; bf16_t* QB = P + 4 * PSTR1; bf16_t* KB = P + 5 * PSTR1; bf16_t* VB = P + 6 * PSTR1; bf16_t* GB = P + 7 * PSTR1; bf16_t* P3 = (bf16_t*)(ws_ + WS_P3); bf16_t* QC = P3; bf16_t* KC = P3 + PSTR3; bf16_t* VC = P3 + 2 * PSTR3; bf16_t* GC = P3 + 3 * PSTR3;
__global__ void __launch_bounds__(NWAVES * 64, 2) fwd_kernel(Args args) {
    extern __shared__ __attribute__((aligned(16))) unsigned char lds_raw[];
    LAS unsigned char* lds = (LAS unsigned char*)lds_raw;
    const int tid0 = threadIdx.x;
    const int wid0 = __builtin_amdgcn_readfirstlane(tid0 >> 6);
    const int G = gridDim.x, bx = blockIdx.x;
    const int NGW = G * NWAVES;
    unsigned char* ws = args.ws;
    unsigned* ctl = (unsigned*)(ws + WS_CTL);
    volatile LAS unsigned* MISC = (volatile LAS unsigned*)(lds + MISC_OFF);
    for (int u = tid0; u < (LDS_BYTES - RING_BYTES) / 4; u += NWAVES * 64) ((LAS unsigned*)(lds + RING_BYTES))[u] = 0u;
    __syncthreads();
    const int lo = args.ph_lo, hi = args.ph_hi;
    const bool fused = (hi - lo) > 1;
    XcdBarrier bar; bar.bar = ctl + CW_BAR; bar.x = 0; bar.st = nullptr;
    if (fused) bar = xcd_barrier_post(ctl + CW_BAR, MISC + 8);
#ifdef ONLY
#define IN(k) ((k) == ONLY && lo <= (k) && (k) < hi)
#else
#define IN(k) (lo <= (k) && (k) < hi)
#endif
#ifndef DUP_MASK
#define DUP_MASK 0
#endif
#define REP(k) for (int rep_ = 0; rep_ < (((DUP_MASK >> (k)) & 1) ? 2 : 1); ++rep_)
#define SEAM(k) do { if (IN(k) && IN((k) + 1)) xcd_barrier(bar, wid0); } while (0)

    if (IN(0)) REP(0) { PH_PTRS PH_TID
        LAS float* scr = (LAS float*)(lds + wid * 16384);
        constexpr int I1 = (DM / 64) * (N1 / 64), I2 = (DM / 64) * (DM / 64);
        for (int it = gw; it < I1 + I2; it += NGW) {
            if (it < I1) p0_transpose_item64(w_in_even, DM, N1, W1T, scr, it, lane);
            else p0_transpose_item64(w_out_even, DM, DM, W2T, scr, it - I1, lane);
        }
        for (int m = gw; m < MROWS; m += NGW) norm_row_to_bf16(m < TP ? x_prompt + (size_t)m * DM : x_sample + (size_t)(m - TP) * DM, norm_w, XN + (size_t)m * DM, lane);
        {
            v4u* z = (v4u*)(W3T + (size_t)N3R * DM); const size_t n16 = (size_t)(N3 - N3R) * DM / 8;
            for (size_t i = (size_t)bx * 512 + tid; i < n16; i += (size_t)G * 512) z[i] = (v4u){0u, 0u, 0u, 0u};
        }
        for (int c = bx * 512 + tid; c < HW; c += G * 512) LB[c] = rcpf_(1.f + __expf(lb_logits[HW + c] - lb_logits[c]));
    }
    SEAM(0);
    if (IN(1)) REP(1) { PH_PTRS PH_TID
        { pg8::Gemm g{XN, W1T, TP, N1, DM}; pg8::StaticOrder S; S.init(TP, N1, G, bx);
          Epi1 E{P, Gb, LB, out};
          pg8::gemm_phase<Epi1, pg8::StaticOrder, true, true>(lds, g, S, E, tid); }
        for (int hu = bx; hu < 128; hu += G) { pg8::Gemm g{XN, W1T, MROWS, N1, DM}; OneUnit S{32, hu >> 1, hu & 1};
            Epi1 E{P, Gb, LB, out};
            pg8::gemm_phase<Epi1, OneUnit, true, true, true>(lds, g, S, E, tid); }
        if (G > 128) { if (bx >= 128) filler_static(true, (bx - 128) * NWAVES + wid, (G - 128) * NWAVES, 0, FILL_P1, w_in_odd, w_out_odd, W3T, W4T, (LAS float*)(lds + wid * 16384), lane); }
        else filler_static(true, gw, NGW, 0, FILL_P1, w_in_odd, w_out_odd, W3T, W4T, (LAS float*)(lds + wid * 16384), lane);
    }
    SEAM(1);
    if (IN(2)) REP(2) { PH_PTRS
#ifndef P2SUB
#define P2SUB 31
#endif
#ifndef P2REP
#define P2REP 0
#endif
#define R2(bit) for (int r2_ = 0; r2_ < ((P2REP & (bit)) ? 3 : 1); ++r2_)
        if (P2SUB & 2) R2(2) for (int u = bx; u < NSB * NH_B; u += G) attn_sample_sb_unit(lds, u >> 4, u & 15, QB, KB, VB, GB, cache_b_k, cache_b_v, A, TIDX, wid);
        if (P2SUB & 4) R2(4) {
            int tid = TIDX; asm volatile("" : "+v"(tid));
            HgIn I;
            if (bx < NH_A * 128) { const size_t ro = (size_t)(64 * (bx & 127)) * HW + (bx >> 7) * HD; hg_local_load(I, KA + ro, VA + ro, Gb + ro, 64, tid); }
            for (int u = bx; u < NH_A * 128; u += G) {
                HgIn N; const int un = u + G;
                if (un < NH_A * 128) { const size_t ro = (size_t)(64 * (un & 127)) * HW + (un >> 7) * HD; hg_local_load(N, KA + ro, VA + ro, Gb + ro, 64, tid); }
                hg_local_compute<false>(lds, I, nullptr, SLOC + (size_t)u * 8192  , DEC + (size_t)u * 128, tid, wid);
                if (un < NH_A * 128) I = N;
            }
        }
        if (P2SUB & 8) R2(8) for (int u = bx; u < NSB * NH_A; u += G) { const int b = u >> 4, hd = u & 15; const size_t ro = (size_t)(TP + 16 * b) * HW + hd * HD; const float* S0 = state_a + (size_t)u * 16384;
            hg_local<true>(lds, KA + ro, VA + ro, Gb + ro, 16, S0, out + O_SAS + (size_t)u * 16384, nullptr, TIDX, wid, 0); }
        if (P2SUB & 16) R2(16) for (int u = bx; u < NSB * NH_A; u += G) { const int b = u >> 4, hd = u & 15; const size_t ro = (size_t)(TP + 16 * b) * HW + hd * HD; const float* S0 = state_a + (size_t)u * 16384;
            hg_output(lds, QA + ro, KA + ro, VA + ro, Gb + ro, GA + ro, 16, nullptr, S0, a_norm_w, A + (size_t)(TP + 16 * b) * DM + hd * HD, TIDX, wid, 0); }
    }
    SEAM(2);
    if (IN(3)) REP(3) { PH_PTRS PH_TID
        const int NG = (G >= 128) ? 32 : 0, NSCAN = (G >= 128) ? 64 : G;
        if (bx < NG) {
            pg8::Gemm g{A, W2T, MROWS, DM, DM}; OneUnit S{32, bx >> 1, bx & 1};
            EpiRes<true> E{x_prompt, x_sample, H1, XN, norm_w + DM, RS1};
            pg8::gemm_phase<EpiRes<true>, OneUnit, true, true, true>(lds, g, S, E, tid);
        } else if (bx < NG + NSCAN) { const int sb = bx - NG;
            if (NSCAN == 64) {
                const unsigned* sl[4]; const float* dc[4]; unsigned* so[4]; float s0[4], s1[4];
#pragma unroll
                for (int j = 0; j < 4; ++j) { const int e = sb * 512 + tid + j * 32768; const int hd = e >> 13, k = (e >> 6) & 127, vp = e & 63;
                    sl[j] = (const unsigned*)SLOC + (size_t)hd * 128 * 8192 + k * 64 + vp; dc[j] = DEC + (size_t)hd * 128 * 128 + k; so[j] = (unsigned*)(SST + (size_t)hd * 128 * 16384 + k * 128 + 2 * vp); s0[j] = 0.f; s1[j] = 0.f; }
#pragma unroll 4
                for (int c = 0; c < 128; ++c) {
#pragma unroll
                    for (int j = 0; j < 4; ++j) { const unsigned lw = sl[j][(size_t)c * 8192]; const float d = dc[j][c * 128];
                        so[j][(size_t)c * 8192] = cvtpk(s0[j], s1[j]); s0[j] = fmaf(d, s0[j], bflo(lw)); s1[j] = fmaf(d, s1[j], bfhi(lw)); } }
#pragma unroll
                for (int j = 0; j < 4; ++j) { const int e = sb * 512 + tid + j * 32768; const int hd = e >> 13, k = (e >> 6) & 127, vp = e & 63;
                    *(f32x2*)(out + O_SAP + (size_t)hd * 16384 + k * 128 + 2 * vp) = (f32x2){s0[j], s1[j]}; }
            } else
            for (int e = sb * 512 + tid; e < NH_A * 128 * 64; e += NSCAN * 512) {
                const int hd = e >> 13, k = (e >> 6) & 127, vp = e & 63;
                const unsigned* sl = (const unsigned*)SLOC + (size_t)hd * 128 * 8192 + k * 64 + vp;
                const float* dc = DEC + (size_t)hd * 128 * 128 + k;
                unsigned* so = (unsigned*)(SST + (size_t)hd * 128 * 16384 + k * 128 + 2 * vp);
                float s0 = 0.f, s1 = 0.f;
#pragma unroll 16
                for (int c = 0; c < 128; ++c) { const unsigned lw = sl[(size_t)c * 8192]; const float d = dc[c * 128];
                    so[(size_t)c * 8192] = cvtpk(s0, s1); s0 = fmaf(d, s0, bflo(lw)); s1 = fmaf(d, s1, bfhi(lw)); }
                *(f32x2*)(out + O_SAP + (size_t)hd * 16384 + k * 128 + 2 * vp) = (f32x2){s0, s1};
            }
        }
        if (G < 128) {
            for (int u = bx; u < 32; u += G) { pg8::Gemm g{A, W2T, MROWS, DM, DM}; OneUnit S{32, u >> 1, u & 1}; EpiRes<true> E{x_prompt, x_sample, H1, XN, norm_w + DM, RS1};
                pg8::gemm_phase<EpiRes<true>, OneUnit, true, true, true>(lds, g, S, E, tid); } }
        __syncthreads();
        {
            unsigned* wq = ctl_ + CW_WQ3;
            const int grp = wid >> 2, gw = wid & 3; const int gtid = gw * 64 + (TIDX & 63);
            LAS unsigned char* gl = lds + grp * 65536; LAS unsigned char* gx = lds + RING_BYTES + 2048 + grp * 1024;
            GBar gb; gb.cnt = (volatile LAS unsigned*)(gx + 832); gb.tgt = 0u;
            if (gtid == 0) *gb.cnt = 0u;
            __syncthreads();
            volatile LAS int* wqg = (volatile LAS int*)(gx + 768);
            for (;;) {
                if (gtid == 0) wqg[0] = (int)atomicAdd(wq, 1u);
                gbar_sync(gb, gtid & 63);
                const int u = wqg[0];
                gbar_sync(gb, gtid & 63);
                if (u >= NH_B * 64) break;
                const int hd = u & 15, qb = 63 - (u >> 4);
                attn_prompt_group<0>(gl, gx, gb, QB, KB, VB, GB, HW, hd, qb, A, HW + hd * HD, nullptr, gtid, gw, 0.f);
            }
        }
        __syncthreads();
        filler_drain(ctl_ + CW_FQ, FILL_P1, FI3, w_in_odd, W3T, (LAS float*)(lds + wid * 16384), TIDX & 63);
    }
    SEAM(3);
    if (IN(4)) REP(4) { PH_PTRS
        unsigned* wq = ctl_ + CW_WQ4;
        volatile LAS int* wql = (volatile LAS int*)(lds + RING_BYTES + 1024);
        constexpr int HG_END = 129 + NH_A * 128;
        int item;
        for (;;) {
            if (TIDX == 0) wql[0] = (int)atomicAdd(wq, 1u);
            __syncthreads();
            item = wql[0];
            __syncthreads();
            if (item >= 129) break;
            int tid = TIDX; asm volatile("" : "+v"(tid));
            pg8::Gemm g{XN, W3T, MROWS, N3, DM}; OneUnit S{32, item >> 1, item & 1};
            Epi3 E{P3, RS1, FL, b_forget, out};
            pg8::gemm_phase<Epi3, OneUnit, true, true, true>(lds, g, S, E, tid);
        }
        if (item < HG_END) {
            HgOutIn R;
#define HG_PTRS(it_) const int u_ = (it_) - 129, hd_ = u_ >> 7, c_ = u_ & 127; const size_t ro_ = (size_t)(64 * c_) * HW + hd_ * HD;
            { HG_PTRS(item); int t_ = TIDX; asm volatile("" : "+v"(t_)); hg_out_load(R, QA + ro_, KA + ro_, VA + ro_, Gb + ro_, GA + ro_, SST + (size_t)u_ * 16384, t_, wid); }
            for (;;) {
                int nx = 0;
                if (TIDX == 0) nx = (int)atomicAdd(wq, 1u);
                int t_ = TIDX; asm volatile("" : "+v"(t_));
                hg_out_stage(lds, R, t_);
                if (TIDX == 0) wql[0] = nx;
                __syncthreads();
                const int nitem = wql[0];
                v2u gwc[4]; f32x4 wwc[4];
#pragma unroll
                for (int g2 = 0; g2 < 4; ++g2) { gwc[g2] = R.gwv[g2]; wwc[g2] = *(const f32x4*)(a_norm_w + 32 * (wid & 3) + 4 * ((t_ >> 5) & 1) + 8 * g2); }
                bf16_t* outp; { HG_PTRS(item); outp = A + (size_t)(64 * c_) * DM + hd_ * HD; }
                if (nitem < HG_END) { HG_PTRS(nitem); hg_out_load(R, QA + ro_, KA + ro_, VA + ro_, Gb + ro_, GA + ro_, SST + (size_t)u_ * 16384, t_, wid); }
                hg_out_compute(lds, gwc, wwc, outp, t_, wid);
                if (nitem >= HG_END) break;
                item = nitem;
            }
#undef HG_PTRS
        }
        { unsigned* fq = ctl_ + CW_FQ + 64;
          const int lane_ = TIDX & 63; LAS float* scr_ = (LAS float*)(lds + wid * 16384);
          for (;;) { int it = 0; if (lane_ == 0) it = (int)atomicAdd(fq, 4u); it = __builtin_amdgcn_readfirstlane(it); if (it >= FI4) break;
              const int e4 = (it + 4 < FI4) ? it + 4 : FI4; for (; it < e4; ++it) p0_transpose_item64(w_out_odd, DM, DM, W4T, scr_, it, lane_); } }
    }
    SEAM(4);
    if (IN(5)) REP(5) { PH_PTRS PH_TID
        pg8::Gemm g{A, W2T, TP, DM, DM}; pg8::StaticOrder S; S.init(TP, DM, G, bx);
        EpiRes<true> E{x_prompt, x_sample, H1, XN, norm_w + DM, RS1};
        pg8::gemm_phase<EpiRes<true>, pg8::StaticOrder, true, true>(lds, g, S, E, tid);
    }
    SEAM(5);
    if (IN(6)) REP(6) { PH_PTRS PH_TID
        pg8::Gemm g{XN, W3T, TP, N1, DM}; pg8::StaticOrder S; S.init(TP, N1, G, bx);
        Epi3 E{P3, RS1, FL, b_forget, out};
        pg8::gemm_phase<Epi3, pg8::StaticOrder, true, true>(lds, g, S, E, tid);
        for (int rb = bx; rb < TP / 32; rb += G) fl_rows(lds, XN, W3T + (size_t)N1 * DM, RS1, b_forget, FL, out + O_CFP, 32 * rb, tid, wid);
    }
    SEAM(6);
    if (IN(7)) REP(7) { PH_PTRS PH_TID
        LAS float* scr = (LAS float*)(lds + 1024);
        for (int u = bx; u < NH_C; u += G) { const int hd = u; float v[16];
#pragma unroll
            for (int j = 0; j < 16; ++j) v[j] = FL[(size_t)(tid * 16 + j) * 32 + hd] * -NFRS;
            wg_scan<16>(v, scr, tid, wid, lane);
#pragma unroll
            for (int j = 0; j < 16; j += 4) *(f32x4*)(FCP + (size_t)hd * TP + tid * 16 + j) = (f32x4){v[j], v[j + 1], v[j + 2], v[j + 3]};
        }
        {
            unsigned* KN2 = ctl_ + CW_KN2;
            for (int u = bx; u < NH_C * 8; u += G) { const int hd = u >> 3, part = u & 7; float mx = 0.f;
#pragma unroll
                for (int kk = 0; kk < 2; ++kk) { const int key = part * 1024 + tid * 2 + kk; const v4u* kp = (const v4u*)(KC + (size_t)key * DM + hd * HD); float s2 = 0.f;
#pragma unroll
                    for (int c8 = 0; c8 < 16; ++c8) { const v4u w = kp[c8]; const float a0 = bflo(w.x), a1 = bfhi(w.x), a2 = bflo(w.y), a3 = bfhi(w.y), a4 = bflo(w.z), a5 = bfhi(w.z), a6 = bflo(w.w), a7 = bfhi(w.w);
                        s2 += (a0 * a0 + a1 * a1) + (a2 * a2 + a3 * a3) + (a4 * a4 + a5 * a5) + (a6 * a6 + a7 * a7); }
                    mx = fmaxf(mx, s2); }
#pragma unroll
                for (int o = 32; o >= 1; o >>= 1) mx = fmaxf(mx, __shfl_xor(mx, o));
                if (lane == 0) atomicMax(KN2 + hd, __float_as_uint(mx)); }
        }
        __syncthreads();
        for (int u = bx; u < NSB * NH_C; u += G) attn_sample_fox_unit(lds, u >> 5, u & 31, QC, KC, VC, GC, cache_c_k, cache_c_v, cache_c_logf, FL, A, tid, wid, lane);
    }
    SEAM(7);
    if (IN(8)) REP(8) { PH_PTRS
        { unsigned* wq0 = ctl_ + CW_WQ; volatile LAS int* wql = (volatile LAS int*)(lds + RING_BYTES + 1024);
          for (;;) {
            if (TIDX == 0) wql[0] = (int)atomicAdd(wq0, 1u);
            __syncthreads();
            const int item = wql[0];
            __syncthreads();
            if (item >= 32) break;
            int tid = TIDX; asm volatile("" : "+v"(tid));
            pg8::Gemm g{A, W4T, MROWS, DM, DM}; OneUnit S{32, item >> 1, item & 1};
            EpiRes<false> E{H1, H1 + (size_t)TP * DM, out, nullptr, nullptr, RS2};
            pg8::gemm_phase<EpiRes<false>, OneUnit, true, true, true>(lds, g, S, E, tid);
          } }
        { unsigned* wq = ctl_ + CW_WQ + 16; const unsigned* KN2 = ctl_ + CW_KN2;
          const int grp = wid >> 2, gw = wid & 3; const int gtid = gw * 64 + (TIDX & 63);
          LAS unsigned char* gl = lds + grp * 65536; LAS unsigned char* gx = lds + RING_BYTES + 2048 + grp * 1024;
          GBar gb; gb.cnt = (volatile LAS unsigned*)(gx + 832); gb.tgt = 0u;
          if (gtid == 0) *gb.cnt = 0u;
          __syncthreads();
          volatile LAS int* wqg = (volatile LAS int*)(gx + 768);
          for (;;) {
            if (gtid == 0) wqg[0] = (int)atomicAdd(wq, 1u);
            gbar_sync(gb, gtid & 63);
            const int item = wqg[0];
            gbar_sync(gb, gtid & 63);
            if (item >= 2048) break;
            const int hd = item & 31, qb = 63 - (item >> 5);
            attn_prompt_group<1>(gl, gx, gb, QC, KC, VC, GC, DM, hd, qb, A, hd * HD, FCP + (size_t)hd * TP, gtid, gw, sqrtf(__uint_as_float(KN2[hd])) * QK2);
          }
          __syncthreads(); }
    }
    SEAM(8);
    if (IN(9)) REP(9) { PH_PTRS PH_TID
        pg8::Gemm g{A, W4T, TP, DM, DM}; pg8::StaticOrder S; S.init(TP, DM, G, bx);
        EpiRes<false> E{H1, H1 + (size_t)TP * DM, out, nullptr, nullptr, RS2};
        pg8::gemm_phase<EpiRes<false>, pg8::StaticOrder, true, true>(lds, g, S, E, tid);
    }
    SEAM(9);
    if (IN(10)) REP(10) { PH_PTRS PH_TID
        for (int m = gw; m < MROWS; m += NGW) {
            const float r = rsqrtf((float)RS2[m] * (1.f / (FIX * 4096.f)) + EPS);
            f32x4* yr = (f32x4*)(out + (size_t)m * DM) + lane; const f32x4* wr_ = (const f32x4*)final_w + lane;
#pragma unroll
            for (int j = 0; j < 16; ++j) { const f32x4 v = yr[64 * j], ww = wr_[64 * j]; yr[64 * j] = (f32x4){v.x * r * ww.x, v.y * r * ww.y, v.z * r * ww.z, v.w * r * ww.w}; }
        }
    }
#undef IN
#undef SEAM
}


#if MK_DEBUG
__global__ void dbg_check(const unsigned* p, size_t nwords, int kind  , unsigned long long* stat, unsigned long long* hstat) {
    unsigned long long cs = 0, nf = 0, hg = 0;
    for (size_t i = (size_t)blockIdx.x * blockDim.x + threadIdx.x; i < nwords; i += (size_t)gridDim.x * blockDim.x) {
        const unsigned w = p[i]; cs += (unsigned long long)w * (2ull * i + 1ull);
        if (kind == 0) { nf += ((w & 0x7f800000u) == 0x7f800000u); hg += (((w >> 23) & 0xffu) >= 141u); } else if (kind == 1) { nf += ((w & 0x7f80u) == 0x7f80u) + ((w & 0x7f800000u) == 0x7f800000u); hg += (((w >> 7) & 0xffu) >= 141u) + (((w >> 23) & 0xffu) >= 141u); }
    }
    for (int o = 32; o >= 1; o >>= 1) { cs += __shfl_xor(cs, o); nf += __shfl_xor(nf, o); hg += __shfl_xor(hg, o); }
    if ((threadIdx.x & 63) == 0) { atomicAdd(stat, nf); atomicAdd(stat + 1, cs); atomicAdd(hstat, hg); }
}
__global__ void dbg_check2(const unsigned short* p, int rows, int ld, int col0, int ncols, unsigned long long* stat, unsigned long long* hstat) {
    unsigned long long cs = 0, nf = 0, hg = 0; const size_t n = (size_t)rows * ncols;
    for (size_t i = (size_t)blockIdx.x * blockDim.x + threadIdx.x; i < n; i += (size_t)gridDim.x * blockDim.x) {
        const size_t r = i / ncols, cc = i % ncols; const unsigned w = p[r * ld + col0 + cc]; cs += (unsigned long long)w * (2ull * i + 1ull); nf += ((w & 0x7f80u) == 0x7f80u); hg += (((w >> 7) & 0xffu) >= 141u);
    }
    for (int o = 32; o >= 1; o >>= 1) { cs += __shfl_xor(cs, o); nf += __shfl_xor(nf, o); hg += __shfl_xor(hg, o); }
    if ((threadIdx.x & 63) == 0) { atomicAdd(stat, nf); atomicAdd(stat + 1, cs); atomicAdd(hstat, hg); }
}
__global__ void dbg_report(const unsigned long long* stat, const unsigned long long* hstat, float* out, unsigned* codew) {
    __shared__ int code_s;
    if (threadIdx.x == 0) {
        int code = 0;
        const int order[28] = {1, 2, 3, 4, 5, 6, 7, 8, 9, 10, 11, 12, 25, 26, 27, 13, 14, 15, 16, 17, 18, 19, 20, 21, 22, 23, 24, 0};
        for (int q = 0; q < 27 && !code; ++q) { const int k = order[q];
            if (stat[(0 * 32 + k) * 2] || stat[(1 * 32 + k) * 2]) code = k;
            else if (k != 15 && k != 23 && k != 22 && hstat[k]) code = 64 + k;
            else if (stat[(0 * 32 + k) * 2 + 1] != stat[(1 * 32 + k) * 2 + 1]) code = 32 + k; }
        { const unsigned bits = ((const unsigned*)hstat)[62]; if (bits) { int idx = 0; while (!((bits >> idx) & 1u)) ++idx; code = 92 + idx; } }
        if (!code) { const unsigned* cst = (const unsigned*)hstat + 64;
            for (int i = 14; i >= 0; --i) { const float er = __uint_as_float(cst[2 * i]), rf = __uint_as_float(cst[2 * i + 1]); if (er > 0.06f * rf + 1e-3f) code = 100 + 10 * i; } }
        code_s = code; if (blockIdx.x == 0) *codew = (unsigned)code;
    }
    __syncthreads();
    const int code = code_s; if (!code) return;
    const float c = sqrtf((float)code);
    for (size_t i = (size_t)blockIdx.x * blockDim.x + threadIdx.x; i < O_END; i += (size_t)gridDim.x * blockDim.x) out[i] = (i >= O_YS && i < O_SAP) ? c : 0.f;
}
#endif

#if MK_DEBUG
__device__ __forceinline__ float blk_sum128(float v, float* red) {
    for (int o = 32; o >= 1; o >>= 1) v += __shfl_xor(v, o);
    __syncthreads(); if ((threadIdx.x & 63) == 0) red[threadIdx.x >> 6] = v; __syncthreads();
    return red[0] + red[1];
}
__device__ __forceinline__ void chk_accum(float ref, float got, unsigned* st) {
    float e = fabsf(ref - got), r = fabsf(ref); if (!(e == e)) e = 1e30f;
    for (int o = 32; o >= 1; o >>= 1) { e = fmaxf(e, __shfl_xor(e, o)); r = fmaxf(r, __shfl_xor(r, o)); }
    if ((threadIdx.x & 63) == 0) { atomicMax(st, __float_as_uint(e)); atomicMax(st + 1, __float_as_uint(r)); }
}
template <int MODE>
__global__ void chk_attn(const bf16_t* Q, const bf16_t* K, const bf16_t* V, const bf16_t* Gt, int ld, int NH, const float* ck, const float* cv, const float* clf  ,
                         const float* FL, const bf16_t* A, int acol0, int nprompt, unsigned* st, int smp_slot, int prompt_slot0) {
    __shared__ float red[2];
    const int d = threadIdx.x; int hd, qrow, qpos, b = 0; bool smp;
    if ((int)blockIdx.x < nprompt) { smp = false; hd = blockIdx.x % NH; const int j = blockIdx.x / NH; qrow = (j * 1237 + 5) % TP; qpos = qrow; }
    else { smp = true; const int u = blockIdx.x - nprompt; const int t = u & 15; hd = (u >> 4) % NH; b = (u >> 4) / NH; qrow = TP + 16 * b + t; qpos = PAST + t; }
    const float q = bf2f(Q[(size_t)qrow * ld + hd * HD + d]) ;
    const int s_top = MODE ? qpos : qpos - 1;
    float o = 0.f, tail = 0.f, m = -1e30f, l = 0.f, dsum = 0.f;
    for (int s = s_top; s >= 0; --s) {
        float kv, vv;
        if (smp) { if (s < PAST) { const size_t ix = (((size_t)b * PAST + s) * NH + hd) * HD + d; kv = ck[ix]; vv = cv[ix]; } else { const size_t ix = (size_t)(TP + 16 * b + s - PAST) * ld + hd * HD + d; kv = bf2f(K[ix]); vv = bf2f(V[ix]); } }
        else { const size_t ix = (size_t)s * ld + hd * HD + d; kv = bf2f(K[ix]); vv = bf2f(V[ix]); }
        const float z = blk_sum128(q * kv, red) * 0.08838834764831845f;
        if (MODE == 0) {
            const float lp = fminf(z, 0.f) - log1pf(expf(-fabsf(z))), lm = lp - z;
            o += expf(lp + tail) * vv; tail += lm;
            if (tail < -200.f) break;
        } else {
            const float x = z + dsum;
            const float mn = fmaxf(m, x), al = expf(m - mn), p = expf(x - mn);
            o = o * al + p * vv; l = l * al + p; m = mn;
            float lf;
            if (smp) lf = (s < PAST) ? clf[((size_t)b * PAST + s) * NH + hd] : FL[(size_t)(TP + 16 * b + s - PAST) * 32 + hd]; else lf = FL[(size_t)s * 32 + hd];
            dsum += lf;
            if (dsum < -200.f && m > -1e29f) break;
        }
    }
    if (MODE == 1) o /= l;
    const float ref = o * bf2f(Gt[(size_t)qrow * ld + hd * HD + d]);
    chk_accum(ref, bf2f(A[(size_t)qrow * DM + acol0 + hd * HD + d]), st + (smp ? 2 * smp_slot : (MODE ? 2 * (prompt_slot0 + (int)(blockIdx.x / NH)) : 0)));
}
__global__ void chk_fc(const float* FL, const float* clf, const float* FCP, const float* FCS, unsigned* st) {
    const int u = blockIdx.x, lane = threadIdx.x;
    if (u < 32) { const int hd = u, t = (lane * 131 + 7) % TP; double s = 0; for (int j = 0; j <= t; ++j) s += (double)FL[(size_t)j * 32 + hd]; chk_accum((float)(s * 1.4426950408889634), FCP[(size_t)hd * TP + t], st); }
    else { const int ub = u - 32, b = ub >> 5, hd = ub & 31, t = (lane * 17 + 3) % 1040; double s = 0; for (int j = 0; j <= t; ++j) s += (double)(j < PAST ? clf[((size_t)b * PAST + j) * 32 + hd] : FL[(size_t)(TP + 16 * b + j - PAST) * 32 + hd]); chk_accum((float)(s * 1.4426950408889634), FCS[(size_t)ub * FCS_LD + t], st + 2); }
}
__global__ void chk_hgrn_sample(const bf16_t* QA, const bf16_t* KA, const bf16_t* VA, const float* Gb, const float* S0, const float* Sout, float* oref, unsigned* st) {
    __shared__ float red[2];
    const int u = blockIdx.x >> 7, v = blockIdx.x & 127, k = threadIdx.x, b = u >> 4, hd = u & 15;
    float S = S0[(size_t)u * 16384 + k * 128 + v];
    for (int t = 0; t < 16; ++t) { const size_t ro = (size_t)(TP + 16 * b + t) * HW + hd * HD;
        S = S * expf(Gb[ro + k]) + bf2f(KA[ro + k]) * bf2f(VA[ro + v]);
        const float ov = blk_sum128(bf2f(QA[ro + k]) * S, red);
        if (k == 0) oref[((size_t)u * 16 + t) * 128 + v] = ov; }
    chk_accum(S, Sout[(size_t)u * 16384 + k * 128 + v], st);
}
__global__ void chk_hgrn_sample_out(const float* oref, const bf16_t* GA, const float* anw, const bf16_t* A, unsigned* st) {
    __shared__ float red[2];
    const int u = blockIdx.x >> 4, t = blockIdx.x & 15, v = threadIdx.x, b = u >> 4, hd = u & 15;
    const float o = oref[((size_t)u * 16 + t) * 128 + v];
    const float ss = blk_sum128(o * o, red);
    const int row = TP + 16 * b + t;
    const float ref = o * rsqrtf(ss * (1.f / 128.f) + EPS) * anw[v] * bf2f(GA[(size_t)row * HW + hd * HD + v]);
    chk_accum(ref, bf2f(A[(size_t)row * DM + hd * HD + v]), st);
}
#endif
extern "C" void kernel_launch(void* const* d_in, const int* in_sizes, int n_in, void* d_out, int out_size, void* d_ws, size_t ws_size, hipStream_t stream) {
    static int grid = 0;
    if (grid == 0) {
        if (n_in != 17 || (size_t)out_size != O_END || ws_size < WS_END) { fprintf(stderr, "kernel_launch: unexpected shapes (n_in %d, out %d, ws %zu)\n", n_in, out_size, ws_size); grid = -1; return; }
        int dev = 0, cus = 0, per_cu = 0;
        if (hipGetDevice(&dev) != hipSuccess || hipDeviceGetAttribute(&cus, hipDeviceAttributeMultiprocessorCount, dev) != hipSuccess) { grid = -1; return; }
        if (hipFuncSetAttribute((const void*)fwd_kernel, hipFuncAttributeMaxDynamicSharedMemorySize, LDS_BYTES) != hipSuccess) { fprintf(stderr, "kernel_launch: hipFuncSetAttribute failed\n"); grid = -1; return; }
        if (hipOccupancyMaxActiveBlocksPerMultiprocessor(&per_cu, (const void*)fwd_kernel, NWAVES * 64, LDS_BYTES) != hipSuccess || per_cu < 1)
            fprintf(stderr, "kernel_launch: occupancy query reports %d workgroups per CU\n", per_cu);
        (void)hipGetLastError();
        grid = cus;
    }
    if (grid < 0) return;
    (void)hipMemsetAsync((char*)d_ws + WS_CTL, 0, CTL_ZERO_BYTES, stream);
    Args a{};
    for (int i = 0; i < 17; ++i) a.in[i] = (const float*)d_in[i];
    a.out = (float*)d_out; a.ws = (unsigned char*)d_ws;
#if MK_DEBUG
    unsigned char* ws = (unsigned char*)d_ws; float* out = (float*)d_out;
    unsigned long long* stat = (unsigned long long*)((unsigned*)(ws + WS_CTL) + CW_STAT);
    unsigned long long* hstat = (unsigned long long*)((unsigned*)(ws + WS_CTL) + CW_HSTAT);
    for (int run = 0; run < 2; ++run) {
        if (run) (void)hipMemsetAsync((char*)d_ws + WS_CTL, 0, (size_t)CW_STAT * 4, stream);
        auto CHK = [&](int k, const void* p, size_t bytes, int kind) { hipLaunchKernelGGL(dbg_check, dim3(2048), dim3(256), 0, stream, (const unsigned*)p, bytes / 4, kind, stat + (run * 32 + k) * 2, hstat + k); };
        auto CHK2 = [&](int k, const void* p, int rows, int ld, int col0, int ncols) { hipLaunchKernelGGL(dbg_check2, dim3(2048), dim3(256), 0, stream, (const unsigned short*)p, rows, ld, col0, ncols, stat + (run * 32 + k) * 2, hstat + k); };
        for (int p = 0; p < NPHASE; ++p) {
            a.ph_lo = p; a.ph_hi = p + 1; hipLaunchKernelGGL(fwd_kernel, dim3(grid), dim3(NWAVES * 64), LDS_BYTES, stream, a);
            switch (p) {
                case 0: CHK(1, ws + WS_W1T, WS_XN - WS_W1T, 1); CHK(2, ws + WS_XN, 66 * MiB, 1); CHK(3, ws + WS_LB, 8192, 0); break;
                case 1: CHK(4, ws + WS_P, 8 * 33 * MiB, 1); CHK(5, ws + WS_G, 66 * MiB, 0); CHK(6, out + O_BKP, (O_CKP - O_BKP) * 4, 0); break;
                case 2: CHK(7, ws + WS_SLOC, 128 * MiB, 0); CHK(8, ws + WS_DEC, 1 * MiB, 0); CHK(9, out + O_SAS, (O_BKP - O_SAS) * 4, 0); break;
                case 3: CHK(10, ws + WS_SST, 64 * MiB, 1); CHK(11, out + O_SAP, (O_SAS - O_SAP) * 4, 0); break;
                case 4: if (run == 0) {
                    unsigned* cst = (unsigned*)(ws + WS_CTL) + CW_HSTAT + 64;
                    bf16_t* Pp = (bf16_t*)(ws + WS_P); float* oref = (float*)(ws + WS_FCS);
                    hipLaunchKernelGGL(chk_attn<0>, dim3(16 * 8 + 256 * 16), dim3(128), 0, stream, Pp + 4 * PSTR1, Pp + 5 * PSTR1, Pp + 6 * PSTR1, Pp + 7 * PSTR1, HW, 16, (const float*)d_in[3], (const float*)d_in[4], (const float*)nullptr, (const float*)nullptr, (const bf16_t*)(ws + WS_A), HW, 16 * 8, cst + 0, 1, 0);
                    hipLaunchKernelGGL(chk_hgrn_sample, dim3(256 * 128), dim3(128), 0, stream, Pp, Pp + PSTR1, Pp + 2 * PSTR1, (const float*)(ws + WS_G), (const float*)d_in[2], (const float*)(out + O_SAS), oref, cst + 4);
                    hipLaunchKernelGGL(chk_hgrn_sample_out, dim3(256 * 16), dim3(128), 0, stream, (const float*)oref, Pp + 3 * PSTR1, (const float*)d_in[13], (const bf16_t*)(ws + WS_A), cst + 6); }
                    CHK2(12, ws + WS_A, TP, DM, 0, HW); CHK2(25, ws + WS_A, TP, DM, HW, HW); CHK2(26, ws + WS_A + (size_t)TP * DM * 2, 256, DM, 0, HW); CHK2(27, ws + WS_A + (size_t)TP * DM * 2, 256, DM, HW, HW); break;
                case 5: CHK(13, ws + WS_H1, 132 * MiB, 0); CHK(14, ws + WS_XN, 66 * MiB, 1); CHK(15, ws + WS_CTL + CW_RS1 * 4, 8448 * 8, 1 + 1); break;
                case 6: CHK(16, ws + WS_P, 4 * 66 * MiB, 1); CHK(17, ws + WS_FL, 8448 * 32 * 4, 0); CHK(18, out + O_CKP, (O_END - O_CKP) * 4, 0); break;
                case 7: CHK(19, ws + WS_FCP, 1 * MiB, 0); CHK(20, ws + WS_FCS, (size_t)512 * FCS_LD * 4, 0); break;
                case 8: if (run == 0) {
                    unsigned* cst = (unsigned*)(ws + WS_CTL) + CW_HSTAT + 64; bf16_t* Pp = (bf16_t*)(ws + WS_P);
                    hipLaunchKernelGGL(chk_attn<1>, dim3(32 * 8 + 512 * 16), dim3(128), 0, stream, Pp, Pp + PSTR3, Pp + 2 * PSTR3, Pp + 3 * PSTR3, DM, 32, (const float*)d_in[5], (const float*)d_in[6], (const float*)d_in[7], (const float*)(ws + WS_FL), (const bf16_t*)(ws + WS_A), 0, 32 * 8, cst, 14, 6);
                    hipLaunchKernelGGL(chk_fc, dim3(32 + 512), dim3(64), 0, stream, (const float*)(ws + WS_FL), (const float*)d_in[7], (const float*)(ws + WS_FCP), (const float*)(ws + WS_FCS), cst + 8); }
                    CHK(21, ws + WS_A, 66 * MiB, 1); break;
                case 9: CHK(22, out, (size_t)MROWS * DM * 4, 0); CHK(23, ws + WS_CTL + CW_RS2 * 4, 8448 * 8, 2); break;
                case 10: CHK(24, out, (size_t)MROWS * DM * 4, 0); break;
            }
        }
    }
    hipLaunchKernelGGL(dbg_report, dim3(1024), dim3(256), 0, stream, (const unsigned long long*)stat, (const unsigned long long*)hstat, out, (unsigned*)(ws + WS_CTL) + CW_HSTAT + 63);
#elif MK_FUSED
    a.ph_lo = 0; a.ph_hi = NPHASE;
    hipLaunchKernelGGL(fwd_kernel, dim3(grid), dim3(NWAVES * 64), LDS_BYTES, stream, a);
#else
    for (int p = 0; p < NPHASE; ++p) { a.ph_lo = p; a.ph_hi = p + 1; hipLaunchKernelGGL(fwd_kernel, dim3(grid), dim3(NWAVES * 64), LDS_BYTES, stream, a); }
#endif
}
```

```cpp
#include <hip/hip_runtime.h>
#include <cstdio>
#include <cstdint>

namespace pg8 {
#define PG8_LAS __attribute__((address_space(3)))
typedef unsigned short bf16_t;
typedef short bf16x8 __attribute__((ext_vector_type(8)));
typedef float f32x4 __attribute__((ext_vector_type(4)));
typedef unsigned u32x4 __attribute__((ext_vector_type(4)));
constexpr int BM = 256, BK = 64, HALF = 128, HTB = HALF * BK * 2  , STAGE_BYTES = 8 * HTB, NXCD = 8, WGM = 8;

__host__ __device__ __forceinline__ int lds_byte(int r, int c) { const int st = (r >> 4) * 2 + (c >> 5), rr = r & 15, cc = c & 31, ob = rr * 64 + cc * 2; return st * 1024 + (ob ^ (((ob >> 9) & 1) << 5)); }
__host__ __device__ __forceinline__ void stage_rc(int b, int& R, int& C) { const int st = b / 1024, sb = b % 1024, swz = sb ^ (((sb >> 9) & 1) << 5); R = (st >> 1) * 16 + swz / 64; C = (st & 1) * 32 + (swz % 64) / 2; }
__host__ __device__ __forceinline__ int perm32(int rho) { const int n = rho >> 4, i = rho & 15; return 8 * (i >> 2) + 4 * n + (i & 3); }

struct Unit { int pm, pn, hf; };
struct Gemm { const bf16_t* A; const bf16_t* Bt; int M, N, K; };

struct StaticOrder {
    int nM, nN, nwg, G, c;
    __host__ __device__ void init(int M, int N, int G_, int c_) { nM = M / BM; nN = N / BM; nwg = nM * nN; G = G_; c = c_; }
    __host__ __device__ bool next(int i, Unit& u) const {
        const long L = (long)i * G + c; if (L >= nwg) return false;
        int wgid = (int)L; { const int q = nwg / NXCD, r = nwg % NXCD, xcd = wgid % NXCD, off = wgid / NXCD; wgid = (xcd < r ? xcd * (q + 1) : r * (q + 1) + (xcd - r) * q) + off; }
        const int nig = WGM * nN, gid = wgid / nig, fm = gid * WGM, gsz = (nM - fm) < WGM ? (nM - fm) : WGM;
        u.pm = fm + ((wgid % nig) % gsz); u.pn = (wgid % nig) / gsz; u.hf = -1; return true;
    }
    __device__ __forceinline__ void a_ready(const Unit&) const {}
    __device__ __forceinline__ void done(const Unit&) const {}
};
__device__ __forceinline__ unsigned cvt_pk_bf16(float lo, float hi) { unsigned r; asm volatile("v_cvt_pk_bf16_f32 %0, %1, %2" : "=v"(r) : "v"(lo), "v"(hi)); return r; }
template <class Epi, class Sched, bool ALIGN_EPI = false, bool SP2 = false, bool HALFN = false>
__device__ __forceinline__ void gemm_phase(PG8_LAS unsigned char* lds, const Gemm g, const Sched& S, const Epi& E, const int tid_in) {
    const int tid = tid_in, wid = __builtin_amdgcn_readfirstlane(tid >> 6), lane = tid & 63, wr = wid >> 2, wc = wid & 3, fr = lane & 15, fq = lane >> 4;
    const int K = g.K, nt = K / BK;
    unsigned voffA[2], voffB[2];
#pragma unroll
    for (int i = 0; i < 2; ++i) { int R, C; stage_rc(tid * 16 + i * 8192, R, C); const int Rb = Epi::PERM ? ((R & ~31) + perm32(R & 31)) : R;
        voffA[i] = (unsigned)(R * K + C) * 2u; voffB[i] = (unsigned)(Rb * K + C) * 2u; }
    const size_t kstep = (size_t)(BK * 2);
    const size_t hstep = (size_t)HALF * K * 2;
    const size_t tstep = 2 * hstep;
    const size_t hstepB = HALFN ? 0 : hstep;
    const unsigned ldsw = (unsigned)wid * 1024u;
    const int aoff = lds_byte(wr * 64 + fr, fq * 8), boff = lds_byte(wc * 32 + fr, fq * 8);
#define PG8_SA(b, h) (((b) * 2 + (h)) * HTB)
#define PG8_SB(b, h) ((4 + (b) * 2 + (h)) * HTB)
#define PG8_STAGE(bufoff, gbase, voff) do { _Pragma("unroll") for (int _i = 0; _i < 2; ++_i) \
        __builtin_amdgcn_global_load_lds((const unsigned*)((const char*)(gbase) + (voff)[_i]), (PG8_LAS unsigned*)(lds + (bufoff) + ldsw + _i * 8192), 16, 0, 0); } while (0)
#define PG8_LDA(dst, b, h) do { _Pragma("unroll") for (int m = 0; m < 4; ++m) _Pragma("unroll") for (int k = 0; k < 2; ++k) dst[m][k] = *(const PG8_LAS bf16x8*)(lds + PG8_SA(b, h) + aoff + m * 2048 + k * 1024); } while (0)
#define PG8_LDB(dst, b, h) do { _Pragma("unroll") for (int n = 0; n < 2; ++n) _Pragma("unroll") for (int k = 0; k < 2; ++k) dst[n][k] = *(const PG8_LAS bf16x8*)(lds + PG8_SB(b, h) + boff + n * 2048 + k * 1024); } while (0)
#define PG8_MMA(ai, bj, At, Bt) do { __builtin_amdgcn_s_setprio(1); _Pragma("unroll") for (int m = 0; m < 4; ++m) _Pragma("unroll") for (int n = 0; n < 2; ++n) _Pragma("unroll") for (int k = 0; k < 2; ++k) \
        acc[ai][bj][m][n] = __builtin_amdgcn_mfma_f32_16x16x32_bf16(Bt[n][k], At[m][k], acc[ai][bj][m][n], 0, 0, 0); __builtin_amdgcn_s_setprio(0); } while (0)
#define PG8_WAIT_V(n) asm volatile("s_waitcnt vmcnt(" #n ")" ::: "memory")
#define PG8_WAIT_L(n) asm volatile("s_waitcnt lgkmcnt(" #n ")" ::: "memory")
#define PG8_BAR __builtin_amdgcn_s_barrier()
#define PG8_SCHED __builtin_amdgcn_sched_barrier(0)
    Unit cur, nxt; int ui = 0;
    if (!S.next(0, cur)) return;
    f32x4 acc[2][2][4][2];
#pragma unroll
    for (int a = 0; a < 2; ++a)
#pragma unroll
        for (int b = 0; b < 2; ++b)
#pragma unroll
            for (int m = 0; m < 4; ++m)
#pragma unroll
                for (int n = 0; n < 2; ++n) acc[a][b][m][n] = (f32x4){0.f, 0.f, 0.f, 0.f};
    bf16x8 At[4][2], B0[2][2], B1[2][2];
    const char* cA = (const char*)g.A + (size_t)cur.pm * tstep; const char* cB = (const char*)g.Bt + (size_t)cur.pn * tstep + ((HALFN && cur.hf > 0) ? hstep : 0);
    S.a_ready(cur);
    if constexpr (SP2) {
        PG8_STAGE(PG8_SB(0, 0), cB, voffB); PG8_STAGE(PG8_SB(0, 1), cB + hstepB, voffB); PG8_STAGE(PG8_SA(0, 0), cA, voffA); PG8_STAGE(PG8_SA(0, 1), cA + hstep, voffA);
        if (wr == 1) PG8_BAR;
        PG8_WAIT_V(2); PG8_BAR;
        PG8_STAGE(PG8_SB(1, 0), cB + kstep, voffB); PG8_STAGE(PG8_SA(1, 0), cA + kstep, voffA); PG8_STAGE(PG8_SB(1, 1), cB + hstepB + kstep, voffB);
        PG8_WAIT_V(6); PG8_BAR;
    } else {
        PG8_STAGE(PG8_SB(0, 0), cB, voffB); PG8_STAGE(PG8_SA(0, 0), cA, voffA); PG8_STAGE(PG8_SB(0, 1), cB + hstepB, voffB); PG8_STAGE(PG8_SA(0, 1), cA + hstep, voffA);
        if (wr == 1) PG8_BAR;
        PG8_WAIT_V(4); PG8_BAR;
        PG8_STAGE(PG8_SB(1, 0), cB + kstep, voffB); PG8_STAGE(PG8_SA(1, 0), cA + kstep, voffA); PG8_STAGE(PG8_SB(1, 1), cB + hstepB + kstep, voffB);
        PG8_WAIT_V(6); PG8_BAR;
    }
    for (;;) {
        const bool has_next = S.next(ui + 1, nxt);
        const char* nA = has_next ? (const char*)g.A + (size_t)nxt.pm * tstep : cA; const char* nB = has_next ? (const char*)g.Bt + (size_t)nxt.pn * tstep + ((HALFN && nxt.hf > 0) ? hstep : 0) : cB;
        for (int t = 0; t < nt; t += 2) {
            const bool last = (t == nt - 2);
            const char* a1 = cA + (size_t)(t + 1) * kstep;
            const char* a2 = last ? nA : cA + (size_t)(t + 2) * kstep; const char* b2 = last ? nB : cB + (size_t)(t + 2) * kstep;
            const char* a3 = a2 + kstep; const char* b3 = b2 + kstep;
            if (last && has_next) S.a_ready(nxt);
            if constexpr (SP2) {
            PG8_LDB(B0, 0, 0); if constexpr (!HALFN) PG8_LDB(B1, 0, 1); PG8_SCHED; PG8_LDA(At, 0, 0); PG8_STAGE(PG8_SA(1, 1), a1 + hstep, voffA);
            PG8_WAIT_V(8); PG8_WAIT_L(0); PG8_BAR; PG8_MMA(0, 0, At, B0); if constexpr (!HALFN) PG8_MMA(0, 1, At, B1); PG8_BAR; PG8_SCHED;
            PG8_LDA(At, 0, 1); PG8_STAGE(PG8_SB(0, 0), b2, voffB); PG8_STAGE(PG8_SB(0, 1), b2 + hstepB, voffB); PG8_STAGE(PG8_SA(0, 0), a2, voffA);
            PG8_WAIT_V(8); PG8_WAIT_L(0); PG8_BAR; PG8_MMA(1, 0, At, B0); if constexpr (!HALFN) PG8_MMA(1, 1, At, B1); PG8_BAR; PG8_SCHED;
            PG8_LDB(B0, 1, 0); if constexpr (!HALFN) PG8_LDB(B1, 1, 1); PG8_SCHED; PG8_LDA(At, 1, 0); PG8_STAGE(PG8_SA(0, 1), a2 + hstep, voffA);
            PG8_WAIT_V(8); PG8_WAIT_L(0); PG8_BAR; PG8_MMA(0, 0, At, B0); if constexpr (!HALFN) PG8_MMA(0, 1, At, B1); PG8_BAR; PG8_SCHED;
            PG8_LDA(At, 1, 1); PG8_STAGE(PG8_SB(1, 0), b3, voffB); PG8_STAGE(PG8_SB(1, 1), b3 + hstepB, voffB); PG8_STAGE(PG8_SA(1, 0), a3, voffA);
            PG8_WAIT_V(8); PG8_WAIT_L(0); PG8_BAR; PG8_MMA(1, 0, At, B0); if constexpr (!HALFN) PG8_MMA(1, 1, At, B1); PG8_BAR; PG8_SCHED;
            } else {
            PG8_LDB(B0, 0, 0); PG8_SCHED; PG8_LDA(At, 0, 0); PG8_STAGE(PG8_SA(1, 1), a1 + hstep, voffA);
            PG8_WAIT_L(8); PG8_BAR; PG8_WAIT_L(0); PG8_MMA(0, 0, At, B0); PG8_BAR; PG8_SCHED;
            if constexpr (!HALFN) PG8_LDB(B1, 0, 1); PG8_STAGE(PG8_SB(0, 0), b2, voffB);
            PG8_BAR; PG8_WAIT_L(0); if constexpr (!HALFN) PG8_MMA(0, 1, At, B1); PG8_BAR;
            PG8_LDA(At, 0, 1); PG8_STAGE(PG8_SA(0, 0), a2, voffA);
            PG8_BAR; PG8_WAIT_L(0); PG8_MMA(1, 0, At, B0); PG8_BAR; PG8_SCHED;
            PG8_STAGE(PG8_SB(0, 1), b2 + hstepB, voffB);
            PG8_WAIT_V(6); PG8_BAR; if constexpr (!HALFN) PG8_MMA(1, 1, At, B1); PG8_BAR;
            PG8_LDB(B0, 1, 0); PG8_SCHED; PG8_LDA(At, 1, 0); PG8_STAGE(PG8_SA(0, 1), a2 + hstep, voffA);
            PG8_WAIT_L(8); PG8_BAR; PG8_WAIT_L(0); PG8_MMA(0, 0, At, B0); PG8_BAR; PG8_SCHED;
            if constexpr (!HALFN) PG8_LDB(B1, 1, 1); PG8_STAGE(PG8_SB(1, 0), b3, voffB);
            PG8_BAR; PG8_WAIT_L(0); if constexpr (!HALFN) PG8_MMA(0, 1, At, B1); PG8_BAR;
            PG8_LDA(At, 1, 1); PG8_STAGE(PG8_SA(1, 0), a3, voffA);
            PG8_BAR; PG8_WAIT_L(0); PG8_MMA(1, 0, At, B0); PG8_BAR; PG8_SCHED;
            PG8_STAGE(PG8_SB(1, 1), b3 + hstepB, voffB);
            PG8_WAIT_V(6); PG8_BAR; if constexpr (!HALFN) PG8_MMA(1, 1, At, B1); PG8_BAR;
            }
        }
        if constexpr (ALIGN_EPI) { if (wr == 0) PG8_BAR; }
        if constexpr (!Epi::AFTER_DRAIN) { E(acc, cur, wr, wc, fr, fq); S.done(cur); }
        if (!has_next) break;
#pragma unroll
        for (int a = 0; a < 2; ++a)
#pragma unroll
            for (int b = 0; b < 2; ++b)
#pragma unroll
                for (int m = 0; m < 4; ++m)
#pragma unroll
                    for (int n = 0; n < 2; ++n) acc[a][b][m][n] = (f32x4){0.f, 0.f, 0.f, 0.f};
        cur = nxt; cA = nA; cB = nB; ++ui;
        if constexpr (ALIGN_EPI) { if (wr == 1) PG8_BAR; }
    }
    PG8_WAIT_V(0);
    if constexpr (!ALIGN_EPI) { if (wr == 0) PG8_BAR; }
    PG8_BAR;
    if constexpr (Epi::AFTER_DRAIN) { E.fused(acc, cur, wr, wc, fr, fq, lds, wid, lane); S.done(cur); }
#undef PG8_SA
#undef PG8_SB
#undef PG8_STAGE
#undef PG8_LDA
#undef PG8_LDB
#undef PG8_MMA
#undef PG8_WAIT_V
#undef PG8_WAIT_L
#undef PG8_BAR
#undef PG8_SCHED
}
}

constexpr int DM = 4096, TP = 8192, NSB = 16, TSQ = 16, PAST = 1024;
constexpr int MROWS = TP + NSB * TSQ;
constexpr int N1 = 16384, N3R = 16416, N3 = 16640;
constexpr int HW = 2048;
constexpr int NH_A = 16, NH_B = 16, NH_C = 32, HD = 128;
constexpr int FCS_LD = 1056;
constexpr float EPS = 1e-6f;
constexpr float LOG2E = 1.4426950408889634f;
constexpr float QK2 = 0.08838834764831845f * 1.4426950408889634f;
constexpr float NFRS = 11.313708498984761f;
constexpr float FIX = 16777216.f;

constexpr size_t O_YP = 0, O_YS = O_YP + (size_t)TP * DM, O_SAP = O_YS + (size_t)256 * DM, O_SAS = O_SAP + (size_t)16 * 128 * 128,
    O_BKP = O_SAS + (size_t)16 * 16 * 128 * 128, O_BVP = O_BKP + (size_t)TP * HW, O_BKS = O_BVP + (size_t)TP * HW, O_BVS = O_BKS + (size_t)256 * HW,
    O_CKP = O_BVS + (size_t)256 * HW, O_CVP = O_CKP + (size_t)TP * DM, O_CFP = O_CVP + (size_t)TP * DM, O_CKS = O_CFP + (size_t)TP * 32,
    O_CVS = O_CKS + (size_t)256 * DM, O_CFS = O_CVS + (size_t)256 * DM, O_END = O_CFS + (size_t)256 * 32;
static_assert(O_END == 143138816, "output size");

constexpr size_t MiB = 1u << 20;
constexpr size_t WS_CTL = 0, CTL_ZERO_BYTES = 1 * MiB;
constexpr size_t WS_LB = 1 * MiB;
constexpr size_t WS_W1T = 2 * MiB;
constexpr size_t WS_W2T = WS_W1T + 128 * MiB;
constexpr size_t WS_W3T = WS_W2T + 32 * MiB;
constexpr size_t WS_W4T = WS_W3T + 130 * MiB;
constexpr size_t WS_XN = WS_W4T + 32 * MiB;
constexpr size_t WS_P = WS_XN + 66 * MiB;
constexpr size_t PSTR1 = (size_t)MROWS * HW;
constexpr size_t PSTR3 = (size_t)MROWS * DM;
constexpr size_t WS_G = WS_P + 8 * 33 * MiB;
constexpr size_t WS_A = WS_G + 66 * MiB;
constexpr size_t WS_H1 = WS_A + 66 * MiB;
constexpr size_t WS_SLOC = WS_H1 + 132 * MiB;
constexpr size_t WS_SST = WS_SLOC + 128 * MiB;
constexpr size_t WS_DEC = WS_SST + 64 * MiB;
constexpr size_t WS_FL = WS_DEC + 1 * MiB;
constexpr size_t WS_FCP = WS_FL + 2 * MiB;
constexpr size_t WS_FCS = WS_FCP + 1 * MiB;
constexpr size_t WS_P3 = WS_FCS + 3 * MiB;
constexpr size_t WS_END = WS_P3 + 4 * 66 * MiB;
static_assert(WS_P + 4 * 66 * MiB <= WS_A, "layer-1 overlay fits");
constexpr int CW_BAR = 4096;
constexpr int CW_RS1 = 16384;
constexpr int CW_RS2 = CW_RS1 + 2 * 8448 + 128;
constexpr int CW_STAT = CW_RS2 + 2 * 8448 + 128;
constexpr int CW_KN2 = 8192;
constexpr int CW_WQ = CW_KN2 + 64;
constexpr int CW_WQ3 = CW_WQ + 32;
constexpr int CW_WQ4 = CW_WQ + 64, CW_FQ = CW_WQ4 + 64;
constexpr int CW_HSTAT = CW_STAT + 256;
static_assert(CW_BAR + 3456 <= CW_KN2 && CW_FQ + 128 <= CW_RS1 && (CW_HSTAT + 128) * 4 <= (int)CTL_ZERO_BYTES, "ctl region");

constexpr int RING_BYTES = 131072;
constexpr int MISC_OFF = RING_BYTES + 320;
constexpr int LDS_BYTES = 147456;
constexpr int NWAVES = 8;

#define LAS __attribute__((address_space(3)))
typedef unsigned short bf16_t;
typedef unsigned v4u __attribute__((ext_vector_type(4)));
typedef unsigned v2u __attribute__((ext_vector_type(2)));
typedef float f32x4 __attribute__((ext_vector_type(4)));
typedef float f32x2 __attribute__((ext_vector_type(2)));
typedef float f32x16 __attribute__((ext_vector_type(16)));
typedef short bf16x8 __attribute__((ext_vector_type(8)));
typedef short s16x4 __attribute__((ext_vector_type(4)));
#define LDS_WAIT() asm volatile("s_waitcnt lgkmcnt(0)" ::: "memory")
#define VM_WAIT() asm volatile("s_waitcnt vmcnt(0)" ::: "memory")

typedef __bf16 bf16x2_n __attribute__((ext_vector_type(2)));
__device__ __forceinline__ unsigned cvtpk(float lo, float hi) { const f32x2 f = {lo, hi}; const bf16x2_n r = __builtin_convertvector(f, bf16x2_n); return __builtin_bit_cast(unsigned, r); }
__device__ __forceinline__ float bf2f(unsigned short b) { return __uint_as_float(((unsigned)b) << 16); }
__device__ __forceinline__ float bflo(unsigned w) { return __uint_as_float(w << 16); }
__device__ __forceinline__ float bfhi(unsigned w) { return __uint_as_float(w & 0xffff0000u); }
__device__ __forceinline__ float ex2(float x) { return __builtin_amdgcn_exp2f(x); }
__device__ __forceinline__ float lg2(float x) { return __builtin_amdgcn_logf(x); }
__device__ __forceinline__ float rcpf_(float x) { return __builtin_amdgcn_rcpf(x); }
__device__ __forceinline__ float silu_f(float x) { return x * rcpf_(1.f + ex2(-x * LOG2E)); }
__device__ __forceinline__ float wave_sum(float v) {
#pragma unroll
    for (int o = 1; o < 64; o <<= 1) v += __shfl_xor(v, o);
    return v;
}
__device__ __forceinline__ unsigned off_b(unsigned row, unsigned ch) { return 256u * row + 16u * (ch ^ (((row & 3u) << 2) | ((row >> 2) & 3u))); }

#define XB_TMO      128
#define XB_XCNT(j)  (256  + 64 * (j))
#define XB_XSUB(j)  (1280 + 64 * (j))
#define XB_XGEN(j)  (2304 + 64 * (j))
#define XB_TOP      3328
#define XB_TOPGEN   3392
#define XCD_BAR_WORDS 3456
#define XB_SPIN_CAP (1u << 18)
__device__ __forceinline__ unsigned xb_ld(unsigned* p)              { return __hip_atomic_load(p, __ATOMIC_RELAXED, __HIP_MEMORY_SCOPE_AGENT); }
__device__ __forceinline__ unsigned xb_add(unsigned* p, unsigned v) { return __hip_atomic_fetch_add(p, v, __ATOMIC_RELAXED, __HIP_MEMORY_SCOPE_AGENT); }
__device__ __forceinline__ unsigned xb_xcc_id() { return (unsigned)__builtin_amdgcn_s_getreg((3 << 11) | 20) & 0xFu; }
#define XB_SPIN(cond, bar) do { unsigned _sp = 0; while (cond) { __builtin_amdgcn_s_sleep(1); \
    if ((++_sp & 255u) == 0u) { if (xb_ld(&(bar)[XB_TMO])) break; if (_sp > XB_SPIN_CAP) { atomicAdd(&(bar)[XB_TMO], 1u); break; } } } } while (0)
struct XcdBarrier { unsigned* bar; unsigned x; volatile LAS unsigned* st; };
__device__ __forceinline__ XcdBarrier xcd_barrier_post(unsigned* bar, volatile LAS unsigned* st) {
    XcdBarrier b; b.bar = bar; b.x = xb_xcc_id(); b.st = st;
    if (threadIdx.x == 0) (void)xb_add(&bar[XB_XCNT(b.x)], 1u);
    return b;
}
__device__ __forceinline__ void xcd_barrier_complete(unsigned* bar, unsigned x, unsigned& nloc, unsigned& nx) {
    const unsigned G = gridDim.x * gridDim.y * gridDim.z;
    unsigned sum, cnt, mine, sp = 0u;
    for (;;) {
        sum = 0u; cnt = 0u; mine = 0u;
#pragma unroll
        for (unsigned j = 0; j < 16; ++j) { const unsigned c = xb_ld(&bar[XB_XCNT(j)]); sum += c; cnt += (c > 0u) ? 1u : 0u; mine = (j == x) ? c : mine; }
        if (sum == G) break;
        __builtin_amdgcn_s_sleep(1);
        if ((++sp & 255u) == 0u) { if (xb_ld(&bar[XB_TMO])) break; if (sp > XB_SPIN_CAP) { atomicAdd(&bar[XB_TMO], 1u); break; } }
    }
    nloc = mine > 0u ? mine : 1u; nx = cnt > 0u ? cnt : 1u;
}
__device__ __forceinline__ void xcd_barrier(const XcdBarrier& b, const int wid0  ) {
    asm volatile("s_waitcnt vmcnt(0)" ::: "memory");
    __syncthreads();
    if (wid0 == 0 && __builtin_amdgcn_mbcnt_hi(~0u, __builtin_amdgcn_mbcnt_lo(~0u, 0u)) == 0u) {
        unsigned* bar = b.bar;
        __builtin_amdgcn_s_waitcnt(0);
        unsigned nloc = b.st[0], nx = b.st[1];
        if (nloc == 0u) { xcd_barrier_complete(bar, b.x, nloc, nx); b.st[0] = nloc; b.st[1] = nx; }
        const unsigned old = xb_add(&bar[XB_XSUB(b.x)], 1u);
        const unsigned gen = old / nloc;
        if (old + 1u == (gen + 1u) * nloc) {
            __builtin_amdgcn_fence(__ATOMIC_RELEASE, "agent");
            asm volatile("s_waitcnt vmcnt(0)" ::: "memory");
            const unsigned og = xb_add(&bar[XB_TOP], 1u);
            const unsigned tg = og / nx;
            if (og + 1u == (tg + 1u) * nx) xb_add(&bar[XB_TOPGEN], 1u);
            else XB_SPIN(xb_ld(&bar[XB_TOPGEN]) == tg, bar);
            __builtin_amdgcn_fence(__ATOMIC_ACQUIRE, "agent");
            xb_add(&bar[XB_XGEN(b.x)], 1u);
            asm volatile("s_waitcnt vmcnt(0)" ::: "memory");
        } else {
            XB_SPIN(xb_ld(&bar[XB_XGEN(b.x)]) == gen, bar);
            __builtin_amdgcn_fence(__ATOMIC_ACQUIRE, "agent");
            asm volatile("s_waitcnt vmcnt(0)" ::: "memory");
        }
    }
    __syncthreads();
}

using pg8::Unit;
struct Epi1 {
    static constexpr bool PERM = true, AFTER_DRAIN = false;
    bf16_t* P; float* G; const float* LB; float* out;
    __device__ __forceinline__ void operator()(const f32x4 (&acc)[2][2][4][2], const Unit& u, int wr, int wc, int fr, int fq) const {
        const int t = u.pn >> 3;
        const int row0 = u.pm * 256 + wr * 64 + fr, col0 = (u.pn & 7) * 256 + wc * 32 + 8 * fq + (u.hf > 0 ? 128 : 0);
        const int nbj = (u.hf >= 0) ? 1 : 2;
        bf16_t* dst = P + (size_t)t * PSTR1;
        float* fo = nullptr;
        if (t == 5 || t == 6) { const bool smp = u.pm >= 32; fo = out + (t == 5 ? (smp ? O_BKS : O_BKP) : (smp ? O_BVS : O_BVP)) - (smp ? (size_t)TP * HW : (size_t)0); }
        f32x4 lbv[2][2];
#pragma unroll
        for (int bj = 0; bj < 2; ++bj)
#pragma unroll
            for (int n = 0; n < 2; ++n) lbv[bj][n] = (t == 1 && bj < nbj) ? *(const f32x4*)(LB + col0 + bj * 128 + 4 * n) : (f32x4){0.f, 0.f, 0.f, 0.f};
        const bool act = (t == 0 || t == 3 || t == 7);
#pragma unroll
        for (int ai = 0; ai < 2; ++ai)
#pragma unroll
            for (int m = 0; m < 4; ++m) {
                const size_t ro = (size_t)(row0 + ai * 128 + m * 16) * HW + col0;
#pragma unroll
                for (int bj = 0; bj < 2; ++bj) { if (bj >= nbj) continue;
                    f32x4 v[2] = {acc[ai][bj][m][0], acc[ai][bj][m][1]};
                    if (act) {
#pragma unroll
                        for (int n = 0; n < 2; ++n)
#pragma unroll
                            for (int j = 0; j < 4; ++j) v[n][j] = silu_f(v[n][j]);
                    } else if (t == 1) {
#pragma unroll
                        for (int n = 0; n < 2; ++n) {
                            f32x4 gg;
#pragma unroll
                            for (int j = 0; j < 4; ++j) { const float z = fmaxf(v[n][j], -80.f), lb = lbv[bj][n][j]; const float e = ex2(-z * LOG2E), s = rcpf_(1.f + e);
                                const float f = lb + (1.f - lb) * s; gg[j] = lg2(f) * 0.6931471805599453f; v[n][j] = (1.f - lb) * (e * s); }
                            *(f32x4*)(G + ro + bj * 128 + 4 * n) = gg;
                        }
                    }
                    if (fo) { *(f32x4*)(fo + ro + bj * 128) = v[0]; *(f32x4*)(fo + ro + bj * 128 + 4) = v[1]; }
                    v4u w; w.x = cvtpk(v[0][0], v[0][1]); w.y = cvtpk(v[0][2], v[0][3]); w.z = cvtpk(v[1][0], v[1][1]); w.w = cvtpk(v[1][2], v[1][3]);
                    *(v4u*)(dst + ro + bj * 128) = w;
                }
            }
    }
};
struct Epi3 {
    static constexpr bool PERM = true, AFTER_DRAIN = false;
    bf16_t* P; const unsigned long long* RS; float* FL; const float* bfg; float* out;
    __device__ __forceinline__ void operator()(const f32x4 (&acc)[2][2][4][2], const Unit& u, int wr, int wc, int fr, int fq) const {
        const int t = u.pn >> 4;
        const int row0 = u.pm * 256 + wr * 64 + fr, col0 = (u.pn & 15) * 256 + wc * 32 + 8 * fq + (u.hf > 0 ? 128 : 0);
        const int nbj = (u.hf >= 0) ? 1 : 2;
        const bool smp = u.pm >= 32;
        if (t == 4) {
            if (wc != 0) return;
            float* fo = out + (smp ? O_CFS : O_CFP) - (smp ? (size_t)TP * 32 : (size_t)0);
            const f32x4 b0 = *(const f32x4*)(bfg + 8 * fq), b1 = *(const f32x4*)(bfg + 8 * fq + 4);
#pragma unroll
            for (int ai = 0; ai < 2; ++ai)
#pragma unroll
                for (int m = 0; m < 4; ++m) {
                    const int row = row0 + ai * 128 + m * 16;
                    const float r = rsqrtf((float)RS[row] * (1.f / (FIX * 4096.f)) + EPS);
                    f32x4 v[2] = {acc[ai][0][m][0] * r + b0, acc[ai][0][m][1] * r + b1};
#pragma unroll
                    for (int n = 0; n < 2; ++n)
#pragma unroll
                        for (int j = 0; j < 4; ++j) { const float x = v[n][j]; v[n][j] = fminf(x, 0.f) - log1pf(__expf(-fabsf(x))); }
                    *(f32x4*)(FL + (size_t)row * 32 + 8 * fq) = v[0]; *(f32x4*)(FL + (size_t)row * 32 + 8 * fq + 4) = v[1];
                    *(f32x4*)(fo + (size_t)row * 32 + 8 * fq) = v[0]; *(f32x4*)(fo + (size_t)row * 32 + 8 * fq + 4) = v[1];
                }
            return;
        }
        bf16_t* dst = P + (size_t)t * PSTR3;
        float* fo = nullptr;
        if (t == 1 || t == 2) fo = out + (t == 1 ? (smp ? O_CKS : O_CKP) : (smp ? O_CVS : O_CVP)) - (smp ? (size_t)TP * DM : (size_t)0);
#pragma unroll
        for (int ai = 0; ai < 2; ++ai)
#pragma unroll
            for (int m = 0; m < 4; ++m) {
                const int row = row0 + ai * 128 + m * 16;
                const float r = rsqrtf((float)RS[row] * (1.f / (FIX * 4096.f)) + EPS);
                const size_t ro = (size_t)row * DM + col0;
#pragma unroll
                for (int bj = 0; bj < 2; ++bj) { if (bj >= nbj) continue;
                    f32x4 v[2] = {acc[ai][bj][m][0] * r, acc[ai][bj][m][1] * r};
                    if (t == 3) {
#pragma unroll
                        for (int n = 0; n < 2; ++n)
#pragma unroll
                            for (int j = 0; j < 4; ++j) v[n][j] = silu_f(v[n][j]);
                    }
                    if (fo) { *(f32x4*)(fo + ro + bj * 128) = v[0]; *(f32x4*)(fo + ro + bj * 128 + 4) = v[1]; }
                    v4u w; w.x = cvtpk(v[0][0], v[0][1]); w.y = cvtpk(v[0][2], v[0][3]); w.z = cvtpk(v[1][0], v[1][1]); w.w = cvtpk(v[1][2], v[1][3]);
                    *(v4u*)(dst + ro + bj * 128) = w;
                }
            }
    }
};
template <bool XN_> struct EpiRes {
    static constexpr bool PERM = true, AFTER_DRAIN = false;
    const float* resP; const float* resS;
    float* H; bf16_t* XN; const float* nw; unsigned long long* RS;
    __device__ __forceinline__ void operator()(const f32x4 (&acc)[2][2][4][2], const Unit& u, int wr, int wc, int fr, int fq) const {
        const int row0 = u.pm * 256 + wr * 64 + fr, col0 = u.pn * 256 + wc * 32 + 8 * fq + (u.hf > 0 ? 128 : 0);
        const int nbj = (u.hf >= 0) ? 1 : 2;
        const float* res = (u.pm >= 32) ? resS - (size_t)TP * DM : resP;
        f32x4 wv[2][2];
#pragma unroll
        for (int bj = 0; bj < 2; ++bj)
#pragma unroll
            for (int n = 0; n < 2; ++n) wv[bj][n] = (XN_ && bj < nbj) ? *(const f32x4*)(nw + col0 + bj * 128 + 4 * n) : (f32x4){0.f, 0.f, 0.f, 0.f};
#pragma unroll
        for (int ai = 0; ai < 2; ++ai)
#pragma unroll
            for (int m = 0; m < 4; ++m) {
                const int row = row0 + ai * 128 + m * 16;
                const size_t ro = (size_t)row * DM + col0;
                float ss = 0.f;
#pragma unroll
                for (int bj = 0; bj < 2; ++bj) { if (bj >= nbj) continue;
                    f32x4 v[2];
#pragma unroll
                    for (int n = 0; n < 2; ++n) { v[n] = acc[ai][bj][m][n] + *(const f32x4*)(res + ro + bj * 128 + 4 * n); ss += (v[n][0] * v[n][0] + v[n][1] * v[n][1]) + (v[n][2] * v[n][2] + v[n][3] * v[n][3]); }
                    *(f32x4*)(H + ro + bj * 128) = v[0]; *(f32x4*)(H + ro + bj * 128 + 4) = v[1];
                    if (XN_) { v[0] = v[0] * wv[bj][0]; v[1] = v[1] * wv[bj][1];
                        v4u w; w.x = cvtpk(v[0][0], v[0][1]); w.y = cvtpk(v[0][2], v[0][3]); w.z = cvtpk(v[1][0], v[1][1]); w.w = cvtpk(v[1][2], v[1][3]);
                        *(v4u*)(XN + ro + bj * 128) = w; }
                }
                ss += __shfl_xor(ss, 16); ss += __shfl_xor(ss, 32);
                if (fq == 0) atomicAdd(RS + row, (unsigned long long)__float2ull_rn(ss * FIX));
            }
    }
};

template <int E>
__device__ __forceinline__ void wg_scan(float (&vals)[E], LAS float* scr, int tid, int wid, int lane) {
    float run = 0.f;
#pragma unroll
    for (int j = 0; j < E; ++j) { run += vals[j]; vals[j] = run; }
    float inc = run;
#pragma unroll
    for (int o = 1; o < 64; o <<= 1) { const float t = __shfl_up(inc, o); if (lane >= o) inc += t; }
    if (lane == 63) scr[wid] = inc;
    __syncthreads();
    float woff = 0.f;
#pragma unroll
    for (int w = 0; w < 8; ++w) woff += (w < wid) ? scr[w] : 0.f;
    const float offs = woff + (inc - run);
#pragma unroll
    for (int j = 0; j < E; ++j) vals[j] += offs;
    __syncthreads();
}


__device__ __forceinline__ unsigned f2bf(float f) { unsigned u = __builtin_bit_cast(unsigned, f); return (u + 0x7fffu + ((u >> 16) & 1u)) >> 16; }
__device__ __forceinline__ unsigned pk2(float lo, float hi) { return f2bf(lo) | (f2bf(hi) << 16); }
__device__ __forceinline__ void p0_transpose_item(const float* W, int K, int N, bf16_t* WT, LAS float* scr, int item, int lane) {
    const int nblk = N / 32, kb = item / nblk, nb = item % nblk, k0 = 64 * kb, n0 = 32 * nb;
#pragma unroll 8
    for (int i = 0; i < 32; ++i) { const int kk = 2 * i + (lane >> 5); scr[kk * 33 + (lane & 31)] = W[(size_t)(k0 + kk) * N + n0 + (lane & 31)]; }
    LDS_WAIT(); asm volatile("" ::: "memory");
    const int c = lane & 7;
#pragma unroll
    for (int j = 0; j < 4; ++j) { const int n = (lane >> 3) + 8 * j; const LAS float* s = scr + (8 * c) * 33 + n;
        v4u o; o.x = pk2(s[0 * 33], s[1 * 33]); o.y = pk2(s[2 * 33], s[3 * 33]); o.z = pk2(s[4 * 33], s[5 * 33]); o.w = pk2(s[6 * 33], s[7 * 33]);
        *(v4u*)(WT + (size_t)(n0 + n) * K + k0 + 8 * c) = o; }
    LDS_WAIT(); asm volatile("" ::: "memory");
}
__device__ __forceinline__ void p0_transpose_item64(const float* W, int K, int N, bf16_t* WT, LAS float* scr, int item, int lane) {
    const int nblk = N / 64, kb = item / nblk, nb = item % nblk, k0 = 64 * kb, n0 = 64 * nb;
    const int r4 = lane >> 4, g4 = lane & 15;
    f32x4 v[16];
#pragma unroll
    for (int i = 0; i < 16; ++i) v[i] = *(const f32x4*)(W + (size_t)(k0 + 4 * i + r4) * N + n0 + 4 * g4);
#pragma unroll
    for (int i = 0; i < 16; ++i) { const int kk = 4 * i + r4; *(LAS f32x4*)(scr + kk * 64 + ((g4 ^ (kk >> 3)) << 2)) = v[i]; }
    LDS_WAIT(); asm volatile("" ::: "memory");
    const int c = lane & 7;
#pragma unroll
    for (int j = 0; j < 8; ++j) { const int n = (lane >> 3) + 8 * j; const LAS float* s = scr + (8 * c) * 64 + ((((n >> 2) ^ c)) << 2) + (n & 3);
        v4u o; o.x = cvtpk(s[0 * 64], s[1 * 64]); o.y = cvtpk(s[2 * 64], s[3 * 64]); o.z = cvtpk(s[4 * 64], s[5 * 64]); o.w = cvtpk(s[6 * 64], s[7 * 64]);
        *(v4u*)(WT + (size_t)(n0 + n) * K + k0 + 8 * c) = o; }
    LDS_WAIT(); asm volatile("" ::: "memory");
}
__device__ __forceinline__ void norm_row_to_bf16(const float* xrow, const float* w, bf16_t* orow, int lane) {
    const f32x4* xr = (const f32x4*)xrow + lane;
    f32x4 v[16]; float s = 0.f;
#pragma unroll
    for (int j = 0; j < 16; ++j) { v[j] = xr[64 * j]; s += (v[j].x * v[j].x + v[j].y * v[j].y) + (v[j].z * v[j].z + v[j].w * v[j].w); }
    const float r = rsqrtf(wave_sum(s) * (1.f / DM) + EPS);
    const f32x4* wr_ = (const f32x4*)w + lane;
    v2u* o8 = (v2u*)orow + lane;
#pragma unroll
    for (int j = 0; j < 16; ++j) { const f32x4 ww = wr_[64 * j]; v2u o; o.x = cvtpk(v[j].x * r * ww.x, v[j].y * r * ww.y); o.y = cvtpk(v[j].z * r * ww.z, v[j].w * r * ww.w); o8[64 * j] = o; }
}

#define DBG_FLAG(cond, bit) do { if (dbg && __any(cond)) { if ((threadIdx.x & 63) == 0) atomicOr(dbg, 1u << (bit)); } } while (0)
__device__ __forceinline__ bool nonfin(float v) { return (__float_as_uint(v) & 0x7f800000u) == 0x7f800000u; }
__device__ __forceinline__ void attn_pv(const LAS unsigned char* Vt, int blk, const bf16x8 (&pk)[2], f32x16 (&o)[4], int lane) {
    const unsigned h = (unsigned)lane >> 5, q4 = (lane & 15) >> 2, pp = lane & 3, bc = (lane >> 4) & 1;
#pragma unroll
    for (int ks = 0; ks < 2; ++ks) {
        const unsigned row0 = 32u * blk + 16u * ks + 4u * h + q4, row1 = row0 + 8u;
        const unsigned x0 = (q4 << 2) | (h & 3u), x1 = (q4 << 2) | ((h + 2u) & 3u);
#pragma unroll
        for (int c = 0; c < 4; ++c) {
            const unsigned chn = 4u * c + 2u * bc + (pp >> 1);
            const s16x4 lo = __builtin_amdgcn_ds_read_tr16_b64_v4i16((LAS s16x4*)(Vt + 256u * row0 + 16u * (chn ^ x0) + 8u * (pp & 1)));
            const s16x4 hi = __builtin_amdgcn_ds_read_tr16_b64_v4i16((LAS s16x4*)(Vt + 256u * row1 + 16u * (chn ^ x1) + 8u * (pp & 1)));
            const bf16x8 a = {lo[0], lo[1], lo[2], lo[3], hi[0], hi[1], hi[2], hi[3]};
            o[c] = __builtin_amdgcn_mfma_f32_32x32x16_bf16(a, pk[ks], o[c], 0, 0, 0);
        }
    }
}
__device__ __forceinline__ void attn_v_load(const LAS unsigned char* Vt, int blk, s16x4 (&vl)[8], s16x4 (&vh)[8], int lane) {
    const unsigned h = (unsigned)lane >> 5, q4 = (lane & 15) >> 2, pp = lane & 3, bc = (lane >> 4) & 1;
#pragma unroll
    for (int ks = 0; ks < 2; ++ks) {
        const unsigned row0 = 32u * blk + 16u * ks + 4u * h + q4, row1 = row0 + 8u;
        const unsigned x0 = (q4 << 2) | (h & 3u), x1 = (q4 << 2) | ((h + 2u) & 3u);
#pragma unroll
        for (int c = 0; c < 4; ++c) {
            const unsigned chn = 4u * c + 2u * bc + (pp >> 1);
            vl[4 * ks + c] = __builtin_amdgcn_ds_read_tr16_b64_v4i16((LAS s16x4*)(Vt + 256u * row0 + 16u * (chn ^ x0) + 8u * (pp & 1)));
            vh[4 * ks + c] = __builtin_amdgcn_ds_read_tr16_b64_v4i16((LAS s16x4*)(Vt + 256u * row1 + 16u * (chn ^ x1) + 8u * (pp & 1)));
        }
    }
}
__device__ __forceinline__ void attn_v_mma(const s16x4 (&vl)[8], const s16x4 (&vh)[8], const bf16x8 (&pk)[2], f32x16 (&o)[4]) {
#pragma unroll
    for (int ks = 0; ks < 2; ++ks)
#pragma unroll
        for (int c = 0; c < 4; ++c) { const s16x4 lo = vl[4 * ks + c], hi = vh[4 * ks + c];
            const bf16x8 a = {lo[0], lo[1], lo[2], lo[3], hi[0], hi[1], hi[2], hi[3]};
            o[c] = __builtin_amdgcn_mfma_f32_32x32x16_bf16(a, pk[ks], o[c], 0, 0, 0); }
}
template <int MODE, bool FK_LDS = false, bool VPRE = true>
__device__ __forceinline__ void attn_block(const LAS unsigned char* Kt, const LAS unsigned char* Vt, int blk, const bf16x8 (&qf)[8], f32x16 (&o)[4],
                                           float& m, float& l, float& carry, int key0, int qpos, float fq2, const float* fk, int lane, unsigned* dbg = nullptr, const LAS float* fkl = nullptr, bool need_mask = true) {
    const int r32 = lane & 31, h = lane >> 5;
    f32x16 p = {};
    {
        const unsigned krow = 32u * blk + r32, kx = ((krow & 3u) << 2) | ((krow >> 2) & 3u);
        const LAS unsigned char* kb = Kt + 256u * krow;
        __builtin_amdgcn_s_setprio(1);
#pragma unroll
        for (int s = 0; s < 8; ++s) { const bf16x8 a = *(const LAS bf16x8*)(kb + 16u * ((unsigned)(2 * s + h) ^ kx)); p = __builtin_amdgcn_mfma_f32_32x32x16_bf16(a, qf[s], p, 0, 0, 0); }
        __builtin_amdgcn_s_setprio(0);
    }
    s16x4 fl[4], fh[4];
    const unsigned vh_ = (unsigned)lane >> 5, vq4 = (lane & 15) >> 2, vpp = lane & 3, vbc = (lane >> 4) & 1;
#define BVLD(ks_, c_) do { const unsigned row0_ = 32u * blk + 16u * (ks_) + 4u * vh_ + vq4, x0_ = (vq4 << 2) | (vh_ & 3u), x1_ = (vq4 << 2) | ((vh_ + 2u) & 3u), chn_ = 4u * (c_) + 2u * vbc + (vpp >> 1); \
        fl[c_] = __builtin_amdgcn_ds_read_tr16_b64_v4i16((LAS s16x4*)(Vt + 256u * row0_ + 16u * (chn_ ^ x0_) + 8u * (vpp & 1))); \
        fh[c_] = __builtin_amdgcn_ds_read_tr16_b64_v4i16((LAS s16x4*)(Vt + 256u * (row0_ + 8u) + 16u * (chn_ ^ x1_) + 8u * (vpp & 1))); } while (0)
#define BVMMA(c_, pk_) do { const bf16x8 a_ = {fl[c_][0], fl[c_][1], fl[c_][2], fl[c_][3], fh[c_][0], fh[c_][1], fh[c_][2], fh[c_][3]}; o[c_] = __builtin_amdgcn_mfma_f32_32x32x16_bf16(a_, pk_, o[c_], 0, 0, 0); } while (0)
    if (VPRE) { BVLD(0, 0); BVLD(0, 1); BVLD(0, 2); BVLD(0, 3); }
    __builtin_amdgcn_sched_barrier(0);
    { bool bad = false;
#pragma unroll
      for (int r = 0; r < 16; ++r) bad |= nonfin(p[r]);
      DBG_FLAG(bad, 1); }
    float x[16];
    if (MODE == 1) {
        f32x4 nf[4];
#pragma unroll
        for (int g = 0; g < 4; ++g) nf[g] = FK_LDS ? *(const LAS f32x4*)(fkl + 8 * g + 4 * h) : *(const f32x4*)(fk + 8 * g + 4 * h);
        f32x2 xv[8];
#pragma unroll
        for (int i = 0; i < 8; ++i) { const f32x2 pp = {p[2 * i], p[2 * i + 1]}, nn = {nf[i >> 1][2 * (i & 1)], nf[i >> 1][2 * (i & 1) + 1]}; xv[i] = (pp + nn) * QK2; }
        if (need_mask) {
#pragma unroll
            for (int i = 0; i < 8; ++i) { const int key = key0 + ((2 * i) & 3) + 8 * ((2 * i) >> 2) + 4 * h;
                xv[i].x = (key > qpos) ? -__builtin_inff() : xv[i].x; xv[i].y = (key + 1 > qpos) ? -__builtin_inff() : xv[i].y; }
        }
        float bm = fmaxf(xv[0].x, xv[0].y);
#pragma unroll
        for (int i = 1; i < 8; ++i) bm = fmaxf(bm, fmaxf(xv[i].x, xv[i].y));
        { auto rr = __builtin_amdgcn_permlane32_swap(__float_as_uint(bm), __float_as_uint(bm), false, false); bm = fmaxf(__uint_as_float(rr[0]), __uint_as_float(rr[1])); }
        const float mn = fmaxf(m, bm), alpha = ex2(m - mn); m = mn;
        f32x2 ls2 = {0.f, 0.f};
#pragma unroll
        for (int i = 0; i < 8; ++i) { f32x2 e = xv[i] - mn; e.x = ex2(e.x); e.y = ex2(e.y); ls2 += e; x[2 * i] = e.x; x[2 * i + 1] = e.y; }
        float ls = ls2.x + ls2.y;
        { auto rr = __builtin_amdgcn_permlane32_swap(__float_as_uint(ls), __float_as_uint(ls), false, false); ls = __uint_as_float(rr[0]) + __uint_as_float(rr[1]); }
        l = l * alpha + ls;
        if (__any(alpha != 1.f)) {
#pragma unroll
            for (int c = 0; c < 4; ++c)
#pragma unroll
                for (int r = 0; r < 16; ++r) o[c][r] *= alpha;
        }
    } else {
        float lm[16];
#pragma unroll
        for (int r = 0; r < 16; ++r) { const int key = key0 + (r & 3) + 8 * (r >> 2) + 4 * h; const float z2 = p[r] * QK2, e = ex2(-fabsf(z2)), sp = fmaxf(z2, 0.f) + lg2(1.f + e);
            const bool valid = key < qpos; lm[r] = valid ? -sp : 0.f; x[r] = valid ? (z2 - sp) : -__builtin_inff(); }
        float gs0 = (lm[0] + lm[1]) + (lm[2] + lm[3]), gs1 = (lm[4] + lm[5]) + (lm[6] + lm[7]), gs2 = (lm[8] + lm[9]) + (lm[10] + lm[11]), gs3 = (lm[12] + lm[13]) + (lm[14] + lm[15]);
        float a0, b0, a1, b1, a2, b2, a3, b3;
        { auto rr = __builtin_amdgcn_permlane32_swap(__float_as_uint(gs0), __float_as_uint(gs0), false, false); a0 = __uint_as_float(rr[0]); b0 = __uint_as_float(rr[1]); }
        { auto rr = __builtin_amdgcn_permlane32_swap(__float_as_uint(gs1), __float_as_uint(gs1), false, false); a1 = __uint_as_float(rr[0]); b1 = __uint_as_float(rr[1]); }
        { auto rr = __builtin_amdgcn_permlane32_swap(__float_as_uint(gs2), __float_as_uint(gs2), false, false); a2 = __uint_as_float(rr[0]); b2 = __uint_as_float(rr[1]); }
        { auto rr = __builtin_amdgcn_permlane32_swap(__float_as_uint(gs3), __float_as_uint(gs3), false, false); a3 = __uint_as_float(rr[0]); b3 = __uint_as_float(rr[1]); }
        const float T7 = 0.f, T6 = b3, T5 = T6 + a3, T4 = T5 + b2, T3 = T4 + a2, T2 = T3 + b1, T1 = T2 + a1, T0 = T1 + b0;
        const float total = T0 + a0;
        const float tb0 = carry + (h ? T1 : T0), tb1 = carry + (h ? T3 : T2), tb2 = carry + (h ? T5 : T4), tb3 = carry + (h ? T7 : T6);
#define SB_GRP(g, tb) do { const float t3 = (tb), t2 = t3 + lm[4 * (g) + 3], t1 = t2 + lm[4 * (g) + 2], t0 = t1 + lm[4 * (g) + 1]; \
            x[4 * (g) + 3] = ex2(x[4 * (g) + 3] + t3); x[4 * (g) + 2] = ex2(x[4 * (g) + 2] + t2); x[4 * (g) + 1] = ex2(x[4 * (g) + 1] + t1); x[4 * (g)] = ex2(x[4 * (g)] + t0); } while (0)
        SB_GRP(0, tb0); SB_GRP(1, tb1); SB_GRP(2, tb2); SB_GRP(3, tb3);
#undef SB_GRP
        carry += total;
        { bool bad = false;
#pragma unroll
          for (int r = 0; r < 16; ++r) bad |= nonfin(x[r]);
          DBG_FLAG(bad, 2); DBG_FLAG(nonfin(carry), 3); }
    }
    bf16x8 pk[2];
#pragma unroll
    for (int ks = 0; ks < 2; ++ks) { v4u w; w.x = cvtpk(x[8 * ks], x[8 * ks + 1]); w.y = cvtpk(x[8 * ks + 2], x[8 * ks + 3]); w.z = cvtpk(x[8 * ks + 4], x[8 * ks + 5]); w.w = cvtpk(x[8 * ks + 6], x[8 * ks + 7]); pk[ks] = __builtin_bit_cast(bf16x8, w); }
    __builtin_amdgcn_sched_barrier(0);
    __builtin_amdgcn_s_setprio(1);
#define BVSTEP(c_) do { BVMMA(c_, pk[0]); BVLD(1, c_); __builtin_amdgcn_sched_barrier(0); } while (0)
    if (VPRE) { BVSTEP(0); BVSTEP(1); BVSTEP(2); BVSTEP(3);
        BVMMA(0, pk[1]); BVMMA(1, pk[1]); BVMMA(2, pk[1]); BVMMA(3, pk[1]); }
    else attn_pv(Vt, blk, pk, o, lane);
    __builtin_amdgcn_s_setprio(0);
#undef BVSTEP
#undef BVMMA
#undef BVLD
}

__device__ __forceinline__ float vmax3(float a, float b, float c) { float r; asm("v_max3_f32 %0, %1, %2, %3" : "=v"(r) : "v"(a), "v"(b), "v"(c)); return r; }
__device__ __forceinline__ void attn_tile64_fox(const LAS unsigned char* Kt, const LAS unsigned char* Vt, const bf16x8 (&qf)[8], f32x16 (&o)[4], float& m, float& l, int lane, const LAS float* fkl) {
    const int r32 = lane & 31, h = lane >> 5;
    f32x16 p1, p0;
#pragma unroll
    for (int g = 0; g < 4; ++g) { const f32x4 n1 = *(const LAS f32x4*)(fkl + 32 + 8 * g + 4 * h), n0 = *(const LAS f32x4*)(fkl + 8 * g + 4 * h);
#pragma unroll
        for (int j = 0; j < 4; ++j) { p1[4 * g + j] = n1[j]; p0[4 * g + j] = n0[j]; } }
    {
        const unsigned kx = ((r32 & 3u) << 2) | ((r32 >> 2) & 3u);
        const LAS unsigned char* kb = Kt + 256u * r32;
#pragma unroll
        for (int s = 0; s < 8; ++s) { const unsigned co = 16u * ((unsigned)(2 * s + h) ^ kx);
            const bf16x8 a1 = *(const LAS bf16x8*)(kb + 8192u + co), a0 = *(const LAS bf16x8*)(kb + co);
            p1 = __builtin_amdgcn_mfma_f32_32x32x16_bf16(a1, qf[s], p1, 0, 0, 0); p0 = __builtin_amdgcn_mfma_f32_32x32x16_bf16(a0, qf[s], p0, 0, 0, 0); }
    }
    s16x4 fl[4], fh[4];
    int lv = lane; asm volatile("" : "+v"(lv));
    const unsigned vh_ = ((unsigned)lv >> 5) & 1u, vq4 = (lv & 15) >> 2, vpp = lv & 3, vbc = (lv >> 4) & 1;
#define VLD(blk_, ks_, c_) do { const unsigned row0_ = 32u * (blk_) + 16u * (ks_) + 4u * vh_ + vq4, x0_ = (vq4 << 2) | (vh_ & 3u), x1_ = (vq4 << 2) | ((vh_ + 2u) & 3u), chn_ = 4u * (c_) + 2u * vbc + (vpp >> 1); \
        fl[c_] = __builtin_amdgcn_ds_read_tr16_b64_v4i16((LAS s16x4*)(Vt + 256u * row0_ + 16u * (chn_ ^ x0_) + 8u * (vpp & 1))); \
        fh[c_] = __builtin_amdgcn_ds_read_tr16_b64_v4i16((LAS s16x4*)(Vt + 256u * (row0_ + 8u) + 16u * (chn_ ^ x1_) + 8u * (vpp & 1))); } while (0)
#define VMMA(c_, pk_) do { const bf16x8 a_ = {fl[c_][0], fl[c_][1], fl[c_][2], fl[c_][3], fh[c_][0], fh[c_][1], fh[c_][2], fh[c_][3]}; o[c_] = __builtin_amdgcn_mfma_f32_32x32x16_bf16(a_, pk_, o[c_], 0, 0, 0); } while (0)
    VLD(1, 0, 0); VLD(1, 0, 1); VLD(1, 0, 2); VLD(1, 0, 3);
    __builtin_amdgcn_sched_barrier(0);
    float bmA = vmax3(p1[0], p1[1], p1[2]), bmB = vmax3(p0[0], p0[1], p0[2]);
#pragma unroll
    for (int i = 3; i < 15; i += 2) { bmA = vmax3(bmA, p1[i], p1[i + 1]); bmB = vmax3(bmB, p0[i], p0[i + 1]); }
    float bm = vmax3(bmA, bmB, p1[15]); bm = fmaxf(bm, p0[15]);
    { auto rr = __builtin_amdgcn_permlane32_swap(__float_as_uint(bm), __float_as_uint(bm), false, false); bm = fmaxf(__uint_as_float(rr[0]), __uint_as_float(rr[1])) * QK2; }
    const float mn = fmaxf(m, bm), alpha = ex2(m - mn); m = mn;
    if (__any(alpha != 1.f)) {
#pragma unroll
        for (int c = 0; c < 4; ++c)
#pragma unroll
            for (int r = 0; r < 16; ++r) o[c][r] *= alpha;
    }
    f32x2 ls2 = {0.f, 0.f};
    bf16x8 pk1[2], pk0[2];
    { v4u w[2];
#pragma unroll
      for (int i = 0; i < 8; ++i) { f32x2 e = (f32x2){p1[2 * i], p1[2 * i + 1]} * QK2 - mn; e.x = ex2(e.x); e.y = ex2(e.y); ls2 += e; w[i >> 2][i & 3] = cvtpk(e.x, e.y); }
      pk1[0] = __builtin_bit_cast(bf16x8, w[0]); pk1[1] = __builtin_bit_cast(bf16x8, w[1]); }
    __builtin_amdgcn_sched_barrier(0);
#define VSTEP(c_, pk_, nb_, nk_) do { VMMA(c_, pk_); VLD(nb_, nk_, c_); __builtin_amdgcn_sched_barrier(0); } while (0)
    VSTEP(0, pk1[0], 1, 1); VSTEP(1, pk1[0], 1, 1); VSTEP(2, pk1[0], 1, 1); VSTEP(3, pk1[0], 1, 1);
    VSTEP(0, pk1[1], 0, 0); VSTEP(1, pk1[1], 0, 0); VSTEP(2, pk1[1], 0, 0); VSTEP(3, pk1[1], 0, 0);
    { v4u w[2];
#pragma unroll
      for (int i = 0; i < 8; ++i) { f32x2 e = (f32x2){p0[2 * i], p0[2 * i + 1]} * QK2 - mn; e.x = ex2(e.x); e.y = ex2(e.y); ls2 += e; w[i >> 2][i & 3] = cvtpk(e.x, e.y); }
      pk0[0] = __builtin_bit_cast(bf16x8, w[0]); pk0[1] = __builtin_bit_cast(bf16x8, w[1]); }
    __builtin_amdgcn_sched_barrier(0);
    VSTEP(0, pk0[0], 0, 1); VSTEP(1, pk0[0], 0, 1); VSTEP(2, pk0[0], 0, 1); VSTEP(3, pk0[0], 0, 1);
    VMMA(0, pk0[1]); VMMA(1, pk0[1]); VMMA(2, pk0[1]); VMMA(3, pk0[1]);
#undef VSTEP
#undef VMMA
#undef VLD
    float ls = ls2.x + ls2.y;
    { auto rr = __builtin_amdgcn_permlane32_swap(__float_as_uint(ls), __float_as_uint(ls), false, false); ls = __uint_as_float(rr[0]) + __uint_as_float(rr[1]); }
    l = l * alpha + ls;
}

template <int MODE>
__device__ __forceinline__ void attn_prompt_unit(LAS unsigned char* lds, const bf16_t* Qb, const bf16_t* Kb, const bf16_t* Vb, const bf16_t* Gate, int ld, int hd, int qb,
                                                 bf16_t* Out, int ocol0, const float* FCh, int tid, int wid, int lane, float kn2 = 0.f  ) {
    asm volatile("" : "+v"(tid)); lane = tid & 63;
    const int r32 = lane & 31, h = lane >> 5;
    const int qlo = qb * 256 + wid * 32, qrow = qlo + r32;
    bf16x8 qf[8];
    { const bf16_t* qp = Qb + (size_t)qrow * ld + hd * HD + 8 * h;
#pragma unroll
      for (int s = 0; s < 8; ++s) qf[s] = *(const bf16x8*)(qp + 16 * s); }
    f32x16 o[4] = {};
    float m = -1e30f, l = 0.f, carry = 0.f;
    const float fq2 = MODE ? FCh[qrow] : 0.f;
    float qnk = 0.f;
    if (MODE == 1) { float s2 = 0.f;
#pragma unroll
        for (int s = 0; s < 8; ++s)
#pragma unroll
            for (int e = 0; e < 8; ++e) { const float qv = bf2f((unsigned short)qf[s][e]); s2 += qv * qv; }
        { auto rr = __builtin_amdgcn_permlane32_swap(__float_as_uint(s2), __float_as_uint(s2), false, false); s2 = __uint_as_float(rr[0]) + __uint_as_float(rr[1]); }
        qnk = sqrtf(s2) * kn2; }
    LAS float* Fl = (LAS float*)(lds + 65536 + 128);
    float sf = 0.f;
    volatile LAS int* flags = (volatile LAS int*)(lds + 65536);
    const int ktop = 4 * qb + 3;
    const int srow = tid >> 4, sch = tid & 15;
    const bf16_t* kg = Kb + (size_t)srow * ld + hd * HD + sch * 8;
    const bf16_t* vg = Vb + (size_t)srow * ld + hd * HD + sch * 8;
    const unsigned so0 = off_b(srow, sch), so1 = off_b(srow + 32, sch);
    v4u sk0, sk1, sv0, sv1;
#define AP_ISSUE(kt) do { if (MODE == 1 && tid < 64) sf = FCh[(kt) * 64 + tid]; const size_t go = (size_t)(kt) * 64 * ld; sk0 = *(const v4u*)(kg + go); sk1 = *(const v4u*)(kg + go + (size_t)32 * ld); sv0 = *(const v4u*)(vg + go); sv1 = *(const v4u*)(vg + go + (size_t)32 * ld); } while (0)
#define AP_WRITE(b) do { if (MODE == 1 && tid < 64) Fl[(b) * 64 + tid] = sf; LAS unsigned char* kb_ = lds + (b) * 32768; *(LAS v4u*)(kb_ + so0) = sk0; *(LAS v4u*)(kb_ + so1) = sk1; *(LAS v4u*)(kb_ + 16384 + so0) = sv0; *(LAS v4u*)(kb_ + 16384 + so1) = sv1; } while (0)
    if (tid < 16) flags[tid] = 0;
    int cur = 0, it = 0; bool wdone = false;
    AP_ISSUE(ktop);
    for (int kt = ktop; kt >= 0; --kt, ++it) {
        AP_WRITE(cur);
        __syncthreads();
        if (it > 0) { const volatile LAS int* f = flags + ((it - 1) & 1) * 8; int all = 1;
#pragma unroll
            for (int w = 0; w < 8; ++w) all &= f[w];
            if (all) break; }
        if (kt > 0) AP_ISSUE(kt - 1);
        if (!wdone) {
#pragma unroll
            for (int blk = 1; blk >= 0; --blk) {
                const int key0 = kt * 64 + blk * 32;
                if (key0 > qlo + 31) continue;
                attn_block<MODE, MODE == 1>(lds + cur * 32768, lds + cur * 32768 + 16384, blk, qf, o, m, l, carry, key0, qrow, fq2, nullptr, lane, nullptr, Fl + cur * 64 + blk * 32, key0 + 31 > qlo);
            }
            if (MODE == 0) wdone = __all(carry < -136.f);
            else wdone = __all(m > -1e29f && qnk + Fl[cur * 64] * QK2 < m - 136.f);
        }
        if (lane == 0) flags[(it & 1) * 8 + wid] = wdone ? 1 : 0;
        cur ^= 1;
    }
#undef AP_ISSUE
#undef AP_WRITE
    const float inv = MODE ? 1.f / l : 1.f;
    const bf16_t* gp = Gate + (size_t)qrow * ld + hd * HD + 4 * h;
    bf16_t* op = Out + (size_t)qrow * DM + ocol0 + 4 * h;
#pragma unroll
    for (int c = 0; c < 4; ++c)
#pragma unroll
        for (int g = 0; g < 4; ++g) { const v2u gw = *(const v2u*)(gp + 32 * c + 8 * g);
            v2u w; w.x = cvtpk(o[c][4 * g] * inv * bflo(gw.x), o[c][4 * g + 1] * inv * bfhi(gw.x)); w.y = cvtpk(o[c][4 * g + 2] * inv * bflo(gw.y), o[c][4 * g + 3] * inv * bfhi(gw.y));
            *(v2u*)(op + 32 * c + 8 * g) = w; }
    __syncthreads();
}

struct GBar { volatile LAS unsigned* cnt; unsigned tgt; };
__device__ __forceinline__ void gbar_sync(GBar& g, int lane) {
    g.tgt += 4u;
    asm volatile("s_waitcnt lgkmcnt(0)" ::: "memory");
    if (lane == 0) __hip_atomic_fetch_add((LAS unsigned*)g.cnt, 1u, __ATOMIC_RELAXED, __HIP_MEMORY_SCOPE_WORKGROUP);
    while ((int)(__hip_atomic_load((LAS unsigned*)g.cnt, __ATOMIC_RELAXED, __HIP_MEMORY_SCOPE_WORKGROUP) - g.tgt) < 0) __builtin_amdgcn_s_sleep(1);
    asm volatile("" ::: "memory");
}
template <int MODE>
__device__ __forceinline__ void attn_prompt_group(LAS unsigned char* gl, LAS unsigned char* gx, GBar& gb, const bf16_t* Qb, const bf16_t* Kb, const bf16_t* Vb, const bf16_t* Gate, int ld, int hd, int qb,
                                                  bf16_t* Out, int ocol0, const float* FCh, int gtid, int gw, float kn2) {
    asm volatile("" : "+v"(gtid)); const int lane = gtid & 63;
    const int r32 = lane & 31, h = lane >> 5;
    const int qlo = qb * 128 + gw * 32, qrow = qlo + r32;
    bf16x8 qf[8];
    { const bf16_t* qp = Qb + (size_t)qrow * ld + hd * HD + 8 * h;
#pragma unroll
      for (int s = 0; s < 8; ++s) qf[s] = *(const bf16x8*)(qp + 16 * s); }
    f32x16 o[4] = {};
    float m = -1e30f, l = 0.f, carry = 0.f;
    float qnk = 0.f;
    if (MODE == 1) { float s2 = 0.f;
#pragma unroll
        for (int s = 0; s < 8; ++s)
#pragma unroll
            for (int e = 0; e < 8; ++e) { const float qv = bf2f((unsigned short)qf[s][e]); s2 += qv * qv; }
        { auto rr = __builtin_amdgcn_permlane32_swap(__float_as_uint(s2), __float_as_uint(s2), false, false); s2 = __uint_as_float(rr[0]) + __uint_as_float(rr[1]); }
        qnk = sqrtf(s2) * kn2; }
    LAS float* Fl = (LAS float*)(gx + 128);
    volatile LAS int* flags = (volatile LAS int*)gx;
    const int ktop = 2 * qb + 1;
#define AG_DMA(kt, b) do { const size_t go_ = (size_t)(kt) * 64 * ld * 2; LAS unsigned char* kb_ = gl + (b) * 32768 + gw * 4096; int l_ = gtid; asm volatile("" : "+v"(l_)); l_ &= 63; unsigned voff[4]; \
        _Pragma("unroll") for (int i_ = 0; i_ < 4; ++i_) { const int row_ = 16 * gw + 4 * i_ + (l_ >> 4), ch_ = (l_ & 15) ^ ((((l_ >> 4) & 3) << 2) | i_); voff[i_] = (unsigned)((row_ * ld + hd * HD + 8 * ch_) * 2); } \
        _Pragma("unroll") for (int i_ = 0; i_ < 4; ++i_) { \
            __builtin_amdgcn_global_load_lds((const unsigned*)((const char*)Kb + go_ + voff[i_]), (LAS unsigned*)(kb_ + i_ * 1024), 16, 0, 0); \
            __builtin_amdgcn_global_load_lds((const unsigned*)((const char*)Vb + go_ + voff[i_]), (LAS unsigned*)(kb_ + 16384 + i_ * 1024), 16, 0, 0); } \
        if (MODE == 1 && gw == 0) __builtin_amdgcn_global_load_lds((const unsigned*)(FCh + (kt) * 64 + l_), (LAS unsigned*)(Fl + (b) * 64), 4, 0, 0); } while (0)
    if (gtid < 8) flags[gtid] = 0;
    int cur = 0, it = 0; bool wdone = false;
    AG_DMA(ktop, 0);
    for (int kt = ktop; kt >= 0; --kt, ++it) {
        asm volatile("s_waitcnt vmcnt(0)" ::: "memory");
        gbar_sync(gb, lane);
        if (it > 0) { const volatile LAS int* f = flags + ((it - 1) & 1) * 4; if (f[0] & f[1] & f[2] & f[3]) break; }
        if (kt > 0) AG_DMA(kt - 1, cur ^ 1);
        if (!wdone) {
            if (MODE == 1 && kt * 64 + 63 <= qlo) attn_tile64_fox(gl + cur * 32768, gl + cur * 32768 + 16384, qf, o, m, l, lane, Fl + cur * 64);
            else {
#pragma unroll
            for (int blk = 1; blk >= 0; --blk) {
                const int key0 = kt * 64 + blk * 32;
                if (key0 > qlo + 31) continue;
                attn_block<MODE, MODE == 1>(gl + cur * 32768, gl + cur * 32768 + 16384, blk, qf, o, m, l, carry, key0, qrow, 0.f, nullptr, lane, nullptr, Fl + cur * 64 + blk * 32, key0 + 31 > qlo);
            } }
            if (MODE == 0) wdone = __all(carry < -136.f);
            else wdone = __all(m > -1e29f && qnk + Fl[cur * 64] * QK2 < m - 136.f);
        }
        if (lane == 0) flags[(it & 1) * 4 + gw] = wdone ? 1 : 0;
        cur ^= 1;
    }
#undef AG_DMA
    const float inv = MODE ? 1.f / l : 1.f;
    int le = gtid; asm volatile("" : "+v"(le));
    const int qrow_e = qlo + (le & 31), he = (le >> 5) & 1;
    const bf16_t* gp = Gate + (size_t)qrow_e * ld + hd * HD + 4 * he;
    bf16_t* op = Out + (size_t)qrow_e * DM + ocol0 + 4 * he;
#pragma unroll
    for (int c = 0; c < 4; ++c)
#pragma unroll
        for (int g = 0; g < 4; ++g) { const v2u gw_ = *(const v2u*)(gp + 32 * c + 8 * g);
            v2u w; w.x = cvtpk(o[c][4 * g] * inv * bflo(gw_.x), o[c][4 * g + 1] * inv * bfhi(gw_.x)); w.y = cvtpk(o[c][4 * g + 2] * inv * bflo(gw_.y), o[c][4 * g + 3] * inv * bfhi(gw_.y));
            *(v2u*)(op + 32 * c + 8 * g) = w; }
    gbar_sync(gb, lane);
}

__device__ __forceinline__ void fl_rows(LAS unsigned char* lds, const bf16_t* XN, const bf16_t* W3fl, const unsigned long long* RS, const float* bfg, float* FL, float* outF, int row0, int tid, int wid) {
    asm volatile("" : "+v"(tid)); const int lane = tid & 63;
    const int r32 = lane & 31, h = lane >> 5;
    f32x16 acc = {};
    const bf16_t* ap = XN + (size_t)(row0 + r32) * DM + wid * 512 + 8 * h;
    const bf16_t* bp = W3fl + (size_t)r32 * DM + wid * 512 + 8 * h;
#pragma unroll 8
    for (int s = 0; s < 32; ++s) { const bf16x8 a = *(const bf16x8*)(ap + 16 * s), bb = *(const bf16x8*)(bp + 16 * s); acc = __builtin_amdgcn_mfma_f32_32x32x16_bf16(a, bb, acc, 0, 0, 0); }
    LAS float* red = (LAS float*)lds;
#pragma unroll
    for (int r = 0; r < 16; ++r) red[(wid * 32 + (r & 3) + 8 * (r >> 2) + 4 * h) * 32 + r32] = acc[r];
    __syncthreads();
    { const int row = tid >> 4, c2 = (tid & 15) * 2;
      float s0 = 0.f, s1 = 0.f;
#pragma unroll
      for (int w = 0; w < 8; ++w) { const f32x2 v = *(const LAS f32x2*)(red + (w * 32 + row) * 32 + c2); s0 += v.x; s1 += v.y; }
      const float r = rsqrtf((float)RS[row0 + row] * (1.f / (FIX * 4096.f)) + EPS);
      float x0 = s0 * r + bfg[c2], x1 = s1 * r + bfg[c2 + 1];
      x0 = fminf(x0, 0.f) - log1pf(__expf(-fabsf(x0))); x1 = fminf(x1, 0.f) - log1pf(__expf(-fabsf(x1)));
      *(f32x2*)(FL + (size_t)(row0 + row) * 32 + c2) = (f32x2){x0, x1}; *(f32x2*)(outF + (size_t)(row0 + row) * 32 + c2) = (f32x2){x0, x1}; }
    __syncthreads();
}

template <int NB>
__device__ __forceinline__ void stage_block_f32(LAS unsigned char* T, const float* src  , size_t rs, int lane) {
#pragma unroll
    for (int hf = 0; hf < 16 / NB; ++hf) {
        f32x4 v[NB];
#pragma unroll
        for (int i = 0; i < NB; ++i) { const int id = lane + 64 * (NB * hf + i), row = id >> 5, c4 = id & 31; v[i] = *(const f32x4*)(src + (size_t)row * rs + c4 * 4); }
#pragma unroll
        for (int i = 0; i < NB; ++i) { const int id = lane + 64 * (NB * hf + i), row = id >> 5, c4 = id & 31; v2u w; w.x = cvtpk(v[i].x, v[i].y); w.y = cvtpk(v[i].z, v[i].w);
            *(LAS v2u*)(T + off_b(row, c4 >> 1) + (c4 & 1) * 8) = w; }
        asm volatile("" ::: "memory");
    }
}
__device__ __forceinline__ void stage_block_new(LAS unsigned char* T, const bf16_t* src  , int ld, int lane) {
#pragma unroll
    for (int i = 0; i < 8; ++i) { const int id = lane + 64 * i, row = id >> 4, ch = id & 15; v4u w = {0u, 0u, 0u, 0u}; if (row < 16) w = *(const v4u*)(src + (size_t)row * ld + ch * 8);
        *(LAS v4u*)(T + off_b(row, ch)) = w; }
    asm volatile("" ::: "memory");
}
__device__ __forceinline__ void attn_sample_sb_unit(LAS unsigned char* lds, int b, int hd, const bf16_t* QB, const bf16_t* KB, const bf16_t* VB, const bf16_t* GB,
                                                    const float* ck, const float* cv, bf16_t* Out, int tid_, int wid) {
    int lane = tid_ & 63; asm volatile("" : "+v"(lane));
    const int r32 = lane & 31, h = lane >> 5, t = r32 & 15; const bool real = r32 < 16;
    const int qrow = TP + 16 * b + t, qpos = real ? PAST + t : -1;
    bf16x8 qf[8];
    { const bf16_t* qp = QB + (size_t)qrow * HW + hd * HD + 8 * h;
#pragma unroll
      for (int s = 0; s < 8; ++s) { qf[s] = *(const bf16x8*)(qp + 16 * s); if (!real) qf[s] = (bf16x8){0, 0, 0, 0, 0, 0, 0, 0}; } }
    f32x16 o[4] = {};
    float m = 0.f, l = 0.f, carry = 0.f;
    volatile LAS int* flag = (volatile LAS int*)(lds + 65536);
    for (int tl = 16; tl >= 0; --tl) {
        int tid = wid * 64 + lane; asm volatile("" : "+v"(tid));
        if (tl == 16) {
#pragma unroll
            for (int i = 0; i < 2; ++i) { const int id = tid + 512 * i, row = id >> 4, ch = id & 15; v4u wk = {0u, 0u, 0u, 0u}, wv = {0u, 0u, 0u, 0u};
                if (row < 16) { const size_t go = (size_t)(TP + 16 * b + row) * HW + hd * HD + ch * 8; wk = *(const v4u*)(KB + go); wv = *(const v4u*)(VB + go); }
                *(LAS v4u*)(lds + off_b(row, ch)) = wk; *(LAS v4u*)(lds + 16384 + off_b(row, ch)) = wv; }
        } else {
            const size_t ro = (((size_t)b * PAST + 64 * tl) * NH_B + hd) * HD;
            f32x4 vk[4], vv[4];
#pragma unroll
            for (int i = 0; i < 4; ++i) { const int id = tid + 512 * i, row = id >> 5, c4 = id & 31; const size_t go = ro + (size_t)row * (NH_B * HD) + c4 * 4; vk[i] = *(const f32x4*)(ck + go); vv[i] = *(const f32x4*)(cv + go); }
#pragma unroll
            for (int i = 0; i < 4; ++i) { const int id = tid + 512 * i, row = id >> 5, c4 = id & 31; const unsigned lo = off_b(row, c4 >> 1) + (c4 & 1) * 8;
                v2u w; w.x = cvtpk(vk[i].x, vk[i].y); w.y = cvtpk(vk[i].z, vk[i].w); *(LAS v2u*)(lds + lo) = w;
                w.x = cvtpk(vv[i].x, vv[i].y); w.y = cvtpk(vv[i].z, vv[i].w); *(LAS v2u*)(lds + 16384 + lo) = w; }
        }
        __syncthreads();
        if (wid == 0) {
            attn_block<0, false, false>(lds, lds + 16384, 1, qf, o, m, l, carry, 64 * tl + 32, qpos, 0.f, nullptr, lane);
            attn_block<0, false, false>(lds, lds + 16384, 0, qf, o, m, l, carry, 64 * tl, qpos, 0.f, nullptr, lane);
            if (lane == 0) flag[0] = __all(carry < -136.f || !real) ? 1 : 0;
        }
        __syncthreads();
        if (flag[0]) break;
    }
    if (wid == 0 && real) {
        const bf16_t* gp = GB + (size_t)qrow * HW + hd * HD + 4 * h;
        bf16_t* op = Out + (size_t)qrow * DM + HW + hd * HD + 4 * h;
#pragma unroll
        for (int c = 0; c < 4; ++c)
#pragma unroll
            for (int g = 0; g < 4; ++g) { const v2u gw = *(const v2u*)(gp + 32 * c + 8 * g);
                v2u w; w.x = cvtpk(o[c][4 * g] * bflo(gw.x), o[c][4 * g + 1] * bfhi(gw.x)); w.y = cvtpk(o[c][4 * g + 2] * bflo(gw.y), o[c][4 * g + 3] * bfhi(gw.y));
                *(v2u*)(op + 32 * c + 8 * g) = w; }
    }
    __syncthreads();
}
__device__ __forceinline__ void attn_sample_fox_unit(LAS unsigned char* lds, int b, int hd, const bf16_t* QC, const bf16_t* KC, const bf16_t* VC, const bf16_t* GC,
                                                     const float* ck, const float* cv, const float* clf  , const float* FL, bf16_t* Out, int tid, int wid, int lane) {
    asm volatile("" : "+v"(tid)); lane = tid & 63;
    const int r32 = lane & 31, h = lane >> 5, t = r32 & 15; const bool real = r32 < 16;
    const int qrow = TP + 16 * b + t, qpos = real ? PAST + t : -1;
    LAS float* NFl = (LAS float*)(lds + RING_BYTES + 2048);
    { float v[3];
#pragma unroll
      for (int j = 0; j < 3; ++j) { const int s = tid * 3 + j; float x = 0.f;
          if (s < PAST) x = clf[((size_t)b * PAST + s) * NH_C + hd]; else if (s < PAST + TSQ) x = FL[(size_t)(TP + 16 * b + s - PAST) * 32 + hd];
          v[j] = x * -NFRS; }
      wg_scan<3>(v, (LAS float*)(lds + RING_BYTES + 1536), tid, wid, lane);
#pragma unroll
      for (int j = 0; j < 3; ++j) { const int s = tid * 3 + j; if (s < FCS_LD) NFl[s] = v[j]; }
      __syncthreads(); }
    LAS unsigned char* wl = lds + wid * 16384;
    bf16x8 qf[8];
    { const bf16_t* qp = QC + (size_t)qrow * DM + hd * HD + 8 * h;
#pragma unroll
      for (int s = 0; s < 8; ++s) { qf[s] = *(const bf16x8*)(qp + 16 * s); if (!real) qf[s] = (bf16x8){0, 0, 0, 0, 0, 0, 0, 0}; } }
    f32x16 o[4] = {};
    float m = -1e30f, l = 0.f, carry = 0.f;
    const float fq2 = 0.f;
    const int nb = (wid == 7) ? 5 : 4;
    for (int j = 0; j < nb; ++j) {
        const int bi = (j == 4) ? 32 : 4 * wid + j;
        if (bi == 32) { stage_block_new(wl, KC + (size_t)(TP + 16 * b) * DM + hd * HD, DM, lane); stage_block_new(wl + 8192, VC + (size_t)(TP + 16 * b) * DM + hd * HD, DM, lane); }
        else { const size_t ro = (((size_t)b * PAST + 32 * bi) * NH_C + hd) * HD; stage_block_f32<8>(wl, ck + ro, (size_t)NH_C * HD, lane); stage_block_f32<8>(wl + 8192, cv + ro, (size_t)NH_C * HD, lane); }
        attn_block<1, true>(wl, wl + 8192, 0, qf, o, m, l, carry, 32 * bi, qpos, fq2, nullptr, lane, nullptr, NFl + 32 * bi, bi == 32);
    }
    __syncthreads();
    LAS float* co = (LAS float*)lds;
    LAS float* cm = (LAS float*)(lds + 65536);
    if (real) {
        if (h == 0) { cm[wid * 16 + t] = m; cm[128 + wid * 16 + t] = l; }
#pragma unroll
        for (int c = 0; c < 4; ++c)
#pragma unroll
            for (int g = 0; g < 4; ++g) *(LAS f32x4*)(co + (wid * 16 + t) * 128 + 32 * c + 8 * g + 4 * h) = (f32x4){o[c][4 * g], o[c][4 * g + 1], o[c][4 * g + 2], o[c][4 * g + 3]};
    }
    __syncthreads();
    {
        const int tq = tid >> 5, d4 = (tid & 31) * 4;
        float M = -1e30f;
#pragma unroll
        for (int w = 0; w < 8; ++w) M = fmaxf(M, cm[w * 16 + tq]);
        float L = 0.f; f32x4 acc = {0.f, 0.f, 0.f, 0.f};
#pragma unroll
        for (int w = 0; w < 8; ++w) { const float sc = ex2(cm[w * 16 + tq] - M); L += cm[128 + w * 16 + tq] * sc; acc += *(const LAS f32x4*)(co + (w * 16 + tq) * 128 + d4) * sc; }
        const float inv = 1.f / L;
        const int orow = TP + 16 * b + tq;
        const v2u gw = *(const v2u*)(GC + (size_t)orow * DM + hd * HD + d4);
        v2u w; w.x = cvtpk(acc[0] * inv * bflo(gw.x), acc[1] * inv * bfhi(gw.x)); w.y = cvtpk(acc[2] * inv * bflo(gw.y), acc[3] * inv * bfhi(gw.y));
        *(v2u*)(Out + (size_t)orow * DM + hd * HD + d4) = w;
    }
    __syncthreads();
}

__device__ __forceinline__ void hg_load_g(const float* Gp  , int ntok, int k, int a, float (&g)[16]) {
#pragma unroll
    for (int j = 0; j < 16; ++j) { const int i = 16 * a + j; g[j] = (i < ntok) ? Gp[(size_t)i * HW + k] : 0.f; }
}
__device__ __forceinline__ void hg_scan(const float (&g)[16], LAS float* tot, int k, int a, float (&Gc)[16], float& Glast, float& Gmid) {
    float run = 0.f;
#pragma unroll
    for (int j = 0; j < 16; ++j) { run += g[j]; Gc[j] = run; }
    tot[a * 128 + k] = run;
    __syncthreads();
    const float t0 = tot[k], t1 = tot[128 + k], t2 = tot[256 + k], t3 = tot[384 + k];
    const float offs = (a > 0 ? t0 : 0.f) + (a > 1 ? t1 : 0.f) + (a > 2 ? t2 : 0.f);
#pragma unroll
    for (int j = 0; j < 16; ++j) Gc[j] += offs;
    Glast = (t0 + t1) + (t2 + t3); Gmid = t0 + t1;
}
__device__ __forceinline__ void hg_tile_load(const bf16_t* src, int ntok, int tid, v4u (&w)[2]) {
#pragma unroll
    for (int i = 0; i < 2; ++i) { const int id = tid + 512 * i, row = id >> 4, ch = id & 15; w[i] = (v4u){0u, 0u, 0u, 0u}; if (row < ntok) w[i] = *(const v4u*)(src + (size_t)row * HW + ch * 8); }
}
__device__ __forceinline__ void hg_tile_write(LAS unsigned char* T, int tid, const v4u (&w)[2]) {
#pragma unroll
    for (int i = 0; i < 2; ++i) { const int id = tid + 512 * i, row = id >> 4, ch = id & 15; *(LAS v4u*)(T + off_b(row, ch)) = w[i]; }
}
constexpr int HG_V = 0, HG_KT = 16384, HG_QP = 32768, HG_QM = 49152, HG_KM = 65536, HG_SST = 81920, HG_TOT = 114688, HG_RED = 116736;

struct HgIn { float g[16]; unsigned short kr[16]; v4u vt[2]; };
__device__ __forceinline__ void hg_local_load(HgIn& I, const bf16_t* KAp, const bf16_t* VAp, const float* Gp, int ntok, int tid) {
    const int k = tid & 127, a = tid >> 7;
    hg_load_g(Gp, ntok, k, a, I.g);
    hg_tile_load(VAp, ntok, tid, I.vt);
#pragma unroll
    for (int j = 0; j < 16; ++j) { const int i = 16 * a + j; I.kr[j] = (i < ntok) ? KAp[(size_t)i * HW + k] : (unsigned short)0; }
}
template <bool SAMPLE>
__device__ __forceinline__ void hg_local_compute(LAS unsigned char* lds, const HgIn& I, const float* S0, float* Sout, float* Dout, int tid, int wid) {
    const int lane = tid & 63;
    const int k = tid & 127, a = tid >> 7;
    float Gc[16], Glast, Gmid;
    hg_scan(I.g, (LAS float*)(lds + HG_TOT), k, a, Gc, Glast, Gmid);
    hg_tile_write(lds + HG_V, tid, I.vt);
    {
        unsigned w[8];
#pragma unroll
        for (int j = 0; j < 16; j += 2) {
            const float k0 = bf2f(I.kr[j]) * ex2((Glast - Gc[j]) * LOG2E);
            const float k1 = bf2f(I.kr[j + 1]) * ex2((Glast - Gc[j + 1]) * LOG2E);
            w[j >> 1] = cvtpk(k0, k1); }
        const unsigned sx = (k >> 1) & 7;
        *(LAS v4u*)(lds + HG_KT + 128 * k + 16 * ((2 * a) ^ sx)) = (v4u){w[0], w[1], w[2], w[3]};
        *(LAS v4u*)(lds + HG_KT + 128 * k + 16 * ((2 * a + 1) ^ sx)) = (v4u){w[4], w[5], w[6], w[7]};
    }
    if (!SAMPLE && a == 0) Dout[k] = ex2(Glast * LOG2E);
    __syncthreads();
    const int r32 = lane & 31, h = lane >> 5, kb = wid >> 1;
    const unsigned q4 = (lane & 15) >> 2, pp = lane & 3, bc = (lane >> 4) & 1;
    f32x16 acc[2] = {};
    const int krow = 32 * kb + r32; const unsigned sx = (krow >> 1) & 7;
#pragma unroll
    for (int s = 0; s < 4; ++s) {
        const bf16x8 af = *(const LAS bf16x8*)(lds + HG_KT + 128 * krow + 16 * ((unsigned)(2 * s + h) ^ sx));
#pragma unroll
        for (int vv = 0; vv < 2; ++vv) { const int vb = 2 * (wid & 1) + vv;
            const unsigned row0 = 16u * s + 8u * h + q4, row1 = row0 + 4u, chn = 4u * vb + 2u * bc + (pp >> 1);
            const unsigned x0 = (q4 << 2) | ((row0 >> 2) & 3u), x1 = (q4 << 2) | ((row1 >> 2) & 3u);
            const s16x4 lo = __builtin_amdgcn_ds_read_tr16_b64_v4i16((LAS s16x4*)(lds + HG_V + 256u * row0 + 16u * (chn ^ x0) + 8u * (pp & 1)));
            const s16x4 hi = __builtin_amdgcn_ds_read_tr16_b64_v4i16((LAS s16x4*)(lds + HG_V + 256u * row1 + 16u * (chn ^ x1) + 8u * (pp & 1)));
            const bf16x8 bfg = {lo[0], lo[1], lo[2], lo[3], hi[0], hi[1], hi[2], hi[3]};
            acc[vv] = __builtin_amdgcn_mfma_f32_32x32x16_bf16(af, bfg, acc[vv], 0, 0, 0); }
    }
    const LAS float* tot = (const LAS float*)(lds + HG_TOT);
#pragma unroll
    for (int vv = 0; vv < 2; ++vv) { const int v = 32 * (2 * (wid & 1) + vv) + r32;
#pragma unroll
        for (int r = 0; r < 16; ++r) { const int kk = 32 * kb + (r & 3) + 8 * (r >> 2) + 4 * h;
            float val = acc[vv][r];
            if (SAMPLE) { const float gl = (tot[kk] + tot[128 + kk]) + (tot[256 + kk] + tot[384 + kk]); val += ex2(gl * LOG2E) * S0[kk * 128 + v]; }
            if (SAMPLE) Sout[kk * 128 + v] = val;
            else { const float nb_ = __shfl_xor(val, 1);
                   if ((lane & 1) == 0) *(unsigned*)((bf16_t*)Sout + kk * 128 + v) = cvtpk(val, nb_); } } }
    __syncthreads();
}

template <bool SAMPLE>
__device__ __forceinline__ void hg_local(LAS unsigned char* lds, const bf16_t* KAp, const bf16_t* VAp, const float* Gp, int ntok, const float* S0, float* Sout, float* Dout, int tid, int wid, int lane) {
    asm volatile("" : "+v"(tid));
    HgIn I; hg_local_load(I, KAp, VAp, Gp, ntok, tid);
    hg_local_compute<SAMPLE>(lds, I, S0, Sout, Dout, tid, wid);
}

__device__ __forceinline__ void hg_output(LAS unsigned char* lds, const bf16_t* QAp, const bf16_t* KAp, const bf16_t* VAp, const float* Gp, const bf16_t* GAp, int ntok,
                                          const bf16_t* Sst16, const float* S0f, const float* anw, bf16_t* Outp  , int tid, int wid, int lane) {
    asm volatile("" : "+v"(tid)); lane = tid & 63;
    const int k = tid & 127, a = tid >> 7;
    float g[16]; hg_load_g(Gp, ntok, k, a, g);
    v4u vt[2]; hg_tile_load(VAp, ntok, tid, vt);
    unsigned short qr[16], kr[16];
#pragma unroll
    for (int j = 0; j < 16; ++j) { const int i = 16 * a + j; qr[j] = 0; kr[j] = 0; if (i < ntok) { qr[j] = QAp[(size_t)i * HW + k]; kr[j] = KAp[(size_t)i * HW + k]; } }
    v4u s16[4]; f32x4 s32[8];
    if (Sst16) {
#pragma unroll
        for (int i = 0; i < 4; ++i) { const int id = tid + 512 * i, row = id >> 4, ch = id & 15; s16[i] = *(const v4u*)(Sst16 + (size_t)row * 128 + ch * 8); }
    } else {
#pragma unroll
        for (int i = 0; i < 8; ++i) { const int id = tid + 512 * i, row = id >> 5, c4 = id & 31; s32[i] = *(const f32x4*)(S0f + (size_t)row * 128 + c4 * 4); }
    }
    v2u gwv[4]; f32x4 wwv[4];
    { const int lane_e = tid & 63, r32e = lane_e & 31, he = lane_e >> 5, vbe = wid & 3, ibe = wid >> 2, ie = 32 * ibe + r32e;
      const bf16_t* gp = GAp + (size_t)(ie < ntok ? ie : 0) * HW + 32 * vbe + 4 * he; const float* wp = anw + 32 * vbe + 4 * he;
#pragma unroll
      for (int g2 = 0; g2 < 4; ++g2) { gwv[g2] = *(const v2u*)(gp + 8 * g2); wwv[g2] = *(const f32x4*)(wp + 8 * g2); } }
    float Gc[16], Glast, Gmid;
    hg_scan(g, (LAS float*)(lds + HG_TOT), k, a, Gc, Glast, Gmid);
    hg_tile_write(lds + HG_V, tid, vt);
    if (Sst16) {
#pragma unroll
        for (int i = 0; i < 4; ++i) { const int id = tid + 512 * i, row = id >> 4, ch = id & 15; *(LAS v4u*)(lds + HG_SST + off_b(row, ch)) = s16[i]; }
    } else {
#pragma unroll
        for (int i = 0; i < 8; ++i) { const int id = tid + 512 * i, row = id >> 5, c4 = id & 31; const f32x4 v = s32[i];
            v2u w; w.x = cvtpk(v.x, v.y); w.y = cvtpk(v.z, v.w); *(LAS v2u*)(lds + HG_SST + off_b(row, c4 >> 1) + (c4 & 1) * 8) = w; }
    }
#pragma unroll
    for (int j = 0; j < 16; ++j) { const int i = 16 * a + j;
        const float q = bf2f(qr[j]), kk = bf2f(kr[j]);
        const float eq = ex2(Gc[j] * LOG2E), em = ex2(fminf((Gc[j] - Gmid) * LOG2E, 115.f)), ek = ex2(fminf((Gmid - Gc[j]) * LOG2E, 115.f));
        const unsigned o2 = off_b(i, k >> 3) + (k & 7) * 2;
        *(LAS bf16_t*)(lds + HG_QP + o2) = (bf16_t)(cvtpk(q * eq, 0.f) & 0xffffu);
        *(LAS bf16_t*)(lds + HG_QM + o2) = (bf16_t)(cvtpk(q * em, 0.f) & 0xffffu);
        *(LAS bf16_t*)(lds + HG_KM + o2) = (bf16_t)(cvtpk(kk * ek, 0.f) & 0xffffu); }
    __syncthreads();
    const int r32 = lane & 31, h = lane >> 5, vb = wid & 3, ib = wid >> 2;
    const unsigned q4 = (lane & 15) >> 2, pp = lane & 3, bc = (lane >> 4) & 1;
    f32x16 o = {};
    const bool active = (32 * ib < ntok);
    if (active) {
        const unsigned irow = 32u * ib + r32, ix = ((irow & 3u) << 2) | ((irow >> 2) & 3u);
#pragma unroll
        for (int s = 0; s < 8; ++s) {
            const bf16x8 bq = *(const LAS bf16x8*)(lds + HG_QP + 256u * irow + 16u * ((unsigned)(2 * s + h) ^ ix));
            const unsigned row0 = 16u * s + 8u * h + q4, row1 = row0 + 4u, chn = 4u * vb + 2u * bc + (pp >> 1);
            const unsigned x0 = (q4 << 2) | ((row0 >> 2) & 3u), x1 = (q4 << 2) | ((row1 >> 2) & 3u);
            const s16x4 lo = __builtin_amdgcn_ds_read_tr16_b64_v4i16((LAS s16x4*)(lds + HG_SST + 256u * row0 + 16u * (chn ^ x0) + 8u * (pp & 1)));
            const s16x4 hi = __builtin_amdgcn_ds_read_tr16_b64_v4i16((LAS s16x4*)(lds + HG_SST + 256u * row1 + 16u * (chn ^ x1) + 8u * (pp & 1)));
            const bf16x8 as = {lo[0], lo[1], lo[2], lo[3], hi[0], hi[1], hi[2], hi[3]};
            o = __builtin_amdgcn_mfma_f32_32x32x16_bf16(as, bq, o, 0, 0, 0);
        }
#pragma unroll
        for (int jb = 0; jb < 2; ++jb) {
            if (jb > ib) continue;
            f32x16 p = {};
            const unsigned jrow = 32u * jb + r32, jx = ((jrow & 3u) << 2) | ((jrow >> 2) & 3u);
#pragma unroll
            for (int s = 0; s < 8; ++s) {
                const bf16x8 ak = *(const LAS bf16x8*)(lds + HG_KM + 256u * jrow + 16u * ((unsigned)(2 * s + h) ^ jx));
                const bf16x8 bq = *(const LAS bf16x8*)(lds + HG_QM + 256u * irow + 16u * ((unsigned)(2 * s + h) ^ ix));
                p = __builtin_amdgcn_mfma_f32_32x32x16_bf16(ak, bq, p, 0, 0, 0);
            }
            float x[16];
#pragma unroll
            for (int r = 0; r < 16; ++r) { const int j = 32 * jb + (r & 3) + 8 * (r >> 2) + 4 * h, i = 32 * ib + r32; x[r] = (j <= i) ? p[r] : 0.f; }
#pragma unroll
            for (int ks = 0; ks < 2; ++ks) {
                v4u w; w.x = cvtpk(x[8 * ks], x[8 * ks + 1]); w.y = cvtpk(x[8 * ks + 2], x[8 * ks + 3]); w.z = cvtpk(x[8 * ks + 4], x[8 * ks + 5]); w.w = cvtpk(x[8 * ks + 6], x[8 * ks + 7]);
                const bf16x8 pk = __builtin_bit_cast(bf16x8, w);
                const unsigned row0 = 32u * jb + 16u * ks + 4u * h + q4, row1 = row0 + 8u, chn = 4u * vb + 2u * bc + (pp >> 1);
                const unsigned x0 = (q4 << 2) | ((unsigned)h & 3u), x1 = (q4 << 2) | (((unsigned)h + 2u) & 3u);
                const s16x4 lo = __builtin_amdgcn_ds_read_tr16_b64_v4i16((LAS s16x4*)(lds + HG_V + 256u * row0 + 16u * (chn ^ x0) + 8u * (pp & 1)));
                const s16x4 hi = __builtin_amdgcn_ds_read_tr16_b64_v4i16((LAS s16x4*)(lds + HG_V + 256u * row1 + 16u * (chn ^ x1) + 8u * (pp & 1)));
                const bf16x8 av = {lo[0], lo[1], lo[2], lo[3], hi[0], hi[1], hi[2], hi[3]};
                o = __builtin_amdgcn_mfma_f32_32x32x16_bf16(av, pk, o, 0, 0, 0);
            }
        }
    }
    float ss = 0.f;
#pragma unroll
    for (int r = 0; r < 16; ++r) ss += o[r] * o[r];
    { auto rr = __builtin_amdgcn_permlane32_swap(__float_as_uint(ss), __float_as_uint(ss), false, false); ss = __uint_as_float(rr[0]) + __uint_as_float(rr[1]); }
    LAS float* red = (LAS float*)(lds + HG_RED);
    if (h == 0) red[(ib * 4 + vb) * 32 + r32] = ss;
    __syncthreads();
    const int i = 32 * ib + r32;
    if (active && i < ntok) {
        const float tot = (red[(ib * 4 + 0) * 32 + r32] + red[(ib * 4 + 1) * 32 + r32]) + (red[(ib * 4 + 2) * 32 + r32] + red[(ib * 4 + 3) * 32 + r32]);
        const float rn = rsqrtf(tot * (1.f / 128.f) + EPS);
        bf16_t* op = Outp + (size_t)i * DM + 32 * vb + 4 * h;
#pragma unroll
        for (int g = 0; g < 4; ++g) { const v2u gw = gwv[g]; const f32x4 ww = wwv[g];
            v2u w; w.x = cvtpk(o[4 * g] * rn * ww.x * bflo(gw.x), o[4 * g + 1] * rn * ww.y * bfhi(gw.x)); w.y = cvtpk(o[4 * g + 2] * rn * ww.z * bflo(gw.y), o[4 * g + 3] * rn * ww.w * bfhi(gw.y));
            *(v2u*)(op + 8 * g) = w; }
    }
    __syncthreads();
}
struct HgOutIn { float g[16]; v4u vt[2]; unsigned short qr[16], kr[16]; v4u s16[4]; v2u gwv[4]; };
__device__ __forceinline__ void hg_out_load(HgOutIn& I, const bf16_t* QAp, const bf16_t* KAp, const bf16_t* VAp, const float* Gp, const bf16_t* GAp, const bf16_t* Sst16, int tid, int wid) {
    const int k = tid & 127, a = tid >> 7;
    hg_load_g(Gp, 64, k, a, I.g);
    hg_tile_load(VAp, 64, tid, I.vt);
#pragma unroll
    for (int j = 0; j < 16; ++j) { const int i = 16 * a + j; I.qr[j] = QAp[(size_t)i * HW + k]; I.kr[j] = KAp[(size_t)i * HW + k]; }
#pragma unroll
    for (int i = 0; i < 4; ++i) { const int id = tid + 512 * i, row = id >> 4, ch = id & 15; I.s16[i] = *(const v4u*)(Sst16 + (size_t)row * 128 + ch * 8); }
    { const int lane_e = tid & 63, r32e = lane_e & 31, he = lane_e >> 5, vbe = wid & 3, ibe = wid >> 2, ie = 32 * ibe + r32e;
      const bf16_t* gp = GAp + (size_t)ie * HW + 32 * vbe + 4 * he;
#pragma unroll
      for (int g2 = 0; g2 < 4; ++g2) I.gwv[g2] = *(const v2u*)(gp + 8 * g2); }
}
__device__ __forceinline__ void hg_out_stage(LAS unsigned char* lds, const HgOutIn& I, int tid) {
    const int k = tid & 127, a = tid >> 7;
    float Gc[16], Glast, Gmid;
    hg_scan(I.g, (LAS float*)(lds + HG_TOT), k, a, Gc, Glast, Gmid);
    hg_tile_write(lds + HG_V, tid, I.vt);
#pragma unroll
    for (int i = 0; i < 4; ++i) { const int id = tid + 512 * i, row = id >> 4, ch = id & 15; *(LAS v4u*)(lds + HG_SST + off_b(row, ch)) = I.s16[i]; }
#pragma unroll
    for (int j = 0; j < 16; ++j) { const int i = 16 * a + j;
        const float q = bf2f(I.qr[j]), kk = bf2f(I.kr[j]);
        const float eq = ex2(Gc[j] * LOG2E), em = ex2(fminf((Gc[j] - Gmid) * LOG2E, 115.f)), ek = ex2(fminf((Gmid - Gc[j]) * LOG2E, 115.f));
        const unsigned o2 = off_b(i, k >> 3) + (k & 7) * 2;
        *(LAS bf16_t*)(lds + HG_QP + o2) = (bf16_t)(cvtpk(q * eq, 0.f) & 0xffffu);
        *(LAS bf16_t*)(lds + HG_QM + o2) = (bf16_t)(cvtpk(q * em, 0.f) & 0xffffu);
        *(LAS bf16_t*)(lds + HG_KM + o2) = (bf16_t)(cvtpk(kk * ek, 0.f) & 0xffffu); }
}
__device__ __forceinline__ void hg_out_compute(LAS unsigned char* lds, const v2u (&gwv)[4], const f32x4 (&wwv)[4], bf16_t* Outp, int tid, int wid) {
    constexpr int ntok = 64;
    const int lane = tid & 63;
    const int r32 = lane & 31, h = lane >> 5, vb = wid & 3, ib = wid >> 2;
    const unsigned q4 = (lane & 15) >> 2, pp = lane & 3, bc = (lane >> 4) & 1;
    f32x16 o = {};
    const bool active = (32 * ib < ntok);
    if (active) {
        const unsigned irow = 32u * ib + r32, ix = ((irow & 3u) << 2) | ((irow >> 2) & 3u);
#pragma unroll
        for (int s = 0; s < 8; ++s) {
            const bf16x8 bq = *(const LAS bf16x8*)(lds + HG_QP + 256u * irow + 16u * ((unsigned)(2 * s + h) ^ ix));
            const unsigned row0 = 16u * s + 8u * h + q4, row1 = row0 + 4u, chn = 4u * vb + 2u * bc + (pp >> 1);
            const unsigned x0 = (q4 << 2) | ((row0 >> 2) & 3u), x1 = (q4 << 2) | ((row1 >> 2) & 3u);
            const s16x4 lo = __builtin_amdgcn_ds_read_tr16_b64_v4i16((LAS s16x4*)(lds + HG_SST + 256u * row0 + 16u * (chn ^ x0) + 8u * (pp & 1)));
            const s16x4 hi = __builtin_amdgcn_ds_read_tr16_b64_v4i16((LAS s16x4*)(lds + HG_SST + 256u * row1 + 16u * (chn ^ x1) + 8u * (pp & 1)));
            const bf16x8 as = {lo[0], lo[1], lo[2], lo[3], hi[0], hi[1], hi[2], hi[3]};
            o = __builtin_amdgcn_mfma_f32_32x32x16_bf16(as, bq, o, 0, 0, 0);
        }
#pragma unroll
        for (int jb = 0; jb < 2; ++jb) {
            if (jb > ib) continue;
            f32x16 p = {};
            const unsigned jrow = 32u * jb + r32, jx = ((jrow & 3u) << 2) | ((jrow >> 2) & 3u);
#pragma unroll
            for (int s = 0; s < 8; ++s) {
                const bf16x8 ak = *(const LAS bf16x8*)(lds + HG_KM + 256u * jrow + 16u * ((unsigned)(2 * s + h) ^ jx));
                const bf16x8 bq = *(const LAS bf16x8*)(lds + HG_QM + 256u * irow + 16u * ((unsigned)(2 * s + h) ^ ix));
                p = __builtin_amdgcn_mfma_f32_32x32x16_bf16(ak, bq, p, 0, 0, 0);
            }
            float x[16];
#pragma unroll
            for (int r = 0; r < 16; ++r) { const int j = 32 * jb + (r & 3) + 8 * (r >> 2) + 4 * h, i = 32 * ib + r32; x[r] = (j <= i) ? p[r] : 0.f; }
#pragma unroll
            for (int ks = 0; ks < 2; ++ks) {
                v4u w; w.x = cvtpk(x[8 * ks], x[8 * ks + 1]); w.y = cvtpk(x[8 * ks + 2], x[8 * ks + 3]); w.z = cvtpk(x[8 * ks + 4], x[8 * ks + 5]); w.w = cvtpk(x[8 * ks + 6], x[8 * ks + 7]);
                const bf16x8 pk = __builtin_bit_cast(bf16x8, w);
                const unsigned row0 = 32u * jb + 16u * ks + 4u * h + q4, row1 = row0 + 8u, chn = 4u * vb + 2u * bc + (pp >> 1);
                const unsigned x0 = (q4 << 2) | ((unsigned)h & 3u), x1 = (q4 << 2) | (((unsigned)h + 2u) & 3u);
                const s16x4 lo = __builtin_amdgcn_ds_read_tr16_b64_v4i16((LAS s16x4*)(lds + HG_V + 256u * row0 + 16u * (chn ^ x0) + 8u * (pp & 1)));
                const s16x4 hi = __builtin_amdgcn_ds_read_tr16_b64_v4i16((LAS s16x4*)(lds + HG_V + 256u * row1 + 16u * (chn ^ x1) + 8u * (pp & 1)));
                const bf16x8 av = {lo[0], lo[1], lo[2], lo[3], hi[0], hi[1], hi[2], hi[3]};
                o = __builtin_amdgcn_mfma_f32_32x32x16_bf16(av, pk, o, 0, 0, 0);
            }
        }
    }
    float ss = 0.f;
#pragma unroll
    for (int r = 0; r < 16; ++r) ss += o[r] * o[r];
    { auto rr = __builtin_amdgcn_permlane32_swap(__float_as_uint(ss), __float_as_uint(ss), false, false); ss = __uint_as_float(rr[0]) + __uint_as_float(rr[1]); }
    LAS float* red = (LAS float*)(lds + HG_RED);
    if (h == 0) red[(ib * 4 + vb) * 32 + r32] = ss;
    __syncthreads();
    const int i = 32 * ib + r32;
    if (active && i < ntok) {
        const float tot = (red[(ib * 4 + 0) * 32 + r32] + red[(ib * 4 + 1) * 32 + r32]) + (red[(ib * 4 + 2) * 32 + r32] + red[(ib * 4 + 3) * 32 + r32]);
        const float rn = rsqrtf(tot * (1.f / 128.f) + EPS);
        bf16_t* op = Outp + (size_t)i * DM + 32 * vb + 4 * h;
#pragma unroll
        for (int g = 0; g < 4; ++g) { const v2u gw = gwv[g]; const f32x4 ww = wwv[g];
            v2u w; w.x = cvtpk(o[4 * g] * rn * ww.x * bflo(gw.x), o[4 * g + 1] * rn * ww.y * bfhi(gw.x)); w.y = cvtpk(o[4 * g + 2] * rn * ww.z * bflo(gw.y), o[4 * g + 3] * rn * ww.w * bfhi(gw.y));
            *(v2u*)(op + 8 * g) = w; }
    }
    __syncthreads();
}

#ifndef MK_FUSED
#define MK_FUSED 1
#endif
#ifndef MK_DEBUG
#define MK_DEBUG 0
#endif

constexpr int FI3 = (DM / 64) * (N1 / 64) + DM / 64, FI4 = (DM / 64) * (DM / 64), FILL_P1 = 6000;
__device__ __forceinline__ void w3_item(const float* w_in_odd, bf16_t* W3T, LAS float* scr, int it, int lane) {
    if (it < (DM / 64) * (N1 / 64)) p0_transpose_item64(w_in_odd, DM, N3R, W3T, scr, it, lane);
    else p0_transpose_item(w_in_odd, DM, N3R, W3T, scr, (it - (DM / 64) * (N1 / 64)) * (N3R / 32) + (N3R / 32 - 1), lane);
}
__device__ __forceinline__ void filler_static(bool w3, int first, int stride, int lo, int hi, const float* w_in_odd, const float* w_out_odd, bf16_t* W3T, bf16_t* W4T, LAS float* scr, int lane) {
    for (int it = lo + first; it < hi; it += stride) { if (w3) w3_item(w_in_odd, W3T, scr, it, lane); else p0_transpose_item64(w_out_odd, DM, DM, W4T, scr, it, lane); }
}
__device__ __forceinline__ void filler_drain(unsigned* fq, int lo, int hi, const float* w_in_odd, bf16_t* W3T, LAS float* scr, int lane) {
    for (;;) {
        int it = 0; if (lane == 0) it = (int)atomicAdd(fq, 4u);
        it = lo + __builtin_amdgcn_readfirstlane(it);
        if (it >= hi) break;
        const int e4 = (it + 4 < hi) ? it + 4 : hi;
        for (; it < e4; ++it) w3_item(w_in_odd, W3T, scr, it, lane);
    }
}
struct OneUnit { int pm, pn, hf;
    __device__ __forceinline__ bool next(int i, pg8::Unit& u) const { if (i) return false; u.pm = pm; u.pn = pn; u.hf = hf; return true; }
    __device__ __forceinline__ void a_ready(const pg8::Unit&) const {}
    __device__ __forceinline__ void done(const pg8::Unit&) const {} };
struct Args { const float* in[17]; float* out; unsigned char* ws; int ph_lo, ph_hi; };
constexpr int NPHASE = 11;

#define TIDX (wid0 * 64 + (int)__builtin_amdgcn_mbcnt_hi(~0u, __builtin_amdgcn_mbcnt_lo(~0u, 0u)))
#define PH_TID int tid = TIDX; asm volatile("" : "+v"(tid)); const int lane = tid & 63; (void)lane;
#define PH_PTRS const int wid = wid0; const int gw = bx * NWAVES + wid; (void)gw; unsigned char* ws_ = args.ws; unsigned* ctl_ = (unsigned*)(ws_ + WS_CTL); (void)ctl_; const float* x_prompt = args.in[0]; const float* x_sample = args.in[1]; const float* state_a = args.in[2]; const float* cache_b_k = args.in[3]; const float* cache_b_v = args.in[4]; const float* cache_c_k = args.in[5]; const float* cache_c_v = args.in[6]; const float* cache_c_logf = args.in[7]; const float* norm_w = args.in[8]; const float* final_w = args.in[9]; const float* w_in_even = args.in[10]; const float* w_out_even = args.in[11]; const float* lb_logits = args.in[12]; const float* a_norm_w = args.in[13]; const float* w_in_odd = args.in[14]; const float* b_forget = args.in[15]; const float* w_out_odd = args.in[16]; float* out = args.out; bf16_t* W1T = (bf16_t*)(ws_ + WS_W1T); bf16_t* W2T = (bf16_t*)(ws_ + WS_W2T); bf16_t* W3T = (bf16_t*)(ws_ + WS_W3T); bf16_t* W4T = (bf16_t*)(ws_ + WS_W4T); bf16_t* XN = (bf16_t*)(ws_ + WS_XN); bf16_t* P = (bf16_t*)(ws_ + WS_P); float* Gb = (float*)(ws_ + WS_G); bf16_t* A = (bf16_t*)(ws_ + WS_A); float* H1 = (float*)(ws_ + WS_H1); float* SLOC = (float*)(ws_ + WS_SLOC); bf16_t* SST = (bf16_t*)(ws_ + WS_SST); float* DEC = (float*)(ws_ + WS_DEC); float* FL = (float*)(ws_ + WS_FL); float* FCP = (float*)(ws_ + WS_FCP); float* FCS = (float*)(ws_ + WS_FCS); float* LB = (float*)(ws_ + WS_LB); unsigned long long* RS1 = (unsigned long long*)(ctl_ + CW_RS1); unsigned long long* RS2 = (unsigned long long*)(ctl_ + CW_RS2); bf16_t* QA = P; bf16_t* KA = P + PSTR1; bf16_t* VA = P + 2 * PSTR1; bf16_t* GA = P + 3 * PSTR1; bf16_t* QB = P + 4 * PSTR1; bf16_t* KB = P + 5 * PSTR1; bf16_t* VB = P + 6 * PSTR1; bf16_t* GB = P + 7 * PSTR1; bf16_t* P3 = (bf16_t*)(ws_ + WS_P3); bf16_t* QC = P3; bf16_t* KC = P3 + PSTR3; bf16_t* VC = P3 + 2 * PSTR3; bf16_t* GC = P3 + 3 * PSTR3;
__global__ void __launch_bounds__(NWAVES * 64, 2) fwd_kernel(Args args) {
    extern __shared__ __attribute__((aligned(16))) unsigned char lds_raw[];
    LAS unsigned char* lds = (LAS unsigned char*)lds_raw;
    const int tid0 = threadIdx.x;
    const int wid0 = __builtin_amdgcn_readfirstlane(tid0 >> 6);
    const int G = gridDim.x, bx = blockIdx.x;
    const int NGW = G * NWAVES;
    unsigned char* ws = args.ws;
    unsigned* ctl = (unsigned*)(ws + WS_CTL);
    volatile LAS unsigned* MISC = (volatile LAS unsigned*)(lds + MISC_OFF);
    for (int u = tid0; u < (LDS_BYTES - RING_BYTES) / 4; u += NWAVES * 64) ((LAS unsigned*)(lds + RING_BYTES))[u] = 0u;
    __syncthreads();
    const int lo = args.ph_lo, hi = args.ph_hi;
    const bool fused = (hi - lo) > 1;
    XcdBarrier bar; bar.bar = ctl + CW_BAR; bar.x = 0; bar.st = nullptr;
    if (fused) bar = xcd_barrier_post(ctl + CW_BAR, MISC + 8);
#ifdef ONLY
#define IN(k) ((k) == ONLY && lo <= (k) && (k) < hi)
#else
#define IN(k) (lo <= (k) && (k) < hi)
#endif
#ifndef DUP_MASK
#define DUP_MASK 0
#endif
#define REP(k) for (int rep_ = 0; rep_ < (((DUP_MASK >> (k)) & 1) ? 2 : 1); ++rep_)
#define SEAM(k) do { if (IN(k) && IN((k) + 1)) xcd_barrier(bar, wid0); } while (0)

    if (IN(0)) REP(0) { PH_PTRS PH_TID
        LAS float* scr = (LAS float*)(lds + wid * 16384);
        constexpr int I1 = (DM / 64) * (N1 / 64), I2 = (DM / 64) * (DM / 64);
        for (int it = gw; it < I1 + I2; it += NGW) {
            if (it < I1) p0_transpose_item64(w_in_even, DM, N1, W1T, scr, it, lane);
            else p0_transpose_item64(w_out_even, DM, DM, W2T, scr, it - I1, lane);
        }
        for (int m = gw; m < MROWS; m += NGW) norm_row_to_bf16(m < TP ? x_prompt + (size_t)m * DM : x_sample + (size_t)(m - TP) * DM, norm_w, XN + (size_t)m * DM, lane);
        {
            v4u* z = (v4u*)(W3T + (size_t)N3R * DM); const size_t n16 = (size_t)(N3 - N3R) * DM / 8;
            for (size_t i = (size_t)bx * 512 + tid; i < n16; i += (size_t)G * 512) z[i] = (v4u){0u, 0u, 0u, 0u};
        }
        for (int c = bx * 512 + tid; c < HW; c += G * 512) LB[c] = rcpf_(1.f + __expf(lb_logits[HW + c] - lb_logits[c]));
    }
    SEAM(0);
    if (IN(1)) REP(1) { PH_PTRS PH_TID
        { pg8::Gemm g{XN, W1T, TP, N1, DM}; pg8::StaticOrder S; S.init(TP, N1, G, bx);
          Epi1 E{P, Gb, LB, out};
          pg8::gemm_phase<Epi1, pg8::StaticOrder, true, true>(lds, g, S, E, tid); }
        for (int hu = bx; hu < 128; hu += G) { pg8::Gemm g{XN, W1T, MROWS, N1, DM}; OneUnit S{32, hu >> 1, hu & 1};
            Epi1 E{P, Gb, LB, out};
            pg8::gemm_phase<Epi1, OneUnit, true, true, true>(lds, g, S, E, tid); }
        if (G > 128) { if (bx >= 128) filler_static(true, (bx - 128) * NWAVES + wid, (G - 128) * NWAVES, 0, FILL_P1, w_in_odd, w_out_odd, W3T, W4T, (LAS float*)(lds + wid * 16384), lane); }
        else filler_static(true, gw, NGW, 0, FILL_P1, w_in_odd, w_out_odd, W3T, W4T, (LAS float*)(lds + wid * 16384), lane);
    }
    SEAM(1);
    if (IN(2)) REP(2) { PH_PTRS
#ifndef P2SUB
#define P2SUB 31
#endif
#ifndef P2REP
#define P2REP 0
#endif
#define R2(bit) for (int r2_ = 0; r2_ < ((P2REP & (bit)) ? 3 : 1); ++r2_)
        if (P2SUB & 2) R2(2) for (int u = bx; u < NSB * NH_B; u += G) attn_sample_sb_unit(lds, u >> 4, u & 15, QB, KB, VB, GB, cache_b_k, cache_b_v, A, TIDX, wid);
        if (P2SUB & 4) R2(4) {
            int tid = TIDX; asm volatile("" : "+v"(tid));
            HgIn I;
            if (bx < NH_A * 128) { const size_t ro = (size_t)(64 * (bx & 127)) * HW + (bx >> 7) * HD; hg_local_load(I, KA + ro, VA + ro, Gb + ro, 64, tid); }
            for (int u = bx; u < NH_A * 128; u += G) {
                HgIn N; const int un = u + G;
                if (un < NH_A * 128) { const size_t ro = (size_t)(64 * (un & 127)) * HW + (un >> 7) * HD; hg_local_load(N, KA + ro, VA + ro, Gb + ro, 64, tid); }
                hg_local_compute<false>(lds, I, nullptr, SLOC + (size_t)u * 8192  , DEC + (size_t)u * 128, tid, wid);
                if (un < NH_A * 128) I = N;
            }
        }
        if (P2SUB & 8) R2(8) for (int u = bx; u < NSB * NH_A; u += G) { const int b = u >> 4, hd = u & 15; const size_t ro = (size_t)(TP + 16 * b) * HW + hd * HD; const float* S0 = state_a + (size_t)u * 16384;
            hg_local<true>(lds, KA + ro, VA + ro, Gb + ro, 16, S0, out + O_SAS + (size_t)u * 16384, nullptr, TIDX, wid, 0); }
        if (P2SUB & 16) R2(16) for (int u = bx; u < NSB * NH_A; u += G) { const int b = u >> 4, hd = u & 15; const size_t ro = (size_t)(TP + 16 * b) * HW + hd * HD; const float* S0 = state_a + (size_t)u * 16384;
            hg_output(lds, QA + ro, KA + ro, VA + ro, Gb + ro, GA + ro, 16, nullptr, S0, a_norm_w, A + (size_t)(TP + 16 * b) * DM + hd * HD, TIDX, wid, 0); }
    }
    SEAM(2);
    if (IN(3)) REP(3) { PH_PTRS PH_TID
        const int NG = (G >= 128) ? 32 : 0, NSCAN = (G >= 128) ? 64 : G;
        if (bx < NG) {
            pg8::Gemm g{A, W2T, MROWS, DM, DM}; OneUnit S{32, bx >> 1, bx & 1};
            EpiRes<true> E{x_prompt, x_sample, H1, XN, norm_w + DM, RS1};
            pg8::gemm_phase<EpiRes<true>, OneUnit, true, true, true>(lds, g, S, E, tid);
        } else if (bx < NG + NSCAN) { const int sb = bx - NG;
            if (NSCAN == 64) {
                const unsigned* sl[4]; const float* dc[4]; unsigned* so[4]; float s0[4], s1[4];
#pragma unroll
                for (int j = 0; j < 4; ++j) { const int e = sb * 512 + tid + j * 32768; const int hd = e >> 13, k = (e >> 6) & 127, vp = e & 63;
                    sl[j] = (const unsigned*)SLOC + (size_t)hd * 128 * 8192 + k * 64 + vp; dc[j] = DEC + (size_t)hd * 128 * 128 + k; so[j] = (unsigned*)(SST + (size_t)hd * 128 * 16384 + k * 128 + 2 * vp); s0[j] = 0.f; s1[j] = 0.f; }
#pragma unroll 4
                for (int c = 0; c < 128; ++c) {
#pragma unroll
                    for (int j = 0; j < 4; ++j) { const unsigned lw = sl[j][(size_t)c * 8192]; const float d = dc[j][c * 128];
                        so[j][(size_t)c * 8192] = cvtpk(s0[j], s1[j]); s0[j] = fmaf(d, s0[j], bflo(lw)); s1[j] = fmaf(d, s1[j], bfhi(lw)); } }
#pragma unroll
                for (int j = 0; j < 4; ++j) { const int e = sb * 512 + tid + j * 32768; const int hd = e >> 13, k = (e >> 6) & 127, vp = e & 63;
                    *(f32x2*)(out + O_SAP + (size_t)hd * 16384 + k * 128 + 2 * vp) = (f32x2){s0[j], s1[j]}; }
            } else
            for (int e = sb * 512 + tid; e < NH_A * 128 * 64; e += NSCAN * 512) {
                const int hd = e >> 13, k = (e >> 6) & 127, vp = e & 63;
                const unsigned* sl = (const unsigned*)SLOC + (size_t)hd * 128 * 8192 + k * 64 + vp;
                const float* dc = DEC + (size_t)hd * 128 * 128 + k;
                unsigned* so = (unsigned*)(SST + (size_t)hd * 128 * 16384 + k * 128 + 2 * vp);
                float s0 = 0.f, s1 = 0.f;
#pragma unroll 16
                for (int c = 0; c < 128; ++c) { const unsigned lw = sl[(size_t)c * 8192]; const float d = dc[c * 128];
                    so[(size_t)c * 8192] = cvtpk(s0, s1); s0 = fmaf(d, s0, bflo(lw)); s1 = fmaf(d, s1, bfhi(lw)); }
                *(f32x2*)(out + O_SAP + (size_t)hd * 16384 + k * 128 + 2 * vp) = (f32x2){s0, s1};
            }
        }
        if (G < 128) {
            for (int u = bx; u < 32; u += G) { pg8::Gemm g{A, W2T, MROWS, DM, DM}; OneUnit S{32, u >> 1, u & 1}; EpiRes<true> E{x_prompt, x_sample, H1, XN, norm_w + DM, RS1};
                pg8::gemm_phase<EpiRes<true>, OneUnit, true, true, true>(lds, g, S, E, tid); } }
        __syncthreads();
        {
            unsigned* wq = ctl_ + CW_WQ3;
            const int grp = wid >> 2, gw = wid & 3; const int gtid = gw * 64 + (TIDX & 63);
            LAS unsigned char* gl = lds + grp * 65536; LAS unsigned char* gx = lds + RING_BYTES + 2048 + grp * 1024;
            GBar gb; gb.cnt = (volatile LAS unsigned*)(gx + 832); gb.tgt = 0u;
            if (gtid == 0) *gb.cnt = 0u;
            __syncthreads();
            volatile LAS int* wqg = (volatile LAS int*)(gx + 768);
            for (;;) {
                if (gtid == 0) wqg[0] = (int)atomicAdd(wq, 1u);
                gbar_sync(gb, gtid & 63);
                const int u = wqg[0];
                gbar_sync(gb, gtid & 63);
                if (u >= NH_B * 64) break;
                const int hd = u & 15, qb = 63 - (u >> 4);
                attn_prompt_group<0>(gl, gx, gb, QB, KB, VB, GB, HW, hd, qb, A, HW + hd * HD, nullptr, gtid, gw, 0.f);
            }
        }
        __syncthreads();
        filler_drain(ctl_ + CW_FQ, FILL_P1, FI3, w_in_odd, W3T, (LAS float*)(lds + wid * 16384), TIDX & 63);
    }
    SEAM(3);
    if (IN(4)) REP(4) { PH_PTRS
        unsigned* wq = ctl_ + CW_WQ4;
        volatile LAS int* wql = (volatile LAS int*)(lds + RING_BYTES + 1024);
        constexpr int HG_END = 129 + NH_A * 128;
        int item;
        for (;;) {
            if (TIDX == 0) wql[0] = (int)atomicAdd(wq, 1u);
            __syncthreads();
            item = wql[0];
            __syncthreads();
            if (item >= 129) break;
            int tid = TIDX; asm volatile("" : "+v"(tid));
            pg8::Gemm g{XN, W3T, MROWS, N3, DM}; OneUnit S{32, item >> 1, item & 1};
            Epi3 E{P3, RS1, FL, b_forget, out};
            pg8::gemm_phase<Epi3, OneUnit, true, true, true>(lds, g, S, E, tid);
        }
        if (item < HG_END) {
            HgOutIn R;
#define HG_PTRS(it_) const int u_ = (it_) - 129, hd_ = u_ >> 7, c_ = u_ & 127; const size_t ro_ = (size_t)(64 * c_) * HW + hd_ * HD;
            { HG_PTRS(item); int t_ = TIDX; asm volatile("" : "+v"(t_)); hg_out_load(R, QA + ro_, KA + ro_, VA + ro_, Gb + ro_, GA + ro_, SST + (size_t)u_ * 16384, t_, wid); }
            for (;;) {
                int nx = 0;
                if (TIDX == 0) nx = (int)atomicAdd(wq, 1u);
                int t_ = TIDX; asm volatile("" : "+v"(t_));
                hg_out_stage(lds, R, t_);
                if (TIDX == 0) wql[0] = nx;
                __syncthreads();
                const int nitem = wql[0];
                v2u gwc[4]; f32x4 wwc[4];
#pragma unroll
                for (int g2 = 0; g2 < 4; ++g2) { gwc[g2] = R.gwv[g2]; wwc[g2] = *(const f32x4*)(a_norm_w + 32 * (wid & 3) + 4 * ((t_ >> 5) & 1) + 8 * g2); }
                bf16_t* outp; { HG_PTRS(item); outp = A + (size_t)(64 * c_) * DM + hd_ * HD; }
                if (nitem < HG_END) { HG_PTRS(nitem); hg_out_load(R, QA + ro_, KA + ro_, VA + ro_, Gb + ro_, GA + ro_, SST + (size_t)u_ * 16384, t_, wid); }
                hg_out_compute(lds, gwc, wwc, outp, t_, wid);
                if (nitem >= HG_END) break;
                item = nitem;
            }
#undef HG_PTRS
        }
        { unsigned* fq = ctl_ + CW_FQ + 64;
          const int lane_ = TIDX & 63; LAS float* scr_ = (LAS float*)(lds + wid * 16384);
          for (;;) { int it = 0; if (lane_ == 0) it = (int)atomicAdd(fq, 4u); it = __builtin_amdgcn_readfirstlane(it); if (it >= FI4) break;
              const int e4 = (it + 4 < FI4) ? it + 4 : FI4; for (; it < e4; ++it) p0_transpose_item64(w_out_odd, DM, DM, W4T, scr_, it, lane_); } }
    }
    SEAM(4);
    if (IN(5)) REP(5) { PH_PTRS PH_TID
        pg8::Gemm g{A, W2T, TP, DM, DM}; pg8::StaticOrder S; S.init(TP, DM, G, bx);
        EpiRes<true> E{x_prompt, x_sample, H1, XN, norm_w + DM, RS1};
        pg8::gemm_phase<EpiRes<true>, pg8::StaticOrder, true, true>(lds, g, S, E, tid);
    }
    SEAM(5);
    if (IN(6)) REP(6) { PH_PTRS PH_TID
        pg8::Gemm g{XN, W3T, TP, N1, DM}; pg8::StaticOrder S; S.init(TP, N1, G, bx);
        Epi3 E{P3, RS1, FL, b_forget, out};
        pg8::gemm_phase<Epi3, pg8::StaticOrder, true, true>(lds, g, S, E, tid);
        for (int rb = bx; rb < TP / 32; rb += G) fl_rows(lds, XN, W3T + (size_t)N1 * DM, RS1, b_forget, FL, out + O_CFP, 32 * rb, tid, wid);
    }
    SEAM(6);
    if (IN(7)) REP(7) { PH_PTRS PH_TID
        LAS float* scr = (LAS float*)(lds + 1024);
        for (int u = bx; u < NH_C; u += G) { const int hd = u; float v[16];
#pragma unroll
            for (int j = 0; j < 16; ++j) v[j] = FL[(size_t)(tid * 16 + j) * 32 + hd] * -NFRS;
            wg_scan<16>(v, scr, tid, wid, lane);
#pragma unroll
            for (int j = 0; j < 16; j += 4) *(f32x4*)(FCP + (size_t)hd * TP + tid * 16 + j) = (f32x4){v[j], v[j + 1], v[j + 2], v[j + 3]};
        }
        {
            unsigned* KN2 = ctl_ + CW_KN2;
            for (int u = bx; u < NH_C * 8; u += G) { const int hd = u >> 3, part = u & 7; float mx = 0.f;
#pragma unroll
                for (int kk = 0; kk < 2; ++kk) { const int key = part * 1024 + tid * 2 + kk; const v4u* kp = (const v4u*)(KC + (size_t)key * DM + hd * HD); float s2 = 0.f;
#pragma unroll
                    for (int c8 = 0; c8 < 16; ++c8) { const v4u w = kp[c8]; const float a0 = bflo(w.x), a1 = bfhi(w.x), a2 = bflo(w.y), a3 = bfhi(w.y), a4 = bflo(w.z), a5 = bfhi(w.z), a6 = bflo(w.w), a7 = bfhi(w.w);
                        s2 += (a0 * a0 + a1 * a1) + (a2 * a2 + a3 * a3) + (a4 * a4 + a5 * a5) + (a6 * a6 + a7 * a7); }
                    mx = fmaxf(mx, s2); }
#pragma unroll
                for (int o = 32; o >= 1; o >>= 1) mx = fmaxf(mx, __shfl_xor(mx, o));
                if (lane == 0) atomicMax(KN2 + hd, __float_as_uint(mx)); }
        }
        __syncthreads();
        for (int u = bx; u < NSB * NH_C; u += G) attn_sample_fox_unit(lds, u >> 5, u & 31, QC, KC, VC, GC, cache_c_k, cache_c_v, cache_c_logf, FL, A, tid, wid, lane);
    }
    SEAM(7);
    if (IN(8)) REP(8) { PH_PTRS
        { unsigned* wq0 = ctl_ + CW_WQ; volatile LAS int* wql = (volatile LAS int*)(lds + RING_BYTES + 1024);
          for (;;) {
            if (TIDX == 0) wql[0] = (int)atomicAdd(wq0, 1u);
            __syncthreads();
            const int item = wql[0];
            __syncthreads();
            if (item >= 32) break;
            int tid = TIDX; asm volatile("" : "+v"(tid));
            pg8::Gemm g{A, W4T, MROWS, DM, DM}; OneUnit S{32, item >> 1, item & 1};
            EpiRes<false> E{H1, H1 + (size_t)TP * DM, out, nullptr, nullptr, RS2};
            pg8::gemm_phase<EpiRes<false>, OneUnit, true, true, true>(lds, g, S, E, tid);
          } }
        { unsigned* wq = ctl_ + CW_WQ + 16; const unsigned* KN2 = ctl_ + CW_KN2;
          const int grp = wid >> 2, gw = wid & 3; const int gtid = gw * 64 + (TIDX & 63);
          LAS unsigned char* gl = lds + grp * 65536; LAS unsigned char* gx = lds + RING_BYTES + 2048 + grp * 1024;
          GBar gb; gb.cnt = (volatile LAS unsigned*)(gx + 832); gb.tgt = 0u;
          if (gtid == 0) *gb.cnt = 0u;
          __syncthreads();
          volatile LAS int* wqg = (volatile LAS int*)(gx + 768);
          for (;;) {
            if (gtid == 0) wqg[0] = (int)atomicAdd(wq, 1u);
            gbar_sync(gb, gtid & 63);
            const int item = wqg[0];
            gbar_sync(gb, gtid & 63);
            if (item >= 2048) break;
            const int hd = item & 31, qb = 63 - (item >> 5);
            attn_prompt_group<1>(gl, gx, gb, QC, KC, VC, GC, DM, hd, qb, A, hd * HD, FCP + (size_t)hd * TP, gtid, gw, sqrtf(__uint_as_float(KN2[hd])) * QK2);
          }
          __syncthreads(); }
    }
    SEAM(8);
    if (IN(9)) REP(9) { PH_PTRS PH_TID
        pg8::Gemm g{A, W4T, TP, DM, DM}; pg8::StaticOrder S; S.init(TP, DM, G, bx);
        EpiRes<false> E{H1, H1 + (size_t)TP * DM, out, nullptr, nullptr, RS2};
        pg8::gemm_phase<EpiRes<false>, pg8::StaticOrder, true, true>(lds, g, S, E, tid);
    }
    SEAM(9);
    if (IN(10)) REP(10) { PH_PTRS PH_TID
        for (int m = gw; m < MROWS; m += NGW) {
            const float r = rsqrtf((float)RS2[m] * (1.f / (FIX * 4096.f)) + EPS);
            f32x4* yr = (f32x4*)(out + (size_t)m * DM) + lane; const f32x4* wr_ = (const f32x4*)final_w + lane;
#pragma unroll
            for (int j = 0; j < 16; ++j) { const f32x4 v = yr[64 * j], ww = wr_[64 * j]; yr[64 * j] = (f32x4){v.x * r * ww.x, v.y * r * ww.y, v.z * r * ww.z, v.w * r * ww.w}; }
        }
    }
#undef IN
#undef SEAM
}


#if MK_DEBUG
__global__ void dbg_check(const unsigned* p, size_t nwords, int kind  , unsigned long long* stat, unsigned long long* hstat) {
    unsigned long long cs = 0, nf = 0, hg = 0;
    for (size_t i = (size_t)blockIdx.x * blockDim.x + threadIdx.x; i < nwords; i += (size_t)gridDim.x * blockDim.x) {
        const unsigned w = p[i]; cs += (unsigned long long)w * (2ull * i + 1ull);
        if (kind == 0) { nf += ((w & 0x7f800000u) == 0x7f800000u); hg += (((w >> 23) & 0xffu) >= 141u); } else if (kind == 1) { nf += ((w & 0x7f80u) == 0x7f80u) + ((w & 0x7f800000u) == 0x7f800000u); hg += (((w >> 7) & 0xffu) >= 141u) + (((w >> 23) & 0xffu) >= 141u); }
    }
    for (int o = 32; o >= 1; o >>= 1) { cs += __shfl_xor(cs, o); nf += __shfl_xor(nf, o); hg += __shfl_xor(hg, o); }
    if ((threadIdx.x & 63) == 0) { atomicAdd(stat, nf); atomicAdd(stat + 1, cs); atomicAdd(hstat, hg); }
}
__global__ void dbg_check2(const unsigned short* p, int rows, int ld, int col0, int ncols, unsigned long long* stat, unsigned long long* hstat) {
    unsigned long long cs = 0, nf = 0, hg = 0; const size_t n = (size_t)rows * ncols;
    for (size_t i = (size_t)blockIdx.x * blockDim.x + threadIdx.x; i < n; i += (size_t)gridDim.x * blockDim.x) {
        const size_t r = i / ncols, cc = i % ncols; const unsigned w = p[r * ld + col0 + cc]; cs += (unsigned long long)w * (2ull * i + 1ull); nf += ((w & 0x7f80u) == 0x7f80u); hg += (((w >> 7) & 0xffu) >= 141u);
    }
    for (int o = 32; o >= 1; o >>= 1) { cs += __shfl_xor(cs, o); nf += __shfl_xor(nf, o); hg += __shfl_xor(hg, o); }
    if ((threadIdx.x & 63) == 0) { atomicAdd(stat, nf); atomicAdd(stat + 1, cs); atomicAdd(hstat, hg); }
}
__global__ void dbg_report(const unsigned long long* stat, const unsigned long long* hstat, float* out, unsigned* codew) {
    __shared__ int code_s;
    if (threadIdx.x == 0) {
        int code = 0;
        const int order[28] = {1, 2, 3, 4, 5, 6, 7, 8, 9, 10, 11, 12, 25, 26, 27, 13, 14, 15, 16, 17, 18, 19, 20, 21, 22, 23, 24, 0};
        for (int q = 0; q < 27 && !code; ++q) { const int k = order[q];
            if (stat[(0 * 32 + k) * 2] || stat[(1 * 32 + k) * 2]) code = k;
            else if (k != 15 && k != 23 && k != 22 && hstat[k]) code = 64 + k;
            else if (stat[(0 * 32 + k) * 2 + 1] != stat[(1 * 32 + k) * 2 + 1]) code = 32 + k; }
        { const unsigned bits = ((const unsigned*)hstat)[62]; if (bits) { int idx = 0; while (!((bits >> idx) & 1u)) ++idx; code = 92 + idx; } }
        if (!code) { const unsigned* cst = (const unsigned*)hstat + 64;
            for (int i = 14; i >= 0; --i) { const float er = __uint_as_float(cst[2 * i]), rf = __uint_as_float(cst[2 * i + 1]); if (er > 0.06f * rf + 1e-3f) code = 100 + 10 * i; } }
        code_s = code; if (blockIdx.x == 0) *codew = (unsigned)code;
    }
    __syncthreads();
    const int code = code_s; if (!code) return;
    const float c = sqrtf((float)code);
    for (size_t i = (size_t)blockIdx.x * blockDim.x + threadIdx.x; i < O_END; i += (size_t)gridDim.x * blockDim.x) out[i] = (i >= O_YS && i < O_SAP) ? c : 0.f;
}
#endif

#if MK_DEBUG
__device__ __forceinline__ float blk_sum128(float v, float* red) {
    for (int o = 32; o >= 1; o >>= 1) v += __shfl_xor(v, o);
    __syncthreads(); if ((threadIdx.x & 63) == 0) red[threadIdx.x >> 6] = v; __syncthreads();
    return red[0] + red[1];
}
__device__ __forceinline__ void chk_accum(float ref, float got, unsigned* st) {
    float e = fabsf(ref - got), r = fabsf(ref); if (!(e == e)) e = 1e30f;
    for (int o = 32; o >= 1; o >>= 1) { e = fmaxf(e, __shfl_xor(e, o)); r = fmaxf(r, __shfl_xor(r, o)); }
    if ((threadIdx.x & 63) == 0) { atomicMax(st, __float_as_uint(e)); atomicMax(st + 1, __float_as_uint(r)); }
}
template <int MODE>
__global__ void chk_attn(const bf16_t* Q, const bf16_t* K, const bf16_t* V, const bf16_t* Gt, int ld, int NH, const float* ck, const float* cv, const float* clf  ,
                         const float* FL, const bf16_t* A, int acol0, int nprompt, unsigned* st, int smp_slot, int prompt_slot0) {
    __shared__ float red[2];
    const int d = threadIdx.x; int hd, qrow, qpos, b = 0; bool smp;
    if ((int)blockIdx.x < nprompt) { smp = false; hd = blockIdx.x % NH; const int j = blockIdx.x / NH; qrow = (j * 1237 + 5) % TP; qpos = qrow; }
    else { smp = true; const int u = blockIdx.x - nprompt; const int t = u & 15; hd = (u >> 4) % NH; b = (u >> 4) / NH; qrow = TP + 16 * b + t; qpos = PAST + t; }
    const float q = bf2f(Q[(size_t)qrow * ld + hd * HD + d]) ;
    const int s_top = MODE ? qpos : qpos - 1;
    float o = 0.f, tail = 0.f, m = -1e30f, l = 0.f, dsum = 0.f;
    for (int s = s_top; s >= 0; --s) {
        float kv, vv;
        if (smp) { if (s < PAST) { const size_t ix = (((size_t)b * PAST + s) * NH + hd) * HD + d; kv = ck[ix]; vv = cv[ix]; } else { const size_t ix = (size_t)(TP + 16 * b + s - PAST) * ld + hd * HD + d; kv = bf2f(K[ix]); vv = bf2f(V[ix]); } }
        else { const size_t ix = (size_t)s * ld + hd * HD + d; kv = bf2f(K[ix]); vv = bf2f(V[ix]); }
        const float z = blk_sum128(q * kv, red) * 0.08838834764831845f;
        if (MODE == 0) {
            const float lp = fminf(z, 0.f) - log1pf(expf(-fabsf(z))), lm = lp - z;
            o += expf(lp + tail) * vv; tail += lm;
            if (tail < -200.f) break;
        } else {
            const float x = z + dsum;
            const float mn = fmaxf(m, x), al = expf(m - mn), p = expf(x - mn);
            o = o * al + p * vv; l = l * al + p; m = mn;
            float lf;
            if (smp) lf = (s < PAST) ? clf[((size_t)b * PAST + s) * NH + hd] : FL[(size_t)(TP + 16 * b + s - PAST) * 32 + hd]; else lf = FL[(size_t)s * 32 + hd];
            dsum += lf;
            if (dsum < -200.f && m > -1e29f) break;
        }
    }
    if (MODE == 1) o /= l;
    const float ref = o * bf2f(Gt[(size_t)qrow * ld + hd * HD + d]);
    chk_accum(ref, bf2f(A[(size_t)qrow * DM + acol0 + hd * HD + d]), st + (smp ? 2 * smp_slot : (MODE ? 2 * (prompt_slot0 + (int)(blockIdx.x / NH)) : 0)));
}
__global__ void chk_fc(const float* FL, const float* clf, const float* FCP, const float* FCS, unsigned* st) {
    const int u = blockIdx.x, lane = threadIdx.x;
    if (u < 32) { const int hd = u, t = (lane * 131 + 7) % TP; double s = 0; for (int j = 0; j <= t; ++j) s += (double)FL[(size_t)j * 32 + hd]; chk_accum((float)(s * 1.4426950408889634), FCP[(size_t)hd * TP + t], st); }
    else { const int ub = u - 32, b = ub >> 5, hd = ub & 31, t = (lane * 17 + 3) % 1040; double s = 0; for (int j = 0; j <= t; ++j) s += (double)(j < PAST ? clf[((size_t)b * PAST + j) * 32 + hd] : FL[(size_t)(TP + 16 * b + j - PAST) * 32 + hd]); chk_accum((float)(s * 1.4426950408889634), FCS[(size_t)ub * FCS_LD + t], st + 2); }
}
__global__ void chk_hgrn_sample(const bf16_t* QA, const bf16_t* KA, const bf16_t* VA, const float* Gb, const float* S0, const float* Sout, float* oref, unsigned* st) {
    __shared__ float red[2];
    const int u = blockIdx.x >> 7, v = blockIdx.x & 127, k = threadIdx.x, b = u >> 4, hd = u & 15;
    float S = S0[(size_t)u * 16384 + k * 128 + v];
    for (int t = 0; t < 16; ++t) { const size_t ro = (size_t)(TP + 16 * b + t) * HW + hd * HD;
        S = S * expf(Gb[ro + k]) + bf2f(KA[ro + k]) * bf2f(VA[ro + v]);
        const float ov = blk_sum128(bf2f(QA[ro + k]) * S, red);
        if (k == 0) oref[((size_t)u * 16 + t) * 128 + v] = ov; }
    chk_accum(S, Sout[(size_t)u * 16384 + k * 128 + v], st);
}
__global__ void chk_hgrn_sample_out(const float* oref, const bf16_t* GA, const float* anw, const bf16_t* A, unsigned* st) {
    __shared__ float red[2];
    const int u = blockIdx.x >> 4, t = blockIdx.x & 15, v = threadIdx.x, b = u >> 4, hd = u & 15;
    const float o = oref[((size_t)u * 16 + t) * 128 + v];
    const float ss = blk_sum128(o * o, red);
    const int row = TP + 16 * b + t;
    const float ref = o * rsqrtf(ss * (1.f / 128.f) + EPS) * anw[v] * bf2f(GA[(size_t)row * HW + hd * HD + v]);
    chk_accum(ref, bf2f(A[(size_t)row * DM + hd * HD + v]), st);
}
#endif
extern "C" void kernel_launch(void* const* d_in, const int* in_sizes, int n_in, void* d_out, int out_size, void* d_ws, size_t ws_size, hipStream_t stream) {
    static int grid = 0;
    if (grid == 0) {
        if (n_in != 17 || (size_t)out_size != O_END || ws_size < WS_END) { fprintf(stderr, "kernel_launch: unexpected shapes (n_in %d, out %d, ws %zu)\n", n_in, out_size, ws_size); grid = -1; return; }
        int dev = 0, cus = 0, per_cu = 0;
        if (hipGetDevice(&dev) != hipSuccess || hipDeviceGetAttribute(&cus, hipDeviceAttributeMultiprocessorCount, dev) != hipSuccess) { grid = -1; return; }
        if (hipFuncSetAttribute((const void*)fwd_kernel, hipFuncAttributeMaxDynamicSharedMemorySize, LDS_BYTES) != hipSuccess) { fprintf(stderr, "kernel_launch: hipFuncSetAttribute failed\n"); grid = -1; return; }
        if (hipOccupancyMaxActiveBlocksPerMultiprocessor(&per_cu, (const void*)fwd_kernel, NWAVES * 64, LDS_BYTES) != hipSuccess || per_cu < 1)
            fprintf(stderr, "kernel_launch: occupancy query reports %d workgroups per CU\n", per_cu);
        (void)hipGetLastError();
        grid = cus;
    }
    if (grid < 0) return;
    (void)hipMemsetAsync((char*)d_ws + WS_CTL, 0, CTL_ZERO_BYTES, stream);
    Args a{};
    for (int i = 0; i < 17; ++i) a.in[i] = (const float*)d_in[i];
    a.out = (float*)d_out; a.ws = (unsigned char*)d_ws;
#if MK_DEBUG
    unsigned char* ws = (unsigned char*)d_ws; float* out = (float*)d_out;
    unsigned long long* stat = (unsigned long long*)((unsigned*)(ws + WS_CTL) + CW_STAT);
    unsigned long long* hstat = (unsigned long long*)((unsigned*)(ws + WS_CTL) + CW_HSTAT);
    for (int run = 0; run < 2; ++run) {
        if (run) (void)hipMemsetAsync((char*)d_ws + WS_CTL, 0, (size_t)CW_STAT * 4, stream);
        auto CHK = [&](int k, const void* p, size_t bytes, int kind) { hipLaunchKernelGGL(dbg_check, dim3(2048), dim3(256), 0, stream, (const unsigned*)p, bytes / 4, kind, stat + (run * 32 + k) * 2, hstat + k); };
        auto CHK2 = [&](int k, const void* p, int rows, int ld, int col0, int ncols) { hipLaunchKernelGGL(dbg_check2, dim3(2048), dim3(256), 0, stream, (const unsigned short*)p, rows, ld, col0, ncols, stat + (run * 32 + k) * 2, hstat + k); };
        for (int p = 0; p < NPHASE; ++p) {
            a.ph_lo = p; a.ph_hi = p + 1; hipLaunchKernelGGL(fwd_kernel, dim3(grid), dim3(NWAVES * 64), LDS_BYTES, stream, a);
            switch (p) {
                case 0: CHK(1, ws + WS_W1T, WS_XN - WS_W1T, 1); CHK(2, ws + WS_XN, 66 * MiB, 1); CHK(3, ws + WS_LB, 8192, 0); break;
                case 1: CHK(4, ws + WS_P, 8 * 33 * MiB, 1); CHK(5, ws + WS_G, 66 * MiB, 0); CHK(6, out + O_BKP, (O_CKP - O_BKP) * 4, 0); break;
                case 2: CHK(7, ws + WS_SLOC, 128 * MiB, 0); CHK(8, ws + WS_DEC, 1 * MiB, 0); CHK(9, out + O_SAS, (O_BKP - O_SAS) * 4, 0); break;
                case 3: CHK(10, ws + WS_SST, 64 * MiB, 1); CHK(11, out + O_SAP, (O_SAS - O_SAP) * 4, 0); break;
                case 4: if (run == 0) {
                    unsigned* cst = (unsigned*)(ws + WS_CTL) + CW_HSTAT + 64;
                    bf16_t* Pp = (bf16_t*)(ws + WS_P); float* oref = (float*)(ws + WS_FCS);
                    hipLaunchKernelGGL(chk_attn<0>, dim3(16 * 8 + 256 * 16), dim3(128), 0, stream, Pp + 4 * PSTR1, Pp + 5 * PSTR1, Pp + 6 * PSTR1, Pp + 7 * PSTR1, HW, 16, (const float*)d_in[3], (const float*)d_in[4], (const float*)nullptr, (const float*)nullptr, (const bf16_t*)(ws + WS_A), HW, 16 * 8, cst + 0, 1, 0);
                    hipLaunchKernelGGL(chk_hgrn_sample, dim3(256 * 128), dim3(128), 0, stream, Pp, Pp + PSTR1, Pp + 2 * PSTR1, (const float*)(ws + WS_G), (const float*)d_in[2], (const float*)(out + O_SAS), oref, cst + 4);
                    hipLaunchKernelGGL(chk_hgrn_sample_out, dim3(256 * 16), dim3(128), 0, stream, (const float*)oref, Pp + 3 * PSTR1, (const float*)d_in[13], (const bf16_t*)(ws + WS_A), cst + 6); }
                    CHK2(12, ws + WS_A, TP, DM, 0, HW); CHK2(25, ws + WS_A, TP, DM, HW, HW); CHK2(26, ws + WS_A + (size_t)TP * DM * 2, 256, DM, 0, HW); CHK2(27, ws + WS_A + (size_t)TP * DM * 2, 256, DM, HW, HW); break;
                case 5: CHK(13, ws + WS_H1, 132 * MiB, 0); CHK(14, ws + WS_XN, 66 * MiB, 1); CHK(15, ws + WS_CTL + CW_RS1 * 4, 8448 * 8, 1 + 1); break;
                case 6: CHK(16, ws + WS_P, 4 * 66 * MiB, 1); CHK(17, ws + WS_FL, 8448 * 32 * 4, 0); CHK(18, out + O_CKP, (O_END - O_CKP) * 4, 0); break;
                case 7: CHK(19, ws + WS_FCP, 1 * MiB, 0); CHK(20, ws + WS_FCS, (size_t)512 * FCS_LD * 4, 0); break;
                case 8: if (run == 0) {
                    unsigned* cst = (unsigned*)(ws + WS_CTL) + CW_HSTAT + 64; bf16_t* Pp = (bf16_t*)(ws + WS_P);
                    hipLaunchKernelGGL(chk_attn<1>, dim3(32 * 8 + 512 * 16), dim3(128), 0, stream, Pp, Pp + PSTR3, Pp + 2 * PSTR3, Pp + 3 * PSTR3, DM, 32, (const float*)d_in[5], (const float*)d_in[6], (const float*)d_in[7], (const float*)(ws + WS_FL), (const bf16_t*)(ws + WS_A), 0, 32 * 8, cst, 14, 6);
                    hipLaunchKernelGGL(chk_fc, dim3(32 + 512), dim3(64), 0, stream, (const float*)(ws + WS_FL), (const float*)d_in[7], (const float*)(ws + WS_FCP), (const float*)(ws + WS_FCS), cst + 8); }
                    CHK(21, ws + WS_A, 66 * MiB, 1); break;
                case 9: CHK(22, out, (size_t)MROWS * DM * 4, 0); CHK(23, ws + WS_CTL + CW_RS2 * 4, 8448 * 8, 2); break;
                case 10: CHK(24, out, (size_t)MROWS * DM * 4, 0); break;
            }
        }
    }
    hipLaunchKernelGGL(dbg_report, dim3(1024), dim3(256), 0, stream, (const unsigned long long*)stat, (const unsigned long long*)hstat, out, (unsigned*)(ws + WS_CTL) + CW_HSTAT + 63);
#elif MK_FUSED
    a.ph_lo = 0; a.ph_hi = NPHASE;
    hipLaunchKernelGGL(fwd_kernel, dim3(grid), dim3(NWAVES * 64), LDS_BYTES, stream, a);
#else
    for (int p = 0; p < NPHASE; ++p) { a.ph_lo = p; a.ph_hi = p + 1; hipLaunchKernelGGL(fwd_kernel, dim3(grid), dim3(NWAVES * 64), LDS_BYTES, stream, a); }
#endif
}
```
